# Optimizing an MI355X kernel written in HIP

```python
import math
import jax, jax.numpy as jnp
from jax import lax
import numpy as np

D_MODEL = 1024
BATCH = 8
SEQ = 2048
DEPTH = 2

CHUNK = 64
QBLOCK = 64
N_EVEN = (DEPTH + 1) // 2
N_ODD = DEPTH // 2

A_HEADS = 8
A_HEAD_DIM = 64
A_WIDTH = A_HEADS * A_HEAD_DIM
IDX_HEADS = 16
IDX_DIM = 64
TOPK_MAX = 256
REL_BUCKETS = 32
REL_MAX_DIST = 128
B_GROUPS = 8
B_GROUP_DIM = 64
B_WIDTH = B_GROUPS * B_GROUP_DIM
B_CHUNK = 128
C_HEADS = 8
C_KEY_DIM = 128
C_VAL_DIM = 128
C_WIDTH = C_HEADS * C_VAL_DIM
D_FF = 2816
CONV_WIDTH = 3
EPS = 1e-6

AB_SPLITS = (A_WIDTH, A_WIDTH, A_WIDTH, IDX_HEADS * IDX_DIM, IDX_DIM, IDX_HEADS, B_WIDTH, B_WIDTH)
AB_IN = sum(AB_SPLITS)
C_SPLITS = (C_HEADS * C_KEY_DIM, C_HEADS * C_KEY_DIM, C_WIDTH, C_WIDTH)
C_IN = sum(C_SPLITS)

kernel_name = 'hybrid_dsa_gmlp_hgrn2_convffn'

F32 = jnp.float32


def rms_norm(x, g):
    xf = x.astype(F32)
    y = xf * lax.rsqrt(jnp.mean(xf * xf, axis=-1, keepdims=True) + EPS)
    return (y * g.astype(F32)).astype(x.dtype)


def split_cols(h, sizes):
    offs = np.cumsum(sizes)[:-1].tolist()
    return jnp.split(h, offs, axis=-1)


def t5_bucket(rel):
    half = REL_BUCKETS // 2
    max_exact = half // 2
    ret = jnp.where(rel > 0, half, 0)
    n = jnp.abs(rel)
    nf = jnp.maximum(n, max_exact).astype(F32)
    large = max_exact + (jnp.log(nf / max_exact) / math.log(REL_MAX_DIST / max_exact)
                         * (half - max_exact)).astype(jnp.int32)
    large = jnp.minimum(large, half - 1)
    return ret + jnp.where(n < max_exact, n, large)


def dsa_attention(q, k, v, iq, ik, iw, rel_bias):
    bsz, seq = q.shape[0], q.shape[1]
    top_k = min(TOPK_MAX, seq // 4)
    n_blocks = seq // QBLOCK
    key_chunk = jnp.arange(seq) // CHUNK
    kv = jnp.concatenate([k, v], axis=-1)
    ik32 = ik.astype(F32)
    idx_scale = IDX_DIM ** -0.5
    w_scale = IDX_HEADS ** -0.5
    att_scale = A_HEAD_DIM ** -0.5

    def block(i):
        start = i * QBLOCK
        t = start + jnp.arange(QBLOCK)
        q_b = lax.dynamic_slice_in_dim(q, start, QBLOCK, axis=1)
        iq_b = lax.dynamic_slice_in_dim(iq, start, QBLOCK, axis=1)
        iw_b = lax.dynamic_slice_in_dim(iw, start, QBLOCK, axis=1)
        s = jnp.einsum('bqhd,bsd->bqhs', iq_b.astype(F32), ik32) * idx_scale
        score = jnp.einsum('bqhs,bqh->bqs', jax.nn.relu(s), iw_b.astype(F32) * w_scale)
        allowed = key_chunk[None, :] <= (t // CHUNK)[:, None]
        score = jnp.where(allowed[None], score, -jnp.inf)
        _, sel = lax.top_k(score, top_k)
        kv_sel = jax.vmap(lambda kvb, ib: kvb[ib])(kv, sel)
        k_sel, v_sel = jnp.split(kv_sel, 2, axis=-1)
        valid = (sel // CHUNK) <= (t // CHUNK)[None, :, None]
        bias = rel_bias[t5_bucket(sel - t[None, :, None])]
        logits = (jnp.einsum('bqhd,bqkhd->bhqk', q_b, k_sel).astype(F32) * att_scale
                  + jnp.transpose(bias, (0, 3, 1, 2)).astype(F32))
        logits = jnp.where(valid[:, None], logits, -jnp.inf)
        p = jax.nn.softmax(logits, axis=-1).astype(v.dtype)
        return jnp.einsum('bhqk,bqkhd->bqhd', p, v_sel)

    out = lax.map(block, jnp.arange(n_blocks))
    return jnp.transpose(out, (1, 0, 2, 3, 4)).reshape(bsz, seq, A_WIDTH)


def gmlp_spatial_gate(u, v, norm_g, w_s, b_s):
    bsz, seq = u.shape[0], u.shape[1]
    v = rms_norm(v, norm_g)
    pos_chunk = jnp.arange(B_CHUNK) // CHUNK
    mask = (pos_chunk[:, None] >= pos_chunk[None, :]).astype(w_s.dtype)
    vb = v.reshape(bsz, seq // B_CHUNK, B_CHUNK, B_GROUPS, B_GROUP_DIM)
    s = (jnp.einsum('gij,bnjgc->bnigc', w_s * mask, vb)
         + jnp.transpose(b_s)[None, None, :, :, None])
    return u * s.reshape(bsz, seq, B_WIDTH)


def hgrn2(q, f, i, lb):
    bsz, seq = q.shape[0], q.shape[1]
    lb = lb.astype(F32)
    q = jax.nn.silu(q.astype(F32))
    g = lb + (1.0 - lb) * jax.nn.sigmoid(f.astype(F32))
    k = 1.0 - g
    log_g = jnp.log(g)
    nc = seq // CHUNK

    def to_chunks(a, d):
        return a.reshape(bsz, nc, CHUNK, C_HEADS, d).transpose(1, 0, 3, 2, 4)

    qc = to_chunks(q, C_KEY_DIM)
    kc = to_chunks(k, C_KEY_DIM)
    lgc = to_chunks(log_g, C_KEY_DIM)
    ic = to_chunks(i.astype(F32), C_VAL_DIM)
    causal = (jnp.arange(CHUNK)[:, None] >= jnp.arange(CHUNK)[None, :])[:, :, None]

    def step(S, xs):
        qb, kb, ib, lgb = xs
        b = jnp.cumsum(lgb, axis=-2)
        inter = jnp.einsum('bhtd,bhde->bhte', qb * jnp.exp(b), S)
        diff = b[:, :, :, None, :] - b[:, :, None, :, :]
        decay = jnp.where(causal, jnp.exp(jnp.where(causal, diff, 0.0)), 0.0)
        a = jnp.einsum('bhtd,bhtsd,bhsd->bhts', qb, decay, kb)
        intra = jnp.einsum('bhts,bhse->bhte', a, ib)
        b_last = b[:, :, -1:, :]
        S_new = (jnp.exp(b_last[:, :, 0, :])[..., None] * S
                 + jnp.einsum('bhsd,bhse->bhde', kb * jnp.exp(b_last - b), ib))
        return S_new, inter + intra

    S0 = jnp.zeros((bsz, C_HEADS, C_KEY_DIM, C_VAL_DIM), F32)
    _, o = lax.scan(step, S0, (qc, kc, ic, lgc))
    return o.transpose(1, 0, 3, 2, 4).reshape(bsz, seq, C_HEADS, C_VAL_DIM)


def conv_ffn(x, w_up, conv_w, conv_b, w_down):
    seq = x.shape[1]
    h = x @ w_up
    hp = jnp.pad(h, ((0, 0), (CONV_WIDTH - 1, 0), (0, 0)))
    y = conv_b + conv_w[CONV_WIDTH - 1] * hp[:, CONV_WIDTH - 1:CONV_WIDTH - 1 + seq]
    for j in range(CONV_WIDTH - 1):
        y = y + conv_w[j] * hp[:, j:j + seq]
    a, b = jnp.split(y, 2, axis=-1)
    return (jax.nn.silu(a) * b) @ w_down


def setup_inputs(seed: int = 0) -> dict:
    key = jax.random.key(seed)
    ks = jax.random.split(key, 19)

    def nrm(k, shape, scale):
        return jax.random.normal(k, shape, F32) * scale

    def gain(k, shape):
        return 1.0 + 0.05 * jax.random.normal(k, shape, F32)

    return {
        'x': nrm(ks[0], (BATCH, SEQ, D_MODEL), 1.0),
        'rel_bias': nrm(ks[1], (REL_BUCKETS, A_HEADS), 0.5),
        'hgrn_lb': nrm(ks[2], (DEPTH, C_HEADS * C_KEY_DIM), 0.5),
        'mix_norm': gain(ks[3], (DEPTH, D_MODEL)),
        'ffn_norm': gain(ks[4], (DEPTH, D_MODEL)),
        'final_norm': gain(ks[5], (D_MODEL,)),
        'ab_w_in': nrm(ks[6], (N_EVEN, D_MODEL, AB_IN), D_MODEL ** -0.5),
        'ab_idx_k_norm': gain(ks[7], (N_EVEN, IDX_DIM)),
        'ab_gmlp_norm': gain(ks[8], (N_EVEN, B_WIDTH)),
        'ab_w_s': nrm(ks[9], (N_EVEN, B_GROUPS, B_CHUNK, B_CHUNK), B_CHUNK ** -0.5),
        'ab_b_s': 1.0 + nrm(ks[10], (N_EVEN, B_GROUPS, B_CHUNK), 0.02),
        'ab_w_out': nrm(ks[11], (N_EVEN, A_WIDTH + B_WIDTH, D_MODEL), (A_WIDTH + B_WIDTH) ** -0.5),
        'c_w_in': nrm(ks[12], (N_ODD, D_MODEL, C_IN), D_MODEL ** -0.5),
        'c_out_norm': gain(ks[13], (N_ODD, C_VAL_DIM)),
        'c_w_out': nrm(ks[14], (N_ODD, C_WIDTH, D_MODEL), C_WIDTH ** -0.5),
        'ffn_w_up': nrm(ks[15], (DEPTH, D_MODEL, 2 * D_FF), D_MODEL ** -0.5),
        'ffn_conv_w': nrm(ks[16], (DEPTH, CONV_WIDTH, 2 * D_FF), CONV_WIDTH ** -0.5),
        'ffn_conv_b': nrm(ks[17], (DEPTH, 2 * D_FF), 0.02),
        'ffn_w_down': nrm(ks[18], (DEPTH, D_FF, D_MODEL), D_FF ** -0.5),
    }


def reference(x, rel_bias, hgrn_lb, mix_norm, ffn_norm, final_norm,
              ab_w_in, ab_idx_k_norm, ab_gmlp_norm, ab_w_s, ab_b_s, ab_w_out,
              c_w_in, c_out_norm, c_w_out,
              ffn_w_up, ffn_conv_w, ffn_conv_b, ffn_w_down):
    bsz, seq, _ = x.shape
    lb_all = jnp.cumsum(jax.nn.softmax(hgrn_lb.astype(F32), axis=0), axis=0)
    lb_all = lb_all - lb_all[0:1]
    for l in range(DEPTH):
        h = rms_norm(x, mix_norm[l])
        if l % 2 == 0:
            e = l // 2
            q, k, v, iq, ik, iw, u, vg = split_cols(h @ ab_w_in[e], AB_SPLITS)
            ik = rms_norm(ik, ab_idx_k_norm[e])
            y_a = dsa_attention(q.reshape(bsz, seq, A_HEADS, A_HEAD_DIM),
                                k.reshape(bsz, seq, A_HEADS, A_HEAD_DIM),
                                v.reshape(bsz, seq, A_HEADS, A_HEAD_DIM),
                                iq.reshape(bsz, seq, IDX_HEADS, IDX_DIM),
                                ik, iw, rel_bias)
            y_b = gmlp_spatial_gate(jax.nn.gelu(u), jax.nn.gelu(vg),
                                    ab_gmlp_norm[e], ab_w_s[e], ab_b_s[e])
            y = jnp.concatenate([y_a, y_b], axis=-1) @ ab_w_out[e]
        else:
            o_i = l // 2
            q, f, i, gate = split_cols(h @ c_w_in[o_i], C_SPLITS)
            o = hgrn2(q, f, i, lb_all[l])
            o = rms_norm(o, c_out_norm[o_i]).reshape(bsz, seq, C_WIDTH).astype(x.dtype)
            y = (o * jax.nn.silu(gate)) @ c_w_out[o_i]
        x = x + y
        x = x + conv_ffn(rms_norm(x, ffn_norm[l]), ffn_w_up[l], ffn_conv_w[l],
                         ffn_conv_b[l], ffn_w_down[l])
    return rms_norm(x, final_norm)
```

```cpp
#include <hip/hip_runtime.h>
#include <cstdio>
#include <cstdint>

#ifndef MK_N_LAUNCHES
#define MK_N_LAUNCHES 1
#endif

__device__ __forceinline__ int lane_now() { int l; asm volatile("v_mbcnt_lo_u32_b32 %0, -1, 0\n\tv_mbcnt_hi_u32_b32 %0, -1, %0" : "=v"(l)); return l; }

namespace pg8 {
#define PG8_LAS __attribute__((address_space(3)))
typedef unsigned short bf16_t;
typedef short bf16x8 __attribute__((ext_vector_type(8)));
typedef float f32x4 __attribute__((ext_vector_type(4)));
typedef unsigned u32x4 __attribute__((ext_vector_type(4)));
constexpr int BM = 256, BK = 64, HALF = 128, HTB = HALF * BK * 2  , STAGE_BYTES = 8 * HTB, NXCD = 8, WGM = 8;

__host__ __device__ __forceinline__ int lds_byte(int r, int c) { const int st = (r >> 4) * 2 + (c >> 5), rr = r & 15, cc = c & 31, ob = rr * 64 + cc * 2; return st * 1024 + (ob ^ (((ob >> 9) & 1) << 5)); }
__host__ __device__ __forceinline__ void stage_rc(int b, int& R, int& C) { const int st = b / 1024, sb = b % 1024, swz = sb ^ (((sb >> 9) & 1) << 5); R = (st >> 1) * 16 + swz / 64; C = (st & 1) * 32 + (swz % 64) / 2; }
__host__ __device__ __forceinline__ int perm32(int rho) { const int n = rho >> 4, i = rho & 15; return 8 * (i >> 2) + 4 * n + (i & 3); }

struct Unit { int pm, pn; };
struct Gemm { const bf16_t* A; const bf16_t* Bt; int M, N, K; };

struct StaticOrder {
    int nM, nN, nwg, G, c;
    __host__ __device__ __forceinline__ void init(int M, int N, int G_, int c_) { nM = M / BM; nN = N / BM; nwg = nM * nN; G = G_; c = c_; }
    __host__ __device__ __forceinline__ bool next(int i, Unit& u) const {
        const long L = (long)i * G + c; if (L >= nwg) return false;
        int wgid = (int)L; { const int q = nwg / NXCD, r = nwg % NXCD, xcd = wgid % NXCD, off = wgid / NXCD; wgid = (xcd < r ? xcd * (q + 1) : r * (q + 1) + (xcd - r) * q) + off; }
        const int nig = WGM * nN, gid = wgid / nig, fm = gid * WGM, gsz = (nM - fm) < WGM ? (nM - fm) : WGM;
        u.pm = fm + ((wgid % nig) % gsz); u.pn = (wgid % nig) / gsz; return true;
    }
    __device__ __forceinline__ void a_ready(const Unit&) const {}
    __device__ __forceinline__ void done(const Unit&) const {}
};

template <class Epi, class Sched, bool ALIGN_EPI = false, bool SP2 = false>
__device__ __forceinline__ void gemm_phase(PG8_LAS unsigned char* lds, const Gemm g, const Sched& S, const Epi& E, const int wave_idx) {
    int tid_l = wave_idx * 64 + lane_now();
    const int tid = tid_l, wid = __builtin_amdgcn_readfirstlane(tid >> 6), lane = tid & 63, wr = wid >> 2, wc = wid & 3, fr = lane & 15, fq = lane >> 4;
    const int K = g.K, nt = K / BK;
    unsigned voffA[2], voffB[2];
#pragma unroll
    for (int i = 0; i < 2; ++i) { int R, C; stage_rc(tid * 16 + i * 8192, R, C); const int Rb = Epi::PERM ? ((R & ~31) + perm32(R & 31)) : R;
        const int Rp = (((R >> 6) * 16 + (R & 15)) * 8 + ((R >> 4) & 3)); voffA[i] = (unsigned)(Rp * K + C) * 2u; voffB[i] = (unsigned)(Rb * K + C) * 2u; }
    const size_t kstep = (size_t)(BK * 2);
    const size_t hstepB = (size_t)HALF * K * 2, hstepA = (size_t)4 * K * 2;
    const size_t tstep = 2 * hstepB;
    const unsigned ldsw = (unsigned)wid * 1024u;
    const int aoff = lds_byte(wr * 64 + fr, fq * 8), boff = lds_byte(wc * 32 + fr, fq * 8);
#define PG8_SA(b, h) (((b) * 2 + (h)) * HTB)
#define PG8_SB(b, h) ((4 + (b) * 2 + (h)) * HTB)
#define PG8_STAGE(bufoff, gbase, voff) do { _Pragma("unroll") for (int _i = 0; _i < 2; ++_i) \
        __builtin_amdgcn_global_load_lds((const unsigned*)((const char*)(gbase) + (voff)[_i]), (PG8_LAS unsigned*)(lds + (bufoff) + ldsw + _i * 8192), 16, 0, 0); } while (0)
#define PG8_LDA(dst, b, h) do { _Pragma("unroll") for (int m = 0; m < 4; ++m) _Pragma("unroll") for (int k = 0; k < 2; ++k) dst[m][k] = *(const PG8_LAS bf16x8*)(lds + PG8_SA(b, h) + aoff + m * 2048 + k * 1024); } while (0)
#define PG8_LDB(dst, b, h) do { _Pragma("unroll") for (int n = 0; n < 2; ++n) _Pragma("unroll") for (int k = 0; k < 2; ++k) dst[n][k] = *(const PG8_LAS bf16x8*)(lds + PG8_SB(b, h) + boff + n * 2048 + k * 1024); } while (0)
#define PG8_MMA(ai, bj, At, Bt) do { __builtin_amdgcn_s_setprio(1); _Pragma("unroll") for (int m = 0; m < 4; ++m) _Pragma("unroll") for (int n = 0; n < 2; ++n) _Pragma("unroll") for (int k = 0; k < 2; ++k) \
        acc[ai][bj][m][n] = __builtin_amdgcn_mfma_f32_16x16x32_bf16(Bt[n][k], At[m][k], acc[ai][bj][m][n], 0, 0, 0); __builtin_amdgcn_s_setprio(0); } while (0)
#define PG8_WAIT_V(n) asm volatile("s_waitcnt vmcnt(" #n ")" ::: "memory")
#define PG8_WAIT_L(n) asm volatile("s_waitcnt lgkmcnt(" #n ")" ::: "memory")
#define PG8_BAR __builtin_amdgcn_s_barrier()
#define PG8_SCHED __builtin_amdgcn_sched_barrier(0)
    Unit cur, nxt; int ui = 0;
    if (!S.next(0, cur)) return;
    f32x4 acc[2][2][4][2];
#pragma unroll
    for (int a = 0; a < 2; ++a)
#pragma unroll
        for (int b = 0; b < 2; ++b)
#pragma unroll
            for (int m = 0; m < 4; ++m)
#pragma unroll
                for (int n = 0; n < 2; ++n) acc[a][b][m][n] = (f32x4){0.f, 0.f, 0.f, 0.f};
    bf16x8 At[4][2], B0[2][2], B1[2][2];
    const char* cA = (const char*)g.A + (size_t)cur.pm * tstep; const char* cB = (const char*)g.Bt + (size_t)cur.pn * tstep;
    S.a_ready(cur);
    if constexpr (SP2) {
        PG8_STAGE(PG8_SB(0, 0), cB, voffB); PG8_STAGE(PG8_SB(0, 1), cB + hstepB, voffB); PG8_STAGE(PG8_SA(0, 0), cA, voffA); PG8_STAGE(PG8_SA(0, 1), cA + hstepA, voffA);
        if (wr == 1) PG8_BAR;
        PG8_WAIT_V(2); PG8_BAR;
        PG8_STAGE(PG8_SB(1, 0), cB + kstep, voffB); PG8_STAGE(PG8_SA(1, 0), cA + kstep, voffA); PG8_STAGE(PG8_SB(1, 1), cB + hstepB + kstep, voffB);
        PG8_WAIT_V(6); PG8_BAR;
    } else {
        PG8_STAGE(PG8_SB(0, 0), cB, voffB); PG8_STAGE(PG8_SA(0, 0), cA, voffA); PG8_STAGE(PG8_SB(0, 1), cB + hstepB, voffB); PG8_STAGE(PG8_SA(0, 1), cA + hstepA, voffA);
        if (wr == 1) PG8_BAR;
        PG8_WAIT_V(4); PG8_BAR;
        PG8_STAGE(PG8_SB(1, 0), cB + kstep, voffB); PG8_STAGE(PG8_SA(1, 0), cA + kstep, voffA); PG8_STAGE(PG8_SB(1, 1), cB + hstepB + kstep, voffB);
        PG8_WAIT_V(6); PG8_BAR;
    }
    for (;;) {
        const bool has_next = S.next(ui + 1, nxt);
        const char* nA = has_next ? (const char*)g.A + (size_t)nxt.pm * tstep : cA; const char* nB = has_next ? (const char*)g.Bt + (size_t)nxt.pn * tstep : cB;
        for (int t = 0; t < nt; t += 2) {
            const bool last = (t == nt - 2);
            const char* a1 = cA + (size_t)(t + 1) * kstep;
            const char* a2 = last ? nA : cA + (size_t)(t + 2) * kstep; const char* b2 = last ? nB : cB + (size_t)(t + 2) * kstep;
            const char* a3 = a2 + kstep; const char* b3 = b2 + kstep;
            if (last && has_next) S.a_ready(nxt);
            if constexpr (SP2) {
            PG8_LDB(B0, 0, 0); PG8_LDB(B1, 0, 1); PG8_SCHED; PG8_LDA(At, 0, 0); PG8_STAGE(PG8_SA(1, 1), a1 + hstepA, voffA);
            PG8_WAIT_V(8); PG8_WAIT_L(0); PG8_BAR; PG8_MMA(0, 0, At, B0); PG8_MMA(0, 1, At, B1); PG8_BAR; PG8_SCHED;
            PG8_LDA(At, 0, 1); PG8_STAGE(PG8_SB(0, 0), b2, voffB); PG8_STAGE(PG8_SB(0, 1), b2 + hstepB, voffB); PG8_STAGE(PG8_SA(0, 0), a2, voffA);
            PG8_WAIT_V(8); PG8_WAIT_L(0); PG8_BAR; PG8_MMA(1, 0, At, B0); PG8_MMA(1, 1, At, B1); PG8_BAR; PG8_SCHED;
            PG8_LDB(B0, 1, 0); PG8_LDB(B1, 1, 1); PG8_SCHED; PG8_LDA(At, 1, 0); PG8_STAGE(PG8_SA(0, 1), a2 + hstepA, voffA);
            PG8_WAIT_V(8); PG8_WAIT_L(0); PG8_BAR; PG8_MMA(0, 0, At, B0); PG8_MMA(0, 1, At, B1); PG8_BAR; PG8_SCHED;
            PG8_LDA(At, 1, 1); PG8_STAGE(PG8_SB(1, 0), b3, voffB); PG8_STAGE(PG8_SB(1, 1), b3 + hstepB, voffB); PG8_STAGE(PG8_SA(1, 0), a3, voffA);
            PG8_WAIT_V(8); PG8_WAIT_L(0); PG8_BAR; PG8_MMA(1, 0, At, B0); PG8_MMA(1, 1, At, B1); PG8_BAR; PG8_SCHED;
            } else {
            PG8_LDB(B0, 0, 0); PG8_SCHED; PG8_LDA(At, 0, 0); PG8_STAGE(PG8_SA(1, 1), a1 + hstepA, voffA);
            PG8_WAIT_L(8); PG8_BAR; PG8_WAIT_L(0); PG8_MMA(0, 0, At, B0); PG8_BAR; PG8_SCHED;
            PG8_LDB(B1, 0, 1); PG8_STAGE(PG8_SB(0, 0), b2, voffB);
            PG8_BAR; PG8_WAIT_L(0); PG8_MMA(0, 1, At, B1); PG8_BAR;
            PG8_LDA(At, 0, 1); PG8_STAGE(PG8_SA(0, 0), a2, voffA);
            PG8_BAR; PG8_WAIT_L(0); PG8_MMA(1, 0, At, B0); PG8_BAR; PG8_SCHED;
            PG8_STAGE(PG8_SB(0, 1), b2 + hstepB, voffB);
            PG8_WAIT_V(6); PG8_BAR; PG8_MMA(1, 1, At, B1); PG8_BAR;
            PG8_LDB(B0, 1, 0); PG8_SCHED; PG8_LDA(At, 1, 0); PG8_STAGE(PG8_SA(0, 1), a2 + hstepA, voffA);
            PG8_WAIT_L(8); PG8_BAR; PG8_WAIT_L(0); PG8_MMA(0, 0, At, B0); PG8_BAR; PG8_SCHED;
            PG8_LDB(B1, 1, 1); PG8_STAGE(PG8_SB(1, 0), b3, voffB);
            PG8_BAR; PG8_WAIT_L(0); PG8_MMA(0, 1, At, B1); PG8_BAR;
            PG8_LDA(At, 1, 1); PG8_STAGE(PG8_SA(1, 0), a3, voffA);
            PG8_BAR; PG8_WAIT_L(0); PG8_MMA(1, 0, At, B0); PG8_BAR; PG8_SCHED;
            PG8_STAGE(PG8_SB(1, 1), b3 + hstepB, voffB);
            PG8_WAIT_V(6); PG8_BAR; PG8_MMA(1, 1, At, B1); PG8_BAR;
            }
        }
        if constexpr (ALIGN_EPI) { if (wr == 0) PG8_BAR; }
        if constexpr (!Epi::AFTER_DRAIN) { E(acc, cur, wr, wc, fr, fq); S.done(cur); }
        if (!has_next) break;
#pragma unroll
        for (int a = 0; a < 2; ++a)
#pragma unroll
            for (int b = 0; b < 2; ++b)
#pragma unroll
                for (int m = 0; m < 4; ++m)
#pragma unroll
                    for (int n = 0; n < 2; ++n) acc[a][b][m][n] = (f32x4){0.f, 0.f, 0.f, 0.f};
        cur = nxt; cA = nA; cB = nB; ++ui;
        if constexpr (ALIGN_EPI) { if (wr == 1) PG8_BAR; }
    }
    PG8_WAIT_V(0);
    if constexpr (!ALIGN_EPI) { if (wr == 0) PG8_BAR; }
    PG8_BAR;
    if constexpr (Epi::AFTER_DRAIN) { E.fused(acc, cur, wr, wc, fr, fq, lds, wid, lane); S.done(cur); }
#undef PG8_SA
#undef PG8_SB
#undef PG8_STAGE
#undef PG8_LDA
#undef PG8_LDB
#undef PG8_MMA
#undef PG8_WAIT_V
#undef PG8_WAIT_L
#undef PG8_BAR
#undef PG8_SCHED
}
}

constexpr int NB = 8, SEQ = 2048, DM = 1024, M = NB * SEQ;
constexpr int DFF = 2816, NUP = 2 * DFF;
constexpr int NAB = 3840;
constexpr int NCI = 4096;
constexpr float EPS = 1e-6f, LOG2E = 1.4426950408889634f, LN2 = 0.6931471805599453f;

#define GAS __attribute__((address_space(1)))
#define LAS __attribute__((address_space(3)))
typedef unsigned short bf16;
typedef short bf16x8 __attribute__((ext_vector_type(8)));
typedef float f32x4 __attribute__((ext_vector_type(4)));
typedef float f32x2 __attribute__((ext_vector_type(2)));
typedef float f32x16 __attribute__((ext_vector_type(16)));
typedef unsigned u32x4 __attribute__((ext_vector_type(4)));
typedef unsigned u32x2 __attribute__((ext_vector_type(2)));
typedef __bf16 bf16x2v __attribute__((ext_vector_type(2)));
typedef GAS unsigned gu32;

constexpr size_t MiB = 1u << 20;
constexpr size_t WS_CTL = 0, CTL_ZERO_BYTES = 1 * MiB;
constexpr size_t WS_WCI = 1 * MiB, WS_WCO = 9 * MiB, WS_WUP1 = 11 * MiB, WS_WDN1 = 22 * MiB;
constexpr size_t WS_SSQA = 128 * 1024;
constexpr size_t WS_SSQ0 = 29 * MiB;
constexpr size_t WS_OSSQ = 29 * MiB + 512 * 1024;
constexpr size_t WS_HB = 32 * MiB;
constexpr size_t WS_EB = 43 * MiB, WS_FAC = 44 * MiB;
constexpr size_t WS_XB = 46 * MiB;
constexpr size_t WS_WAB = 78 * MiB, WS_WABO = 86 * MiB, WS_WUP0 = 88 * MiB, WS_WDN0 = 99 * MiB;
constexpr size_t WS_R = 105 * MiB;
constexpr size_t WS_Q = WS_R, WS_K = WS_R + 16 * MiB, WS_VT = WS_R + 32 * MiB, WS_IQ = WS_R + 48 * MiB, WS_U = WS_R + 80 * MiB, WS_VGT = WS_R + 96 * MiB,
                 WS_Y = WS_R + 112 * MiB, WS_SEL = WS_R + 144 * MiB, WS_IK = WS_R + 148 * MiB, WS_IW = WS_R + 150 * MiB;
constexpr size_t WS_SSQV = 28 * MiB;
constexpr size_t WS_ACT = WS_R;
constexpr size_t WS_GATE = 78 * MiB, WS_QM = 110 * MiB, WS_KM = 142 * MiB, WS_KMT = 174 * MiB, WS_IT = 206 * MiB;
constexpr size_t WS_ON = WS_QM;
constexpr size_t WS_END = 256 * MiB;
static_assert(WS_IW + (size_t)M * 16 * 4 <= WS_END && WS_SSQV + (size_t)M * 8 * 4 <= WS_SSQ0 && WS_IT + 32 * MiB <= WS_END && WS_WDN0 + (size_t)DM * DFF * 2 <= WS_R, "ws map");
constexpr int CW_BAR = 4096;
constexpr size_t WS_FCNT = 64 * 1024;

constexpr int RING_BYTES = 131072, LDSX_OFF = RING_BYTES, MISC_OFF = RING_BYTES + 12288, LDS_BYTES = 147456;
constexpr int NWAVES = 8;

#define RLX_AGENT __ATOMIC_RELAXED, __HIP_MEMORY_SCOPE_AGENT
__device__ __forceinline__ unsigned cvt_pk(float lo, float hi) { unsigned r; asm volatile("v_cvt_pk_bf16_f32 %0, %1, %2" : "=v"(r) : "v"(lo), "v"(hi)); return r; }
__device__ __forceinline__ float fexp2(float x) { return __builtin_amdgcn_exp2f(x); }
__device__ __forceinline__ float frcp(float x) { return __builtin_amdgcn_rcpf(x); }
__device__ __forceinline__ float fexp(float x) { return __builtin_amdgcn_exp2f(x * LOG2E); }
__device__ __forceinline__ float fsigmoid(float x) { return frcp(1.f + fexp2(-LOG2E * x)); }
__device__ __forceinline__ float fsilu(float x) { return x * fsigmoid(x); }
__device__ __forceinline__ float fgelu(float x) { const float u = 0.7978845608028654f * (x + 0.044715f * x * x * x); return x * frcp(1.f + fexp2(-2.f * LOG2E * u)); }
__device__ __forceinline__ f32x2 fsilu2(f32x2 x, f32x2 xe) {
    const f32x2 e = {fexp2(xe[0]), fexp2(xe[1])}, d = e + 1.f; const f32x2 rr = {frcp(d[0]), frcp(d[1])}; return x * rr; }
__device__ __forceinline__ f32x2 fgelu2(f32x2 x) {
    constexpr float C1 = -2.f * LOG2E * 0.7978845608028654f, C2 = C1 * 0.044715f;
    const f32x2 x2 = x * x, t = x2 * C2 + C1, a = x * t;
    const f32x2 e = {fexp2(a[0]), fexp2(a[1])}, d = e + 1.f; const f32x2 rr = {frcp(d[0]), frcp(d[1])}; return x * rr; }
__device__ __forceinline__ float bf2f(unsigned short v) { return __builtin_bit_cast(float, (unsigned)v << 16); }
template <int CTRL> __device__ __forceinline__ float dpp_f(float v) { return __builtin_bit_cast(float, __builtin_amdgcn_update_dpp(0, __builtin_bit_cast(int, v), CTRL, 0xF, 0xF, false)); }
__device__ __forceinline__ bf16x8 pack8(float a0, float a1, float a2, float a3, float a4, float a5, float a6, float a7) {
    u32x4 w; w.x = cvt_pk(a0, a1); w.y = cvt_pk(a2, a3); w.z = cvt_pk(a4, a5); w.w = cvt_pk(a6, a7); return __builtin_bit_cast(bf16x8, w); }
__device__ __forceinline__ u32x2 pack4(float a0, float a1, float a2, float a3) { u32x2 w; w.x = cvt_pk(a0, a1); w.y = cvt_pk(a2, a3); return w; }
__device__ __forceinline__ size_t frag_off(int r, int c, int C) { return ((size_t)((r >> 5) * (C >> 4) + (c >> 4)) * 64 + ((c >> 3) & 1) * 32 + (r & 31)) * 8 + (c & 7); }
__device__ __forceinline__ int swap23(int v) { return (v & ~12) | ((v & 4) << 1) | ((v & 8) >> 1); }
#define MFMA32(a, b, c) __builtin_amdgcn_mfma_f32_32x32x16_bf16((a), (b), (c), 0, 0, 0)
__device__ __forceinline__ float wave_sum(float v) {
#pragma unroll
    for (int o = 1; o < 64; o <<= 1) v += __shfl_xor(v, o);
    return v;
}

struct Params {
    const float *x, *rel_bias, *hgrn_lb, *mix_norm, *ffn_norm, *final_norm, *ab_w_in, *ab_idx_k_norm, *ab_gmlp_norm, *ab_w_s, *ab_b_s, *ab_w_out,
                *c_w_in, *c_out_norm, *c_w_out, *ffn_w_up, *ffn_conv_w, *ffn_conv_b, *ffn_w_down;
    float* out; unsigned char* ws; int ph_lo, ph_hi;
};

template <int NP> __device__ __forceinline__ void row_scales(const float* ssq, int tok0, float (&r)[8]) {
#pragma unroll
    for (int j = 0; j < 8; ++j) {
        float s = 0.f;
        if (NP == 1) s = ssq[tok0 + j];
        else {
#pragma unroll
            for (int q = 0; q < NP / 4; ++q) { const f32x4 v = *(const f32x4*)(ssq + (size_t)(tok0 + j) * NP + 4 * q); s += (v[0] + v[1]) + (v[2] + v[3]); }
        }
        r[j] = 1.0f / sqrtf(s * (1.0f / DM) + EPS);
    }
}

#define ACC(j, bj, n, i) acc[(j) >> 2][bj][(j) & 3][n][i]
typedef pg8::Unit Unit;

struct EpiAB {
    static constexpr bool PERM = true, AFTER_DRAIN = false;
    unsigned char* ws; const float* ikg;
    __device__ __forceinline__ void operator()(const f32x4 (&acc)[2][2][4][2], const Unit& u, int wr, int wc, int fr, int fq) const {
        asm volatile("; epilogue-local lane coordinates" : "+v"(fr), "+v"(fq));
        const int tok0 = u.pm * 256 + (wr * 16 + fr) * 8, b = tok0 >> 11, s0 = tok0 & 2047, pn = u.pn;
        bf16* const IK = (bf16*)(ws + WS_IK); float* const IW = (float*)(ws + WS_IW); float* const SSQV = (float*)(ws + WS_SSQV);
        float r[8]; row_scales<1>((const float*)(ws + WS_SSQ0), tok0, r);
        const int cb = 32 * wc + 8 * fq;
        if (pn == 14) {
            if (wc == 0) {
                f32x4 gk[2][2];
#pragma unroll
                for (int bj = 0; bj < 2; ++bj) { gk[bj][0] = *(const f32x4*)(ikg + 32 * bj + 8 * fq); gk[bj][1] = *(const f32x4*)(ikg + 32 * bj + 8 * fq + 4); }
#pragma unroll
                for (int j = 0; j < 8; ++j) { f32x4 x[2][2]; float s = 0.f;
#pragma unroll
                    for (int bj = 0; bj < 2; ++bj)
#pragma unroll
                        for (int n = 0; n < 2; ++n) { x[bj][n] = acc[j >> 2][bj][j & 3][n] * r[j]; s += (x[bj][n][0] * x[bj][n][0] + x[bj][n][1] * x[bj][n][1]) + (x[bj][n][2] * x[bj][n][2] + x[bj][n][3] * x[bj][n][3]); }
                    s += __shfl_xor(s, 16); s += __shfl_xor(s, 32);
                    const float rn = 1.0f / sqrtf(s * (1.0f / 64.0f) + EPS);
#pragma unroll
                    for (int bj = 0; bj < 2; ++bj) { const int d0 = 32 * bj + 8 * fq; const f32x4 g0 = gk[bj][0], g1 = gk[bj][1];
                        const f32x4 y0 = x[bj][0] * rn * g0, y1 = x[bj][1] * rn * g1;
                        *(bf16x8*)(IK + frag_off(tok0 + j, d0, 64)) = pack8(y0[0], y0[1], y0[2], y0[3], y1[0], y1[1], y1[2], y1[3]); }
                    __builtin_amdgcn_sched_barrier(0); }
            } else if (wc == 1 && fq < 2) {
#pragma unroll
                for (int j = 0; j < 8; ++j) { const float rs = r[j] * 0.03125f;
                    *(f32x4*)(IW + (size_t)(tok0 + j) * 16 + 8 * fq) = acc[j >> 2][0][j & 3][0] * rs; *(f32x4*)(IW + (size_t)(tok0 + j) * 16 + 8 * fq + 4) = acc[j >> 2][0][j & 3][1] * rs; }
            }
        } else if (pn == 4 || pn == 5 || pn == 12 || pn == 13) {
            const bool isvg = pn >= 12; bf16* tb = (bf16*)(ws + (isvg ? WS_VGT : WS_VT)); const int pt = isvg ? pn - 12 : pn - 4;
            f32x2 ss2[8];
#pragma unroll
            for (int j = 0; j < 8; ++j) ss2[j] = f32x2{0.f, 0.f};
#pragma unroll
            for (int bj = 0; bj < 2; ++bj) { const int col = pt * 256 + 128 * bj + cb;
#pragma unroll
                for (int n = 0; n < 2; ++n)
#pragma unroll
                    for (int ip = 0; ip < 2; ++ip) { f32x2 v[8];
#pragma unroll
                        for (int j = 0; j < 8; ++j) { const f32x4 a = acc[j >> 2][bj][j & 3][n];
                            v[j] = (ip ? __builtin_shufflevector(a, a, 2, 3) : __builtin_shufflevector(a, a, 0, 1)) * r[j]; if (isvg) { v[j] = fgelu2(v[j]); ss2[j] = ss2[j] + v[j] * v[j]; } }
#pragma unroll
                        for (int e = 0; e < 2; ++e) {
                            bf16* base = tb + (size_t)b * (512 * 2048) + frag_off(col + 4 * n + 2 * ip + e, (s0 & ~15) + 4 * ((s0 >> 3) & 1), 2048);
                            *(u32x2*)base = pack4(v[0][e], v[1][e], v[2][e], v[3][e]); *(u32x2*)(base + 256) = pack4(v[4][e], v[5][e], v[6][e], v[7][e]); }
                        __builtin_amdgcn_sched_barrier(0); } }
            float ss[8];
#pragma unroll
            for (int j = 0; j < 8; ++j) ss[j] = ss2[j][0] + ss2[j][1];
            if (isvg) {
#pragma unroll
                for (int j = 0; j < 8; ++j) { float s = ss[j]; s += __shfl_xor(s, 16); s += __shfl_xor(s, 32); if (fq == 0) SSQV[(size_t)(tok0 + j) * 8 + pt * 4 + wc] = s; }
            }
        } else {
            const bool isqk = pn < 4, isu = pn >= 10;
            bf16* dst = (bf16*)(ws + (isqk ? WS_Q + (size_t)(pn >> 1) * (WS_K - WS_Q) : (isu ? WS_U : WS_IQ)));
            const int pt = isqk ? (pn & 1) : (isu ? pn - 10 : pn - 6);
            const float sc = pn < 2 ? 0.125f * LOG2E : 1.0f;
            const int sA = isqk ? 8 : (isu ? 512 : 0), sB = (isqk || isu) ? 0 : 2048, sC = (isqk || isu) ? 0 : 32;
#pragma unroll
            for (int bj = 0; bj < 2; ++bj) { const int col = pt * 256 + 128 * bj + cb, hd = col >> 6, d0 = col & 63;
                const size_t o0 = isqk ? (size_t)(b * 8 + hd) * (2048 * 64) + frag_off(s0, d0, 64) : (isu ? (size_t)tok0 * 512 + col : frag_off((tok0 >> 1) * 32 + (hd & 3) + 8 * (hd >> 2), d0, 64));
                bf16* dp = dst + o0;
#pragma unroll
                for (int j = 0; j < 8; ++j) { const float rs = r[j] * sc; const f32x4 a0 = acc[j >> 2][bj][j & 3][0], a1 = acc[j >> 2][bj][j & 3][1];
                    f32x2 p0 = __builtin_shufflevector(a0, a0, 0, 1) * rs, p1 = __builtin_shufflevector(a0, a0, 2, 3) * rs, p2 = __builtin_shufflevector(a1, a1, 0, 1) * rs, p3 = __builtin_shufflevector(a1, a1, 2, 3) * rs;
                    if (isu) { p0 = fgelu2(p0); p1 = fgelu2(p1); p2 = fgelu2(p2); p3 = fgelu2(p3); }
                    *(bf16x8*)(dp + (size_t)(j * sA + (j >> 1) * sB + (j & 1) * sC)) = pack8(p0[0], p0[1], p1[0], p1[1], p2[0], p2[1], p3[0], p3[1]);
                    __builtin_amdgcn_sched_barrier(0); } }
        }
    }
};

struct EpiRes {
    static constexpr bool PERM = true, AFTER_DRAIN = false;
    bf16* XB; float* ssq;
    __device__ __forceinline__ void operator()(const f32x4 (&acc)[2][2][4][2], const Unit& u, int wr, int wc, int fr, int fq) const {
        asm volatile("; epilogue-local lane coordinates" : "+v"(fr), "+v"(fq));
        const int tok0 = u.pm * 256 + (wr * 16 + fr) * 8;
        float sj[4];
#pragma unroll
        for (int j = 0; j < 8; ++j) { const size_t ro = (size_t)(tok0 + j) * DM; float s = 0.f;
#pragma unroll
            for (int bj = 0; bj < 2; ++bj) { const int col = u.pn * 256 + 128 * bj + 32 * wc + 8 * fq;
                const u32x4 xb = *(const u32x4*)(XB + ro + col);
                f32x4 v0, v1;
                v0[0] = __builtin_bit_cast(float, xb.x << 16); v0[1] = __builtin_bit_cast(float, xb.x & 0xffff0000u); v0[2] = __builtin_bit_cast(float, xb.y << 16); v0[3] = __builtin_bit_cast(float, xb.y & 0xffff0000u);
                v1[0] = __builtin_bit_cast(float, xb.z << 16); v1[1] = __builtin_bit_cast(float, xb.z & 0xffff0000u); v1[2] = __builtin_bit_cast(float, xb.w << 16); v1[3] = __builtin_bit_cast(float, xb.w & 0xffff0000u);
                v0 += acc[j >> 2][bj][j & 3][0]; v1 += acc[j >> 2][bj][j & 3][1];
                *(bf16x8*)(XB + ro + col) = pack8(v0[0], v0[1], v0[2], v0[3], v1[0], v1[1], v1[2], v1[3]);
                s += (v0[0] * v0[0] + v0[1] * v0[1]) + (v0[2] * v0[2] + v0[3] * v0[3]) + (v1[0] * v1[0] + v1[1] * v1[1]) + (v1[2] * v1[2] + v1[3] * v1[3]); }
            s += __shfl_xor(s, 16); s += __shfl_xor(s, 32);
            sj[j & 3] = s;
            if ((j & 3) == 3) { const float sv = fq == 0 ? sj[0] : (fq == 1 ? sj[1] : (fq == 2 ? sj[2] : sj[3]));
                __hip_atomic_fetch_add(ssq + tok0 + (j & ~3) + fq, sv, __ATOMIC_RELAXED, __HIP_MEMORY_SCOPE_AGENT); }
            __builtin_amdgcn_sched_barrier(0); }
    }
};

struct EpiFinal {
    static constexpr bool PERM = true, AFTER_DRAIN = false;
    const bf16* XB; float* out; float* ssq; unsigned* cnt; const float* gain;
    __device__ __forceinline__ void operator()(f32x4 (&acc)[2][2][4][2], const Unit& u, int wr, int wc, int fr, int fq) const {
        asm volatile("; epilogue-local lane coordinates" : "+v"(fr), "+v"(fq));
        const int tok0 = u.pm * 256 + (wr * 16 + fr) * 8, col0 = u.pn * 256 + 32 * wc + 8 * fq;
        float sj[4];
#pragma unroll
        for (int j = 0; j < 8; ++j) { const size_t ro = (size_t)(tok0 + j) * DM; float s = 0.f;
#pragma unroll
            for (int bj = 0; bj < 2; ++bj) { const int col = col0 + 128 * bj;
                const u32x4 xb = *(const u32x4*)(XB + ro + col);
                f32x4 v0, v1;
                v0[0] = __builtin_bit_cast(float, xb.x << 16); v0[1] = __builtin_bit_cast(float, xb.x & 0xffff0000u); v0[2] = __builtin_bit_cast(float, xb.y << 16); v0[3] = __builtin_bit_cast(float, xb.y & 0xffff0000u);
                v1[0] = __builtin_bit_cast(float, xb.z << 16); v1[1] = __builtin_bit_cast(float, xb.z & 0xffff0000u); v1[2] = __builtin_bit_cast(float, xb.w << 16); v1[3] = __builtin_bit_cast(float, xb.w & 0xffff0000u);
                v0 += acc[j >> 2][bj][j & 3][0]; v1 += acc[j >> 2][bj][j & 3][1];
                acc[j >> 2][bj][j & 3][0] = v0; acc[j >> 2][bj][j & 3][1] = v1;
                s += (v0[0] * v0[0] + v0[1] * v0[1]) + (v0[2] * v0[2] + v0[3] * v0[3]) + (v1[0] * v1[0] + v1[1] * v1[1]) + (v1[2] * v1[2] + v1[3] * v1[3]); }
            s += __shfl_xor(s, 16); s += __shfl_xor(s, 32);
            sj[j & 3] = s;
            if ((j & 3) == 3) { const float sv = fq == 0 ? sj[0] : (fq == 1 ? sj[1] : (fq == 2 ? sj[2] : sj[3]));
                __hip_atomic_fetch_add(ssq + tok0 + (j & ~3) + fq, sv, __ATOMIC_RELAXED, __HIP_MEMORY_SCOPE_AGENT); }
            __builtin_amdgcn_sched_barrier(0); }
        f32x4 gq[2][2];
#pragma unroll
        for (int bj = 0; bj < 2; ++bj) { gq[bj][0] = *(const f32x4*)(gain + col0 + 128 * bj); gq[bj][1] = *(const f32x4*)(gain + col0 + 128 * bj + 4); }
        asm volatile("s_waitcnt vmcnt(0)" ::: "memory");
        unsigned* c = cnt + 64 * u.pm;
        if (fq == 0 && fr == 0) {
            __hip_atomic_fetch_add(c, 1u, __ATOMIC_RELAXED, __HIP_MEMORY_SCOPE_AGENT);
            unsigned spins = 0;
            while (__hip_atomic_load(c, __ATOMIC_RELAXED, __HIP_MEMORY_SCOPE_AGENT) < 32u) { __builtin_amdgcn_s_sleep(2); if (++spins > (1u << 20)) break; }
        }
        asm volatile("" ::: "memory");
        float r[8];
#pragma unroll
        for (int j = 0; j < 8; ++j) { const float s = __hip_atomic_load(ssq + tok0 + j, __ATOMIC_RELAXED, __HIP_MEMORY_SCOPE_AGENT); r[j] = 1.0f / sqrtf(s * (1.0f / DM) + EPS); }
#pragma unroll
        for (int bj = 0; bj < 2; ++bj) { const int col = col0 + 128 * bj; const f32x4 g0 = gq[bj][0], g1 = gq[bj][1];
#pragma unroll
            for (int j = 0; j < 8; ++j) { const size_t ro = (size_t)(tok0 + j) * DM;
                *(f32x4*)(out + ro + col) = acc[j >> 2][bj][j & 3][0] * r[j] * g0; *(f32x4*)(out + ro + col + 4) = acc[j >> 2][bj][j & 3][1] * r[j] * g1; } }
    }
};

struct EpiConv {
    static constexpr bool PERM = true, AFTER_DRAIN = false;
    const float* ssq; const float* cw; const float* cbias; bf16* ACT; float* HB;
    __device__ __forceinline__ void operator()(const f32x4 (&acc)[2][2][4][2], const Unit& u, int wr, int wc, int fr, int fq) const {
        asm volatile("; epilogue-local lane coordinates" : "+v"(fr), "+v"(fq));
        const int tok0 = u.pm * 256 + (wr * 16 + fr) * 8, ca0 = u.pn * 128 + 32 * wc + 8 * fq;
        f32x4 wa[2][3], wb[2][3], ba[2], bb[2];
#pragma unroll
        for (int n = 0; n < 2; ++n) { const int ca = ca0 + 4 * n, cbn = DFF + ca;
#pragma unroll
            for (int tp = 0; tp < 3; ++tp) { wa[n][tp] = *(const f32x4*)(cw + tp * NUP + ca); wb[n][tp] = *(const f32x4*)(cw + tp * NUP + cbn); }
            ba[n] = *(const f32x4*)(cbias + ca); bb[n] = *(const f32x4*)(cbias + cbn); }
        float r[8]; row_scales<1>(ssq, tok0, r);
        const int grp = 2 * u.pm + wr;
        float* hp15 = HB + ((size_t)grp * 4) * NUP; float* hp0 = HB + ((size_t)grp * 4 + 2) * NUP;
        unsigned w[8][4];
#define EC_PAIR(V_) (ip ? __builtin_shufflevector(V_, V_, 2, 3) : __builtin_shufflevector(V_, V_, 0, 1))
#pragma unroll
        for (int n = 0; n < 2; ++n) { const int ca = ca0 + 4 * n, cbn = DFF + ca;
#pragma unroll
            for (int ip = 0; ip < 2; ++ip) {
                const f32x2 WA0 = EC_PAIR(wa[n][0]) * (-LOG2E), WA1 = EC_PAIR(wa[n][1]) * (-LOG2E), WA2 = EC_PAIR(wa[n][2]) * (-LOG2E), BA = EC_PAIR(ba[n]) * (-LOG2E);
                const f32x2 WB0 = EC_PAIR(wb[n][0]) * (-LN2), WB1 = EC_PAIR(wb[n][1]) * (-LN2), WB2 = EC_PAIR(wb[n][2]) * (-LN2), BB = EC_PAIR(bb[n]) * (-LN2);
                f32x2 HA[8], HBv[8];
#pragma unroll
                for (int j = 0; j < 8; ++j) { HA[j] = EC_PAIR(acc[j >> 2][0][j & 3][n]) * r[j]; HBv[j] = EC_PAIR(acc[j >> 2][1][j & 3][n]) * r[j]; }
                const f32x2 PA6 = {dpp_f<0x111>(HA[6][0]), dpp_f<0x111>(HA[6][1])}, PA7 = {dpp_f<0x111>(HA[7][0]), dpp_f<0x111>(HA[7][1])};
                const f32x2 PB6 = {dpp_f<0x111>(HBv[6][0]), dpp_f<0x111>(HBv[6][1])}, PB7 = {dpp_f<0x111>(HBv[7][0]), dpp_f<0x111>(HBv[7][1])};
                const int i0 = 2 * ip;
                if (fr == 15) { *(f32x2*)(hp15 + ca + i0) = HA[6]; *(f32x2*)(hp15 + cbn + i0) = HBv[6]; *(f32x2*)(hp15 + NUP + ca + i0) = HA[7]; *(f32x2*)(hp15 + NUP + cbn + i0) = HBv[7]; }
                if (fr == 0) { *(f32x2*)(hp0 + ca + i0) = HA[0]; *(f32x2*)(hp0 + cbn + i0) = HBv[0]; *(f32x2*)(hp0 + NUP + ca + i0) = HA[1]; *(f32x2*)(hp0 + NUP + cbn + i0) = HBv[1]; }
#pragma unroll
                for (int j = 0; j < 8; ++j) {
                    const f32x2 AM1 = j >= 1 ? HA[j >= 1 ? j - 1 : 0] : PA7, AM2 = j >= 2 ? HA[j >= 2 ? j - 2 : 0] : (j == 1 ? PA7 : PA6);
                    const f32x2 BM1 = j >= 1 ? HBv[j >= 1 ? j - 1 : 0] : PB7, BM2 = j >= 2 ? HBv[j >= 2 ? j - 2 : 0] : (j == 1 ? PB7 : PB6);
                    const f32x2 YA = BA + WA2 * HA[j] + WA1 * AM1 + WA0 * AM2, YB = BB + WB2 * HBv[j] + WB1 * BM1 + WB0 * BM2;
                    const f32x2 E = {fexp2(YA[0]), fexp2(YA[1])};
                    const f32x2 D = E + 1.f;
                    const f32x2 R = {frcp(D[0]), frcp(D[1])};
                    const f32x2 O = (YA * YB) * R;
                    w[j][2 * n + ip] = cvt_pk(O[0], O[1]);
                }
                __builtin_amdgcn_sched_barrier(0);
            }
        }
#undef EC_PAIR
#pragma unroll
        for (int j = 0; j < 8; ++j) if (!(fr == 0 && j < 2)) { u32x4 v; v.x = w[j][0]; v.y = w[j][1]; v.z = w[j][2]; v.w = w[j][3]; *(u32x4*)(ACT + (size_t)(tok0 + j) * DFF + ca0) = v; }
    }
};

struct EpiHg {
    static constexpr bool PERM = true, AFTER_DRAIN = false;
    unsigned char* ws; const float* hlb;
    __device__ __forceinline__ void operator()(const f32x4 (&acc)[2][2][4][2], const Unit& u, int wr, int wc, int fr, int fq) const {
        asm volatile("; epilogue-local lane coordinates" : "+v"(fr), "+v"(fq));
        const int tok0 = u.pm * 256 + (wr * 16 + fr) * 8, b = tok0 >> 11, s0 = tok0 & 2047, pn = u.pn;
        float r[8]; row_scales<1>((const float*)(ws + WS_SSQA) + M, tok0, r);
        const int cb = 32 * wc + 8 * fq;
        if (pn < 8) {
            bf16* const QM = (bf16*)(ws + WS_QM); bf16* const KM = (bf16*)(ws + WS_KM); bf16* const KMT = (bf16*)(ws + WS_KMT); float* const EB = (float*)(ws + WS_EB); float* const FAC = (float*)(ws + WS_FAC);
            const int h = pn, chunk = s0 >> 6, lane = fq * 16 + fr, f7 = fr & 7;
            float lb8[8];
            { const f32x4 l1a = *(const f32x4*)(hlb + 1024 + h * 128 + cb), l1b = *(const f32x4*)(hlb + 1024 + h * 128 + cb + 4), l0a = *(const f32x4*)(hlb + h * 128 + cb), l0b = *(const f32x4*)(hlb + h * 128 + cb + 4);
#pragma unroll
              for (int i = 0; i < 4; ++i) { lb8[i] = fsigmoid(l1a[i] - l0a[i]); lb8[4 + i] = fsigmoid(l1b[i] - l0b[i]); } }
            unsigned wq[8][4], wk[8][4];
            float rf[8];
#pragma unroll
            for (int j = 0; j < 8; ++j) rf[j] = r[j] * (-LOG2E);
#define HG_PAIR(V_) (ip ? __builtin_shufflevector(V_, V_, 2, 3) : __builtin_shufflevector(V_, V_, 0, 1))
#pragma unroll
            for (int n = 0; n < 2; ++n) {
#pragma unroll
                for (int ip = 0; ip < 2; ++ip) { const int d0 = cb + 4 * n + 2 * ip;
                    const f32x2 LB = {lb8[4 * n + 2 * ip], lb8[4 * n + 2 * ip + 1]}, OML = 1.f - LB;
                    f32x2 BC[8], KK[8], QS[8], RUN = {0.f, 0.f};
#pragma unroll
                    for (int j = 0; j < 8; ++j) { const f32x2 QV = HG_PAIR(acc[j >> 2][0][j & 3][n]) * r[j], FE = HG_PAIR(acc[j >> 2][1][j & 3][n]) * rf[j];
                        const f32x2 E1 = {fexp2(FE[0]), fexp2(FE[1])}, D1 = E1 + 1.f;
                        const f32x2 SG = {frcp(D1[0]), frcp(D1[1])};
                        const f32x2 G = LB + OML * SG;
                        const f32x2 LG = {__builtin_amdgcn_logf(G[0]), __builtin_amdgcn_logf(G[1])};
                        RUN = RUN + LG; BC[j] = RUN; KK[j] = OML - OML * SG;
                        const f32x2 QE = QV * (-LOG2E);
                        const f32x2 E2 = {fexp2(QE[0]), fexp2(QE[1])}, D2 = E2 + 1.f;
                        const f32x2 RQ = {frcp(D2[0]), frcp(D2[1])};
                        QS[j] = QV * RQ; }
                    f32x2 EXCL, BREF;
#pragma unroll
                    for (int e = 0; e < 2; ++e) { const float run = RUN[e]; float xs = run, t;
                        t = dpp_f<0x111>(xs); if (f7 >= 1) xs += t;
                        t = dpp_f<0x112>(xs); if (f7 >= 2) xs += t;
                        t = dpp_f<0x114>(xs); if (f7 >= 4) xs += t;
                        const float excl = xs - run, bl = __shfl(xs, (lane & ~7) + 7), bref = __shfl(xs, (lane & ~7) + 3);
                        EXCL[e] = excl; BREF[e] = bref;
                        const int lam = swap23(d0 + e);
                        if (f7 == 0) { const size_t o = ((size_t)((b * 32 + chunk) * 8 + h)) * 128 + lam; EB[o] = fexp2(bref); FAC[o] = fexp2(bl - bref); } }
#pragma unroll
                    for (int j = 0; j < 8; ++j) { const f32x2 BB = EXCL + BC[j], DQ = BB - BREF, DK = BREF - BB;
                        const f32x2 XQ = {fexp2(fminf(DQ[0], 80.f * LOG2E)), fexp2(fminf(DQ[1], 80.f * LOG2E))}, XK = {fexp2(fminf(DK[0], 80.f * LOG2E)), fexp2(fminf(DK[1], 80.f * LOG2E))};
                        QS[j] = QS[j] * XQ; KK[j] = KK[j] * XK;
                        wq[j][2 * n + ip] = cvt_pk(QS[j][0], QS[j][1]); wk[j][2 * n + ip] = cvt_pk(KK[j][0], KK[j][1]); }
#pragma unroll
                    for (int e = 0; e < 2; ++e) { const int lam = swap23(d0 + e);
                        bf16* base = KMT + (size_t)(b * 8 + h) * (128 * 2048) + frag_off(lam, (s0 & ~15) + 4 * ((s0 >> 3) & 1), 2048);
                        *(u32x2*)base = pack4(KK[0][e], KK[1][e], KK[2][e], KK[3][e]); *(u32x2*)(base + 256) = pack4(KK[4][e], KK[5][e], KK[6][e], KK[7][e]); }
                    __builtin_amdgcn_sched_barrier(0);
                }
            }
#undef HG_PAIR
            { const size_t o0 = (size_t)(b * 8 + h) * (2048 * 128) + frag_off(s0, cb, 128);
#pragma unroll
              for (int j = 0; j < 8; ++j) { u32x4 a; a.x = wq[j][0]; a.y = wq[j][1]; a.z = wq[j][2]; a.w = wq[j][3]; u32x4 c; c.x = wk[j][0]; c.y = wk[j][1]; c.z = wk[j][2]; c.w = wk[j][3];
                  *(u32x4*)(QM + o0 + 8 * j) = a; *(u32x4*)(KM + o0 + 8 * j) = c; } }
        } else if (pn < 12) {
            bf16* const IT = (bf16*)(ws + WS_IT);
#pragma unroll
            for (int bj = 0; bj < 2; ++bj) { const int col = (pn - 8) * 256 + 128 * bj + cb;
#pragma unroll
                for (int n = 0; n < 2; ++n)
#pragma unroll
                    for (int i = 0; i < 4; ++i) {
                        const int ci = col + 4 * n + i;
                        bf16* base = IT + (size_t)(b * 8 + (ci >> 7)) * (128 * 2048) + frag_off(ci & 127, (s0 & ~15) + 4 * ((s0 >> 3) & 1), 2048);
                        *(u32x2*)base = pack4(ACC(0, bj, n, i) * r[0], ACC(1, bj, n, i) * r[1], ACC(2, bj, n, i) * r[2], ACC(3, bj, n, i) * r[3]);
                        *(u32x2*)(base + 256) = pack4(ACC(4, bj, n, i) * r[4], ACC(5, bj, n, i) * r[5], ACC(6, bj, n, i) * r[6], ACC(7, bj, n, i) * r[7]);
                        __builtin_amdgcn_sched_barrier(0); } }
        } else {
            bf16* const GATE = (bf16*)(ws + WS_GATE);
#pragma unroll
            for (int bj = 0; bj < 2; ++bj) { const int col = (pn - 12) * 256 + 128 * bj + cb;
#pragma unroll
                for (int j = 0; j < 8; ++j) { const f32x4 a0 = acc[j >> 2][bj][j & 3][0], a1 = acc[j >> 2][bj][j & 3][1]; const float rj = r[j], rfj = rj * (-LOG2E);
                    const f32x2 p0 = __builtin_shufflevector(a0, a0, 0, 1), p1 = __builtin_shufflevector(a0, a0, 2, 3), p2 = __builtin_shufflevector(a1, a1, 0, 1), p3 = __builtin_shufflevector(a1, a1, 2, 3);
                    const f32x2 o0 = fsilu2(p0 * rj, p0 * rfj), o1 = fsilu2(p1 * rj, p1 * rfj), o2 = fsilu2(p2 * rj, p2 * rfj), o3 = fsilu2(p3 * rj, p3 * rfj);
                    *(bf16x8*)(GATE + (size_t)(tok0 + j) * 1024 + col) = pack8(o0[0], o0[1], o1[0], o1[1], o2[0], o2[1], o3[0], o3[1]);
                    __builtin_amdgcn_sched_barrier(0); } }
        }
    }
};

#define XB_TMO      128
#define XB_XCNT(j)  (256  + 64 * (j))
#define XB_XSUB(j)  (1280 + 64 * (j))
#define XB_XGEN(j)  (2304 + 64 * (j))
#define XB_TOP      3328
#define XB_TOPGEN   3392
#define XCD_BAR_WORDS 3456
#define XB_SPIN_CAP (1u << 18)
__device__ __forceinline__ unsigned xb_ld(unsigned* p)              { return __hip_atomic_load(p, __ATOMIC_RELAXED, __HIP_MEMORY_SCOPE_AGENT); }
__device__ __forceinline__ unsigned xb_add(unsigned* p, unsigned v) { return __hip_atomic_fetch_add(p, v, __ATOMIC_RELAXED, __HIP_MEMORY_SCOPE_AGENT); }
__device__ __forceinline__ unsigned xb_xcc_id() { return (unsigned)__builtin_amdgcn_s_getreg((3 << 11) | 20) & 0xFu; }
#define XB_SPIN(cond, bar) do { unsigned _sp = 0; while (cond) { __builtin_amdgcn_s_sleep(1); \
    if ((++_sp & 255u) == 0u) { if (xb_ld(&(bar)[XB_TMO])) break; if (_sp > XB_SPIN_CAP) { atomicAdd(&(bar)[XB_TMO], 1u); break; } } } } while (0)
struct XcdBarrier { unsigned* bar; unsigned x; volatile LAS unsigned* st; };
__device__ __forceinline__ XcdBarrier xcd_barrier_post(unsigned* bar, volatile LAS unsigned* st, bool t0) {
    XcdBarrier b; b.bar = bar; b.x = xb_xcc_id(); b.st = st;
    if (t0) (void)xb_add(&bar[XB_XCNT(b.x)], 1u);
    return b;
}
__device__ __forceinline__ void xcd_barrier_complete(unsigned* bar, unsigned x, unsigned& nloc, unsigned& nx) {
    const unsigned G = gridDim.x * gridDim.y * gridDim.z;
    unsigned sum, cnt, mine, sp = 0u;
    for (;;) {
        sum = 0u; cnt = 0u; mine = 0u;
#pragma unroll
        for (unsigned j = 0; j < 16; ++j) { const unsigned c = xb_ld(&bar[XB_XCNT(j)]); sum += c; cnt += (c > 0u) ? 1u : 0u; mine = (j == x) ? c : mine; }
        if (sum == G) break;
        __builtin_amdgcn_s_sleep(1);
        if ((++sp & 255u) == 0u) { if (xb_ld(&bar[XB_TMO])) break; if (sp > XB_SPIN_CAP) { atomicAdd(&bar[XB_TMO], 1u); break; } }
    }
    nloc = mine > 0u ? mine : 1u; nx = cnt > 0u ? cnt : 1u;
}
__device__ __forceinline__ void xcd_barrier(const XcdBarrier& b, bool t0) {
    asm volatile("s_waitcnt vmcnt(0)" ::: "memory");
    __syncthreads();
    if (t0) {
        unsigned* bar = b.bar;
        __builtin_amdgcn_s_waitcnt(0);
        unsigned nloc = b.st[0], nx = b.st[1];
        if (nloc == 0u) { xcd_barrier_complete(bar, b.x, nloc, nx); b.st[0] = nloc; b.st[1] = nx; }
        const unsigned old = xb_add(&bar[XB_XSUB(b.x)], 1u);
        const unsigned gen = old / nloc;
        if (old + 1u == (gen + 1u) * nloc) {
            __builtin_amdgcn_fence(__ATOMIC_RELEASE, "agent");
            asm volatile("s_waitcnt vmcnt(0)" ::: "memory");
            const unsigned og = xb_add(&bar[XB_TOP], 1u);
            const unsigned tg = og / nx;
            if (og + 1u == (tg + 1u) * nx) xb_add(&bar[XB_TOPGEN], 1u);
            else XB_SPIN(xb_ld(&bar[XB_TOPGEN]) == tg, bar);
            __builtin_amdgcn_fence(__ATOMIC_ACQUIRE, "agent");
            xb_add(&bar[XB_XGEN(b.x)], 1u);
            asm volatile("s_waitcnt vmcnt(0)" ::: "memory");
        } else {
            XB_SPIN(xb_ld(&bar[XB_XGEN(b.x)]) == gen, bar);
            __builtin_amdgcn_fence(__ATOMIC_ACQUIRE, "agent");
            asm volatile("s_waitcnt vmcnt(0)" ::: "memory");
        }
    }
    __syncthreads();
}

__device__ __forceinline__ void conv_item(const float* W, int K, int N, int src0, int nvalid, const float* gain, bf16* WT, int dst_row0, int kb, LAS float* scr, int lane) {
    const int k0 = 64 * kb, cl = lane & 31;
#pragma unroll 8
    for (int i = 0; i < 32; ++i) { const int kk = 2 * i + (lane >> 5); float v = 0.f; if (cl < nvalid) { v = W[(size_t)(k0 + kk) * N + src0 + cl]; if (gain) v *= gain[k0 + kk]; } scr[kk * 33 + cl] = v; }
    asm volatile("s_waitcnt lgkmcnt(0)" ::: "memory");
    const int c = lane & 7;
#pragma unroll
    for (int j = 0; j < 4; ++j) { const int n = (lane >> 3) + 8 * j; const LAS float* s = scr + (8 * c) * 33 + n;
        u32x4 o; o.x = cvt_pk(s[0 * 33], s[1 * 33]); o.y = cvt_pk(s[2 * 33], s[3 * 33]); o.z = cvt_pk(s[4 * 33], s[5 * 33]); o.w = cvt_pk(s[6 * 33], s[7 * 33]);
        *(u32x4*)(WT + (size_t)(dst_row0 + n) * K + k0 + 8 * c) = o; }
    asm volatile("s_waitcnt lgkmcnt(0)" ::: "memory");
}
__device__ __forceinline__ void map_ab(int nb, int& src, int& nv) {
    nv = 32;
    if (nb < 80) src = 32 * nb;
    else if (nb < 96) src = 2640 + 32 * (nb - 80);
    else if (nb < 112) src = 3152 + 32 * (nb - 96);
    else { const int t = nb - 112; if (t == 0) src = 2560; else if (t == 1) { src = 2624; nv = 16; } else if (t == 4) src = 2592; else { src = 0; nv = 0; } }
}
__device__ __forceinline__ int map_up(int nb) { const int pn = nb >> 3, t = nb & 7; return (t < 4 ? 0 : DFF) + 128 * pn + 32 * (t & 3); }
__device__ __forceinline__ int map_ci(int nb) { if (nb < 64) { const int h = nb >> 3, t = nb & 7; return (t < 4 ? 0 : 1024) + 128 * h + 32 * (t & 3); } return 32 * nb; }

template <int MAT> __device__ __forceinline__ void conv64_item(const float* W, int K, int N, const float* gain, bf16* WT, int kb, int nt, int lane) {
    const int n = 128 * nt + 2 * lane, nb = n >> 5, wi = n & 31;
    int src = 32 * nb, nv = 32;
    if (MAT == 0) map_ab(nb, src, nv); else if (MAT == 1) src = map_up(nb); else if (MAT == 2) src = map_ci(nb);
    const bool valid = wi < nv;
    const float* wp = W + (size_t)(64 * kb) * N + src + wi;
    f32x2 v[64];
#pragma unroll
    for (int kk = 0; kk < 64; ++kk) v[kk] = valid ? __builtin_nontemporal_load((const f32x2*)(wp + (size_t)kk * N)) : (f32x2){0.f, 0.f};
    if (gain) {
#pragma unroll
        for (int k4 = 0; k4 < 16; ++k4) { const f32x4 g = *(const f32x4*)(gain + 64 * kb + 4 * k4);
#pragma unroll
            for (int i = 0; i < 4; ++i) v[4 * k4 + i] = v[4 * k4 + i] * g[i]; }
    }
    bf16* op = WT + (size_t)n * K + 64 * kb;
#pragma unroll
    for (int i = 0; i < 2; ++i)
#pragma unroll
        for (int k8 = 0; k8 < 8; ++k8)
            *(bf16x8*)(op + (size_t)i * K + 8 * k8) = pack8(v[8 * k8][i], v[8 * k8 + 1][i], v[8 * k8 + 2][i], v[8 * k8 + 3][i], v[8 * k8 + 4][i], v[8 * k8 + 5][i], v[8 * k8 + 6][i], v[8 * k8 + 7][i]);
}
template <int GRP> __device__ __forceinline__ void convert_weights(const Params& p, int gw, int NGW, int lane) {
    unsigned char* ws = p.ws;
    constexpr int I_AB = 16 * 30, I_ABO = 16 * 8, I_CI = 16 * 32, I_CO = 16 * 8, I_UP = 16 * 44, I_DN = 44 * 8;
    if (GRP == 0) {
#pragma unroll 1
        for (int r = gw; r < I_AB; r += NGW) conv64_item<0>(p.ab_w_in, 1024, 3664, p.mix_norm, (bf16*)(ws + WS_WAB), r / 30, r % 30, lane);
    } else if (GRP == 1) {
#pragma unroll 1
        for (int it = gw; it < I_ABO + I_UP + I_DN; it += NGW) { int r = it;
            if (r < I_ABO) { conv64_item<3>(p.ab_w_out, 1024, 1024, nullptr, (bf16*)(ws + WS_WABO), r / 8, r % 8, lane); continue; } r -= I_ABO;
            if (r < I_UP) { conv64_item<1>(p.ffn_w_up, 1024, NUP, p.ffn_norm, (bf16*)(ws + WS_WUP0), r / 44, r % 44, lane); continue; } r -= I_UP;
            conv64_item<3>(p.ffn_w_down, DFF, 1024, nullptr, (bf16*)(ws + WS_WDN0), r / 8, r % 8, lane); }
    } else {
#pragma unroll 1
        for (int it = gw; it < I_CI + I_CO + I_UP + I_DN; it += NGW) { int r = it;
            if (r < I_CI) { conv64_item<2>(p.c_w_in, 1024, 4096, p.mix_norm + 1024, (bf16*)(ws + WS_WCI), r / 32, r % 32, lane); continue; } r -= I_CI;
            if (r < I_CO) { conv64_item<3>(p.c_w_out, 1024, 1024, nullptr, (bf16*)(ws + WS_WCO), r / 8, r % 8, lane); continue; } r -= I_CO;
            if (r < I_UP) { conv64_item<1>(p.ffn_w_up + (size_t)1024 * NUP, 1024, NUP, p.ffn_norm + 1024, (bf16*)(ws + WS_WUP1), r / 44, r % 44, lane); continue; } r -= I_UP;
            conv64_item<3>(p.ffn_w_down + (size_t)DFF * 1024, DFF, 1024, nullptr, (bf16*)(ws + WS_WDN1), r / 8, r % 8, lane); }
    }
}
__device__ __forceinline__ void p0_prologue(const Params& p, LAS unsigned char* lds, int wave, int lane) {
    unsigned char* ws = p.ws;
    const int gw = blockIdx.x * NWAVES + wave, NGW = gridDim.x * NWAVES;
    convert_weights<0>(p, gw, NGW, lane);
    if (gridDim.x != 256) { convert_weights<1>(p, gw, NGW, lane); convert_weights<2>(p, gw, NGW, lane); }
    bf16* XB = (bf16*)(ws + WS_XB); float* SSQ0 = (float*)(ws + WS_SSQ0);
    for (int m0 = gw; m0 < M; m0 += 4 * NGW) {
        f32x4 v[4][4];
#pragma unroll
        for (int r = 0; r < 4; ++r) { const int mr = m0 + r * NGW; const f32x4* xr = (const f32x4*)(p.x + (size_t)(mr < M ? mr : m0) * DM) + 2 * lane;
#pragma unroll
            for (int j = 0; j < 4; ++j) v[r][j] = __builtin_nontemporal_load(xr + 128 * (j >> 1) + (j & 1)); }
#pragma unroll
        for (int r = 0; r < 4; ++r) { const int m = m0 + r * NGW;
            if (m < M) {
                float s = 0.f;
#pragma unroll
                for (int j = 0; j < 4; ++j) s += (v[r][j][0] * v[r][j][0] + v[r][j][1] * v[r][j][1]) + (v[r][j][2] * v[r][j][2] + v[r][j][3] * v[r][j][3]);
                s = wave_sum(s);
                bf16x8* o = (bf16x8*)(XB + (size_t)m * DM) + lane;
#pragma unroll
                for (int h = 0; h < 2; ++h) o[64 * h] = pack8(v[r][2 * h][0], v[r][2 * h][1], v[r][2 * h][2], v[r][2 * h][3], v[r][2 * h + 1][0], v[r][2 * h + 1][1], v[r][2 * h + 1][2], v[r][2 * h + 1][3]);
                if (lane == 0) SSQ0[m] = s;
            }
        }
    }
}

__device__ __forceinline__ void gmlp_unit(const Params& p, LAS unsigned char* lds, int unit, int wave, int lane_in) {
    unsigned char* ws = p.ws;
    const int lane = lane_now();
    (void)lane_in;
    const int b = unit >> 5, nblk = (unit >> 1) & 15, T0 = b * 2048 + 128 * nblk, tid = wave * 64 + lane, hh = lane >> 5, l31 = lane & 31, g = 4 * (unit & 1) + (wave & 3);
    LAS float* R = (LAS float*)lds;
    const float* SSQV = (const float*)(ws + WS_SSQV);
    const bf16* U = (const bf16*)(ws + WS_U);
    u32x2 uu[2][2][4]; f32x4 gnv[2][4]; float bsv[2];
#define GM_EPI_LOAD() do { const int ln_ = lane_now(), hq_ = ln_ >> 5, lq_ = ln_ & 31;     \
    _Pragma("unroll") for (int il = 0; il < 2; ++il) { const int i = 32 * (2 * (wave >> 2) + il) + lq_; bsv[il] = p.ab_b_s[g * 128 + i]; \
        _Pragma("unroll") for (int ct = 0; ct < 2; ++ct) _Pragma("unroll") for (int q4 = 0; q4 < 4; ++q4) uu[il][ct][q4] = *(const u32x2*)(U + (size_t)(T0 + i) * 512 + 64 * g + 32 * ct + 8 * q4 + 4 * hq_); } \
    _Pragma("unroll") for (int ct = 0; ct < 2; ++ct) _Pragma("unroll") for (int q4 = 0; q4 < 4; ++q4) gnv[ct][q4] = *(const f32x4*)(p.ab_gmlp_norm + 64 * g + 32 * ct + 8 * q4 + 4 * hq_); } while (0)
    const bf16* VGT = (const bf16*)(ws + WS_VGT);
    const int itp = wave >> 2, nks = itp == 0 ? 4 : 8;
    const float* Wg = p.ab_w_s + (size_t)g * 128 * 128;
    bf16x8 Ab[3][2]; f32x4 Wb[3][2][2];
#define GM_LOAD(SLOT_, KS_) do { \
        _Pragma("unroll") for (int ct = 0; ct < 2; ++ct) Ab[SLOT_][ct] = *(const bf16x8*)(VGT + (size_t)b * (512 * 2048) + frag_off(64 * g + 32 * ct + l31, 128 * nblk + 16 * (KS_) + 8 * hh, 2048)); \
        _Pragma("unroll") for (int il = 0; il < 2; ++il) { const float* wr_ = Wg + (size_t)(32 * (2 * itp + il) + l31) * 128 + 16 * (KS_) + 4 * hh; \
            Wb[SLOT_][il][0] = *(const f32x4*)wr_; Wb[SLOT_][il][1] = *(const f32x4*)(wr_ + 8); } } while (0)
    f32x4 sqa_ = {0.f, 0.f, 0.f, 0.f}, sqc_ = {0.f, 0.f, 0.f, 0.f};
    if (tid < 128) { sqa_ = *(const f32x4*)(SSQV + (size_t)(T0 + tid) * 8); sqc_ = *(const f32x4*)(SSQV + (size_t)(T0 + tid) * 8 + 4); }
    GM_LOAD(0, 0); GM_LOAD(1, 1); GM_LOAD(2, 2);
    asm volatile("" : "+v"(sqa_), "+v"(sqc_));
    if (tid < 128) R[tid] = 1.0f / sqrtf(((sqa_[0] + sqa_[1]) + (sqa_[2] + sqa_[3]) + (sqc_[0] + sqc_[1]) + (sqc_[2] + sqc_[3])) * (1.0f / 512.0f) + EPS);
    __syncthreads();
    bf16* Y = (bf16*)(ws + WS_Y);
    {
        f32x16 acc[2][2];
#pragma unroll
        for (int ct = 0; ct < 2; ++ct)
#pragma unroll
            for (int il = 0; il < 2; ++il)
#pragma unroll
                for (int q = 0; q < 16; ++q) acc[ct][il][q] = 0.f;
#define GM_STEP(KS_) do { const int ja = 16 * (KS_) + 4 * hh;                  \
            const f32x4 r0 = *(const LAS f32x4*)(R + ja), r1 = *(const LAS f32x4*)(R + ja + 8); \
            _Pragma("unroll") for (int il = 0; il < 2; ++il) { \
                const f32x4 w0 = Wb[(KS_) % 3][il][0] * r0, w1 = Wb[(KS_) % 3][il][1] * r1; \
                const bf16x8 B = pack8(w0[0], w0[1], w0[2], w0[3], w1[0], w1[1], w1[2], w1[3]); \
                _Pragma("unroll") for (int ct = 0; ct < 2; ++ct) { acc[ct][il] = MFMA32(Ab[(KS_) % 3][ct], B, acc[ct][il]); \
                    asm volatile("; operands stay live past the MFMA: a fresh destination must not be allocated over them" : "+v"(acc[ct][il]) : "v"(Ab[(KS_) % 3][ct]), "v"(B)); } } } while (0)
        if (nks == 8) {
            GM_STEP(0); GM_LOAD(0, 3); GM_STEP(1); GM_LOAD(1, 4); GM_STEP(2); GM_LOAD(2, 5); GM_STEP(3); GM_LOAD(0, 6); GM_STEP(4); GM_LOAD(1, 7);
            GM_STEP(5); GM_EPI_LOAD(); GM_STEP(6); GM_STEP(7);
        } else { GM_STEP(0); GM_LOAD(0, 3); GM_STEP(1); GM_STEP(2); GM_EPI_LOAD(); GM_STEP(3); }
#undef GM_STEP
#undef GM_LOAD
#undef GM_EPI_LOAD
#pragma unroll
        for (int il = 0; il < 2; ++il) { const int le_ = lane_now(), he_ = le_ >> 5; const int i = 32 * (2 * itp + il) + (le_ & 31), tok = T0 + i; const float bs = bsv[il];
#pragma unroll
            for (int ct = 0; ct < 2; ++ct) { u32x2 X[4];
#pragma unroll
                for (int q4 = 0; q4 < 4; ++q4) {
                    const f32x4 gn = gnv[ct][q4];
                    const u32x2 ux = uu[il][ct][q4];
                    const float u0 = __builtin_bit_cast(float, ux.x << 16), u1 = __builtin_bit_cast(float, ux.x & 0xffff0000u), u2 = __builtin_bit_cast(float, ux.y << 16), u3 = __builtin_bit_cast(float, ux.y & 0xffff0000u);
                    X[q4] = pack4(u0 * (acc[ct][il][4 * q4 + 0] * gn[0] + bs), u1 * (acc[ct][il][4 * q4 + 1] * gn[1] + bs), u2 * (acc[ct][il][4 * q4 + 2] * gn[2] + bs), u3 * (acc[ct][il][4 * q4 + 3] * gn[3] + bs)); }
#pragma unroll
                for (int qp = 0; qp < 2; ++qp) {
                    const u32x2 sx = __builtin_amdgcn_permlane32_swap(X[2 * qp].x, X[2 * qp + 1].x, false, false), sy = __builtin_amdgcn_permlane32_swap(X[2 * qp].y, X[2 * qp + 1].y, false, false);
                    const u32x4 v = {sx[0], sy[0], sx[1], sy[1]};
                    *(u32x4*)(Y + (size_t)tok * 1024 + 512 + 64 * g + 32 * ct + 8 * (2 * qp + he_)) = v; } } }
    }
    __syncthreads();
}

template <int CTRL, int RM> __device__ __forceinline__ int dpp_i(int v) { return __builtin_amdgcn_update_dpp(0, v, CTRL, RM, 0xF, false); }
__device__ __forceinline__ void half_sums(int v, int& s0, int& s1) {
    v += dpp_i<0x111, 0xF>(v); v += dpp_i<0x112, 0xF>(v); v += dpp_i<0x114, 0xF>(v); v += dpp_i<0x118, 0xF>(v);
    v += dpp_i<0x142, 0xA>(v);
    s0 = __builtin_amdgcn_readlane(v, 31); s1 = __builtin_amdgcn_readlane(v, 63);
}
__device__ __forceinline__ int count_ge_all(const LAS unsigned* SC, int n8, unsigned cand, int lane) {
    int cnt = 0;
#pragma unroll 1
    for (int i = 0; i < n8; i += 8) { unsigned u8[8];
#pragma unroll
        for (int k = 0; k < 8; ++k) u8[k] = SC[(i + k) * 64 + lane];
#pragma unroll
        for (int k = 0; k < 8; ++k) asm volatile("v_cmp_ge_u32 vcc, %1, %2\n\tv_addc_co_u32 %0, vcc, 0, %0, vcc" : "+v"(cnt) : "v"(u8[k]), "v"(cand) : "vcc"); }
    return cnt;
}
__device__ __forceinline__ void indexer_select(const Params& p, LAS unsigned* SC, LAS unsigned* LIST, int tq0, int c, int lane) {
    unsigned long long* SEL = (unsigned long long*)(p.ws + WS_SEL);
    const int hh = lane >> 5, n32 = 2 * (c + 1);
    const int n8 = (n32 + 7) & ~7;
    for (int kt = n32; kt < n8; ++kt) SC[kt * 64 + lane] = 0u;
    unsigned T0 = 0u, T1 = 0u; bool ex0 = false, ex1 = false;
    const int ng = n8 >> 3;
    unsigned H[8][4];
#pragma unroll
    for (int g = 0; g < 8; ++g)
        if (g < ng) {
#pragma unroll
            for (int k2 = 0; k2 < 4; ++k2) { const unsigned a = SC[(8 * g + 2 * k2) * 64 + lane], b2 = SC[(8 * g + 2 * k2 + 1) * 64 + lane]; H[g][k2] = (a >> 16) | (b2 & 0xFFFF0000u); }
        } else {
#pragma unroll
            for (int k2 = 0; k2 < 4; ++k2) H[g][k2] = 0u;
        }
#pragma unroll 1
    for (int bit = 31; bit >= 16; --bit) {
        const unsigned c0 = ex0 ? T0 : (T0 | (1u << bit)), c1 = ex1 ? T1 : (T1 | (1u << bit));
        const unsigned cm = ((hh ? c1 : c0) >> 16) - 1u, CM = cm | (cm << 16);
        unsigned acc = 0u;
#pragma unroll
        for (int g = 0; g < 8; ++g)
            if (g < ng) {
#pragma unroll
                for (int k2 = 0; k2 < 4; ++k2) { unsigned d_;
                    asm("v_pk_sub_u16 %0, %1, %2 clamp" : "=v"(d_) : "v"(H[g][k2]), "v"(CM));
                    asm("v_pk_min_u16 %0, %1, %2" : "=v"(d_) : "v"(d_), "v"(0x00010001u));
                    asm("v_pk_add_u16 %0, %1, %2" : "=v"(acc) : "v"(acc), "v"(d_)); }
            }
        int n0, n1; half_sums((int)((acc & 0xFFFFu) + (acc >> 16)), n0, n1);
        if (!ex0 && n0 >= 256) { T0 = c0; ex0 = (n0 == 256); }
        if (!ex1 && n1 >= 256) { T1 = c1; ex1 = (n1 == 256); }
        if (ex0 && ex1) break;
    }
    int need0 = 0, need1 = 0;
    if (!(ex0 && ex1)) {
        const unsigned Tl = hh ? T1 : T0;
#pragma unroll
        for (int s = 0; s < 5; ++s) LIST[s * 64 + lane] = 0u;
        int m = 0, cge = 0;
#pragma unroll 1
        for (int i = 0; i < n8; i += 8) { unsigned u8[8];
#pragma unroll
            for (int k = 0; k < 8; ++k) u8[k] = SC[(i + k) * 64 + lane];
#pragma unroll
            for (int k = 0; k < 8; ++k) { const unsigned d = u8[k] - Tl; cge += (u8[k] >= Tl) ? 1 : 0;
                if (u8[k] >= Tl && d < (1u << 16)) { if (m < 5) LIST[m * 64 + lane] = u8[k]; ++m; } } }
        int ge0, ge1, mb0, mb1; half_sums(cge, ge0, ge1); half_sums(m, mb0, mb1);
        const int G0 = ge0 - mb0, G1 = ge1 - mb1;
        const bool overflow = __ballot(m > 5) != 0ull;
        unsigned v[5];
#pragma unroll
        for (int s = 0; s < 5; ++s) v[s] = LIST[s * 64 + lane];
#pragma unroll 1
        for (int bit = 15; bit >= 0; --bit) {
            const unsigned c0 = ex0 ? T0 : (T0 | (1u << bit)), c1 = ex1 ? T1 : (T1 | (1u << bit));
            const unsigned cand = hh ? c1 : c0;
            int n0, n1;
            if (overflow) half_sums(count_ge_all(SC, n8, cand, lane), n0, n1);
            else { int cnt = 0;
#pragma unroll
                for (int s = 0; s < 5; ++s) cnt += (v[s] >= cand) ? 1 : 0;
                half_sums(cnt, n0, n1); n0 += G0; n1 += G1; }
            if (!ex0 && n0 >= 256) { T0 = c0; ex0 = (n0 == 256); }
            if (!ex1 && n1 >= 256) { T1 = c1; ex1 = (n1 == 256); }
            if (ex0 && ex1) break;
        }
        if (!(ex0 && ex1)) { const unsigned Tf = hh ? T1 : T0; int g0, g1;
            if (overflow) { int cnt = 0;
#pragma unroll 1
                for (int i = 0; i < n8; i += 8) { unsigned u8[8];
#pragma unroll
                    for (int k = 0; k < 8; ++k) u8[k] = SC[(i + k) * 64 + lane];
#pragma unroll
                    for (int k = 0; k < 8; ++k) cnt += (u8[k] > Tf) ? 1 : 0; }
                half_sums(cnt, g0, g1);
            } else { int cnt = 0;
#pragma unroll
                for (int s = 0; s < 5; ++s) cnt += (v[s] > Tf) ? 1 : 0;
                half_sums(cnt, g0, g1); g0 += G0; g1 += G1; }
            need0 = ex0 ? 0 : 256 - g0; need1 = ex1 ? 0 : 256 - g1; }
    }
    const unsigned T = hh ? T1 : T0;
    const bool exl = hh ? ex1 : ex0;
#pragma unroll 1
    for (int i0 = 0; i0 < n8; i0 += 8) {
        unsigned u8[8];
#pragma unroll
        for (int k = 0; k < 8; ++k) u8[k] = SC[(i0 + k) * 64 + lane];
        unsigned s0[8], s1[8];
#pragma unroll
        for (int k = 0; k < 8; ++k) { const unsigned long long mg = __ballot(exl ? (u8[k] >= T) : (u8[k] > T)); s0[k] = (unsigned)mg; s1[k] = (unsigned)(mg >> 32); }
        if (need0 > 0 || need1 > 0) {
#pragma unroll
            for (int k = 0; k < 8; ++k) { const unsigned long long me = __ballot(!exl && u8[k] == T);
                unsigned t0 = (unsigned)me, t1 = (unsigned)(me >> 32);
                while (t0 != 0u && need0 > 0) { const unsigned low = t0 & (0u - t0); s0[k] |= low; t0 ^= low; --need0; }
                while (t1 != 0u && need1 > 0) { const unsigned low = t1 & (0u - t1); s1[k] |= low; t1 ^= low; --need1; } }
        }
        int val = 0;
        asm("v_writelane_b32 %0, %1, 0" : "+v"(val) : "s"(s0[0])); asm("v_writelane_b32 %0, %1, 32" : "+v"(val) : "s"(s1[0]));
        asm("v_writelane_b32 %0, %1, 1" : "+v"(val) : "s"(s0[1])); asm("v_writelane_b32 %0, %1, 33" : "+v"(val) : "s"(s1[1]));
        asm("v_writelane_b32 %0, %1, 2" : "+v"(val) : "s"(s0[2])); asm("v_writelane_b32 %0, %1, 34" : "+v"(val) : "s"(s1[2]));
        asm("v_writelane_b32 %0, %1, 3" : "+v"(val) : "s"(s0[3])); asm("v_writelane_b32 %0, %1, 35" : "+v"(val) : "s"(s1[3]));
        asm("v_writelane_b32 %0, %1, 4" : "+v"(val) : "s"(s0[4])); asm("v_writelane_b32 %0, %1, 36" : "+v"(val) : "s"(s1[4]));
        asm("v_writelane_b32 %0, %1, 5" : "+v"(val) : "s"(s0[5])); asm("v_writelane_b32 %0, %1, 37" : "+v"(val) : "s"(s1[5]));
        asm("v_writelane_b32 %0, %1, 6" : "+v"(val) : "s"(s0[6])); asm("v_writelane_b32 %0, %1, 38" : "+v"(val) : "s"(s1[6]));
        asm("v_writelane_b32 %0, %1, 7" : "+v"(val) : "s"(s0[7])); asm("v_writelane_b32 %0, %1, 39" : "+v"(val) : "s"(s1[7]));
        if ((lane & 31) < 8) ((unsigned*)SEL)[(size_t)(tq0 + hh) * 64 + i0 + (lane & 31)] = (unsigned)val;
    }
}

__device__ __forceinline__ void indexer_unit(const Params& p, LAS unsigned char* lds, int b, int c, int qg, int wave, int lane) {
    unsigned char* ws = p.ws;
    const int tq0 = b * 2048 + 64 * c + 16 * qg, hh = lane >> 5, l31 = lane & 31, tid = wave * 64 + lane;
    if (c < 4) {
        if (tid < 64) { const int q = tid >> 2, kt = tid & 3; if (kt <= c) ((unsigned long long*)(ws + WS_SEL))[(size_t)(tq0 + q) * 32 + kt] = ~0ull; }
        return;
    }
    LAS unsigned* SCall = (LAS unsigned*)lds;
    LAS float* WQ = (LAS float*)(lds + LDSX_OFF);
    const bf16* IQ = (const bf16*)(ws + WS_IQ); const bf16* IK = (const bf16*)(ws + WS_IK); const float* IW = (const float*)(ws + WS_IW);
    const int n32 = 2 * (c + 1);
    const bf16* ikp = IK + frag_off(b * 2048 + l31, 8 * hh, 64);
    float wq_ = 0.f; if (tid < 256) wq_ = IW[(size_t)tq0 * 16 + tid];
    const bf16* iqp = IQ + frag_off((tq0 >> 1) * 32 + l31, 8 * hh, 64);
    bf16x8 Ac[4];
#pragma unroll
    for (int ks = 0; ks < 4; ++ks) Ac[ks] = *(const bf16x8*)(iqp + ks * 512);
    bf16x8 Bt[8][4];
#pragma unroll
    for (int j = 0; j < 8; ++j) { const int kt = wave + 8 * j < n32 ? wave + 8 * j : wave;
#pragma unroll
        for (int ks = 0; ks < 4; ++ks) Bt[j][ks] = *(const bf16x8*)(ikp + (size_t)((kt * 4 + ks) * 512)); }
    asm volatile("" : "+v"(wq_)); if (tid < 256) WQ[tid] = wq_;
    __syncthreads();
#pragma unroll 1
    for (int mt = 0; mt < 8; ++mt) {
        const int mtn = mt + 1 < 8 ? mt + 1 : mt;
        bf16x8 An[4];
#pragma unroll
        for (int ks = 0; ks < 4; ++ks) An[ks] = *(const bf16x8*)(iqp + (size_t)((mtn * 4 + ks) * 512));
        const LAS f32x4* wq = (const LAS f32x4*)(WQ + (2 * mt + hh) * 16);
        const f32x4 w0 = wq[0], w1 = wq[1], w2 = wq[2], w3 = wq[3];
#pragma unroll
        for (int j = 0; j < 8; ++j) {
            if (wave + 8 * j < n32) {
                f32x16 a;
#pragma unroll
                for (int q = 0; q < 16; ++q) a[q] = 0.f;
#pragma unroll
                for (int ks = 0; ks < 4; ++ks) a = MFMA32(Ac[ks], Bt[j][ks], a);
                asm volatile("s_nop 10" : "+v"(a));
                float s4[4];
#define IDX_RELU(T_, A_) asm("v_max_f32 %0, 0, %1" : "=v"(T_) : "v"(A_))
#pragma unroll
                for (int i = 0; i < 4; ++i) { float t_; IDX_RELU(t_, a[i]); asm("v_mul_f32 %0, %1, %2" : "=v"(s4[i]) : "v"(w0[i]), "v"(t_)); }
#pragma unroll
                for (int i = 0; i < 4; ++i) { float t_; IDX_RELU(t_, a[4 + i]); asm("v_fmac_f32 %0, %1, %2" : "+v"(s4[i]) : "v"(w1[i]), "v"(t_)); }
#pragma unroll
                for (int i = 0; i < 4; ++i) { float t_; IDX_RELU(t_, a[8 + i]); asm("v_fmac_f32 %0, %1, %2" : "+v"(s4[i]) : "v"(w2[i]), "v"(t_)); }
#pragma unroll
                for (int i = 0; i < 4; ++i) { float t_; IDX_RELU(t_, a[12 + i]); asm("v_fmac_f32 %0, %1, %2" : "+v"(s4[i]) : "v"(w3[i]), "v"(t_)); }
#undef IDX_RELU
                float sc;
                asm("v_add_f32 %0, %1, %2" : "=v"(sc) : "v"(s4[0]), "v"(s4[1])); asm("v_add_f32 %0, %0, %1" : "+v"(s4[2]) : "v"(s4[3])); asm("v_add_f32 %0, %0, %1" : "+v"(sc) : "v"(s4[2]));
                unsigned bits = __builtin_bit_cast(unsigned, sc); bits ^= (bits >> 31) ? 0xFFFFFFFFu : 0x80000000u;
                SCall[mt * 4096 + (wave + 8 * j) * 64 + lane] = bits;
            }
        }
#pragma unroll
        for (int ks = 0; ks < 4; ++ks) Ac[ks] = An[ks];
    }
    __syncthreads();
    indexer_select(p, SCall + wave * 4096, (LAS unsigned*)(lds + LDSX_OFF + 1024) + wave * 320, tq0 + 2 * wave, c, lane);
}

__device__ __forceinline__ void p2_gmlp(const Params& p, LAS unsigned char* lds, int wave, int lane) {
    for (int u = blockIdx.x; u < 256; u += gridDim.x) gmlp_unit(p, lds, u, wave, lane);
}
__device__ __forceinline__ void p2_indexer(const Params& p, LAS unsigned char* lds, int wave, int lane) {
#pragma unroll 1
    for (int it = blockIdx.x; it < 512; it += gridDim.x) {
        const int b = it & 7, cp = (it >> 3) & 15, qg = it >> 7;
#pragma unroll 1
        for (int sub = 0; sub < 2; ++sub) indexer_unit(p, lds, b, sub ? cp : 31 - cp, qg, wave, lane);
    }
}

__device__ __forceinline__ void p3_attention(const Params& p, LAS unsigned char* lds, int wave, int lane) {
    unsigned char* ws = p.ws;
    LAS unsigned* SELL = (LAS unsigned*)(lds + 8192 + 4 * 17 * 1024);
    LAS float* BT = (LAS float*)lds;
    const bf16* Q = (const bf16*)(ws + WS_Q); const bf16* K = (const bf16*)(ws + WS_K); const bf16* VT = (const bf16*)(ws + WS_VT); bf16* Y = (bf16*)(ws + WS_Y);
    const unsigned long long* SEL = (const unsigned long long*)(ws + WS_SEL);
    for (int item = blockIdx.x; item < 256; item += gridDim.x) {
        const int lane_ = lane_now(), hh = lane_ >> 5, l31 = lane_ & 31;
        const int b = item & 7, g = (item >> 3) & 1, cp = item >> 4;
        const int hd = wave & 3, head = 4 * g + hd, kh = wave >> 2, bh = b * 8 + head;
        const LAS float* bt = BT + head * 256;
        int c = 31 - cp;
#define tq0 (64 * c + l31)
#define nTw (c + 1)
#define SELW(S_, NQ_, T_) SELL[((S_) * 64 + 32 * (NQ_) + l31) * 65 + (T_)]
        const bf16* kbase = K + (size_t)bh * (2048 * 64) + (size_t)(hh * 32 + l31) * 8;
        const bf16* vbase = VT + (size_t)b * (512 * 2048) + frag_off(head * 64 + l31, 8 * hh, 2048);
        bf16x8 Qo[2][4], K0[4], K1[4], V0[2][2], V1[2][2]; unsigned w0[2], w1[2];
#define ATT_LOAD(KX, VX, WX, I, SUB_) do { const int T_ = kh + 2 * ((I) < nTw ? (I) : nTw - 1); \
                _Pragma("unroll") for (int ks = 0; ks < 4; ++ks) KX[ks] = *(const bf16x8*)(kbase + (size_t)((T_ * 4 + ks) * 512)); \
                _Pragma("unroll") for (int s2 = 0; s2 < 2; ++s2) _Pragma("unroll") for (int dt = 0; dt < 2; ++dt) VX[s2][dt] = *(const bf16x8*)(vbase + (size_t)dt * (128 * 512) + (size_t)((2 * T_ + s2) * 512)); \
                WX[0] = SELW(SUB_, 0, T_); WX[1] = SELW(SUB_, 1, T_); } while (0)
#define ATT_LOADQ() do { _Pragma("unroll") for (int nq = 0; nq < 2; ++nq) _Pragma("unroll") for (int ks = 0; ks < 4; ++ks) \
                Qo[nq][ks] = *(const bf16x8*)(Q + (size_t)bh * (2048 * 64) + frag_off(tq0 + 32 * nq, 16 * ks + 8 * hh, 64)); } while (0)
        ATT_LOADQ();
#pragma unroll
        for (int ks = 0; ks < 4; ++ks) K0[ks] = *(const bf16x8*)(kbase + (size_t)((kh * 4 + ks) * 512));
#pragma unroll
        for (int s2 = 0; s2 < 2; ++s2)
#pragma unroll
            for (int dt = 0; dt < 2; ++dt) V0[s2][dt] = *(const bf16x8*)(vbase + (size_t)dt * (128 * 512) + (size_t)((2 * kh + s2) * 512));
        if (item != (int)blockIdx.x) __syncthreads();
        {
            const int tid_ = wave * 64 + lane_;
            u32x4 sv_[4]; float bv_[4];
#pragma unroll
            for (int j = 0; j < 4; ++j) {
                const int k_ = tid_ + 512 * j, s_ = k_ >> 10, row_ = (k_ >> 4) & 63, part_ = k_ & 15;
                sv_[j] = *(const u32x4*)((const unsigned*)SEL + (size_t)(b * 2048 + 64 * (s_ ? cp : 31 - cp) + row_) * 64 + 4 * part_);
            }
            if (item == (int)blockIdx.x) {
#pragma unroll
                for (int j = 0; j < 4; ++j) { const int idx = tid_ + 512 * j;
                    const int h = idx >> 8, rel = (idx & 255) - 191, n = rel < 0 ? -rel : rel;
                    int bk = rel > 0 ? 16 : 0;
                    if (n < 8) bk += n; else { int lg = 33 - __builtin_clz((unsigned)(n * n)); bk += lg < 15 ? lg : 15; }
                    bv_[j] = p.rel_bias[bk * 8 + h]; }
            }
#pragma unroll
            for (int j = 0; j < 4; ++j) {
                const int k_ = tid_ + 512 * j, s_ = k_ >> 10, row_ = (k_ >> 4) & 63, part_ = k_ & 15;
                LAS unsigned* d_ = SELL + (s_ * 64 + row_) * 65 + 4 * part_;
                d_[0] = sv_[j][0]; d_[1] = sv_[j][1]; d_[2] = sv_[j][2]; d_[3] = sv_[j][3];
            }
            if (item == (int)blockIdx.x) {
#pragma unroll
                for (int j = 0; j < 4; ++j) BT[tid_ + 512 * j] = bv_[j] * LOG2E;
            }
        }
        __syncthreads();
        w0[0] = SELW(0, 0, kh); w0[1] = SELW(0, 1, kh);
        const float bfar = bt[0];
#pragma unroll 1
        for (int sub = 0; sub < 2; ++sub) {
            f32x16 O[2][2];
#pragma unroll
            for (int q = 0; q < 16; ++q) { O[0][0][q] = 0.f; O[0][1][q] = 0.f; O[1][0][q] = 0.f; O[1][1][q] = 0.f; }
            float mrun[2] = {-1e30f, -1e30f}, lsum[2] = {0.f, 0.f};
#define ATT_PAIR(J, KB0, KB1) { int m0_, m1_; asm("v_bfe_i32 %0, %1, " #KB0 ", 1" : "=v"(m0_) : "v"(w)); asm("v_bfe_i32 %0, %1, " #KB1 ", 1" : "=v"(m1_) : "v"(w)); \
                float a0_, a1_; asm("v_add_f32 %0, %1, %2" : "=v"(a0_) : "v"(S[nq][2 * J]), "v"(sh_)); asm("v_add_f32 %0, %1, %2" : "=v"(a1_) : "v"(S[nq][2 * J + 1]), "v"(sh_)); \
                const float e0_ = __builtin_bit_cast(float, __builtin_bit_cast(unsigned, fexp2(a0_)) & (unsigned)m0_), e1_ = __builtin_bit_cast(float, __builtin_bit_cast(unsigned, fexp2(a1_)) & (unsigned)m1_); \
                pk[J] = cvt_pk(e0_, e1_); \
                asm("v_add_f32 %0, %0, %1" : "+v"(ps0_) : "v"(e0_)); asm("v_add_f32 %0, %0, %1" : "+v"(ps1_) : "v"(e1_)); }
#define ATT_STEP(NEAR) do { \
                ATT_LOAD(K1, V1, w1, i + 1, sub); \
                const int T = kh + 2 * i; \
                f32x16 S[2]; \
                _Pragma("unroll") for (int nq = 0; nq < 2; ++nq) { \
                    _Pragma("unroll") for (int q = 0; q < 16; ++q) S[nq][q] = 0.f; \
                    _Pragma("unroll") for (int ks = 0; ks < 4; ++ks) S[nq] = MFMA32(K0[ks], Qo[nq][ks], S[nq]); \
                    asm volatile("; operands stay live past the MFMAs: a fresh destination must not be allocated over them" : "+v"(S[nq]) : "v"(K0[0]), "v"(K0[1]), "v"(K0[2]), "v"(K0[3])); \
                } \
                _Pragma("unroll") for (int nq = 0; nq < 2; ++nq) { \
                    if (NEAR) { const LAS float* btp = bt + (32 * T - tq0 - 32 * nq + 191) + 4 * hh; \
                        _Pragma("unroll") for (int q = 0; q < 16; ++q) S[nq][q] += btp[(q & 3) + 8 * (q >> 2)]; } \
                    float tmax = S[nq][0]; \
                    _Pragma("unroll") for (int q = 1; q < 16; ++q) tmax = fmaxf(tmax, S[nq][q]); \
                    if (!(NEAR)) tmax += bfar; \
                      \
                    { const u32x2 r_ = __builtin_amdgcn_permlane32_swap(__builtin_bit_cast(unsigned, tmax), __builtin_bit_cast(unsigned, tmax), false, false); \
                      tmax = fmaxf(__builtin_bit_cast(float, r_[0]), __builtin_bit_cast(float, r_[1])); } \
                    if (__builtin_amdgcn_ballot_w64(tmax > mrun[nq] + 8.0f)) {     \
                        const float mnew = fmaxf(mrun[nq], tmax), alpha = fexp2(mrun[nq] - mnew); \
                        mrun[nq] = mnew; lsum[nq] *= alpha; \
                        _Pragma("unroll") for (int q = 0; q < 16; ++q) { O[nq][0][q] *= alpha; O[nq][1][q] *= alpha; } \
                    } \
                    const unsigned w = w0[nq] >> (4 * hh);                  \
                    const float sh_ = (NEAR) ? -mrun[nq] : bfar - mrun[nq]; \
                    unsigned pk[8]; float ps0_ = 0.f, ps1_ = 0.f; \
                    ATT_PAIR(0, 0, 1) ATT_PAIR(1, 2, 3) ATT_PAIR(2, 8, 9) ATT_PAIR(3, 10, 11) ATT_PAIR(4, 16, 17) ATT_PAIR(5, 18, 19) ATT_PAIR(6, 24, 25) ATT_PAIR(7, 26, 27) \
                    lsum[nq] += ps0_ + ps1_; \
                    _Pragma("unroll") for (int s2 = 0; s2 < 2; ++s2) { \
                        const bf16x8 Po = __builtin_bit_cast(bf16x8, u32x4{pk[4 * s2], pk[4 * s2 + 1], pk[4 * s2 + 2], pk[4 * s2 + 3]}); \
                        _Pragma("unroll") for (int dt = 0; dt < 2; ++dt) O[nq][dt] = MFMA32(V0[s2][dt], Po, O[nq][dt]); \
                    } \
                } \
                _Pragma("unroll") for (int ks = 0; ks < 4; ++ks) K0[ks] = K1[ks]; \
                _Pragma("unroll") for (int s2 = 0; s2 < 2; ++s2) _Pragma("unroll") for (int dt = 0; dt < 2; ++dt) V0[s2][dt] = V1[s2][dt]; \
                w0[0] = w1[0]; w0[1] = w1[1]; } while (0)
            const int nfar = c > 2 ? c - 2 : 0;
            int i = 0;
#pragma unroll 1
            for (; i < nfar; ++i) ATT_STEP(false);
#pragma unroll 1
            for (; i < nTw; ++i) ATT_STEP(true);
#undef ATT_STEP
#undef ATT_PAIR
            const int cs_ = c;
            if (sub == 0) {
                c = cp;
                ATT_LOADQ();
#pragma unroll
                for (int ks = 0; ks < 4; ++ks) K0[ks] = *(const bf16x8*)(kbase + (size_t)((kh * 4 + ks) * 512));
            }
            LAS float* MG = (LAS float*)(lds + 8192 + hd * (17 * 1024));
            __syncthreads();
            if (kh == 1) {
#pragma unroll
                for (int nq = 0; nq < 2; ++nq) {
#pragma unroll
                    for (int dt = 0; dt < 2; ++dt)
#pragma unroll
                        for (int q4 = 0; q4 < 4; ++q4)
                            *(LAS f32x4*)(MG + ((nq * 2 + dt) * 4 + q4) * 256 + lane_ * 4) = f32x4{O[nq][dt][4 * q4], O[nq][dt][4 * q4 + 1], O[nq][dt][4 * q4 + 2], O[nq][dt][4 * q4 + 3]};
                    MG[4096 + nq * 64 + lane_] = mrun[nq]; MG[4096 + 128 + nq * 64 + lane_] = lsum[nq];
                }
            }
            __syncthreads();
            if (kh == 0) {
                LAS unsigned char* ST = (LAS unsigned char*)MG;
#pragma unroll
                for (int nq = 0; nq < 2; ++nq) {
                    const float mB = MG[4096 + nq * 64 + lane_], lB = MG[4096 + 128 + nq * 64 + lane_];
                    const float m = fmaxf(mrun[nq], mB);
                    float fa = fexp2(mrun[nq] - m), fb = fexp2(mB - m);
                    float l = lsum[nq] * fa + lB * fb;
                    l += __shfl_xor(l, 32);
                    const float inv = 1.0f / l;
                    fa *= inv; fb *= inv;
#pragma unroll
                    for (int dt = 0; dt < 2; ++dt)
#pragma unroll
                        for (int q4 = 0; q4 < 4; ++q4) {
                            const f32x4 ob = *(const LAS f32x4*)(MG + ((nq * 2 + dt) * 4 + q4) * 256 + lane_ * 4);
#pragma unroll
                            for (int i = 0; i < 4; ++i) O[nq][dt][4 * q4 + i] = O[nq][dt][4 * q4 + i] * fa + ob[i] * fb;
                        }
#pragma unroll
                    for (int dt = 0; dt < 2; ++dt)
#pragma unroll
                        for (int q4 = 0; q4 < 4; ++q4) {
                            const int r = 32 * nq + l31, u = 8 * dt + 2 * q4 + hh;
                            *(LAS u32x2*)(ST + r * 128 + ((u ^ ((r & 7) << 1)) * 8)) = pack4(O[nq][dt][4 * q4], O[nq][dt][4 * q4 + 1], O[nq][dt][4 * q4 + 2], O[nq][dt][4 * q4 + 3]);
                        }
                    __builtin_amdgcn_sched_barrier(0);
                }
                const int ln2_ = lane_now();
                bf16* yb = Y + (size_t)(b * 2048 + 64 * cs_) * 1024 + head * 64;
#pragma unroll
                for (int it = 0; it < 8; ++it) {
                    const int rr = 8 * it + (ln2_ >> 3), ch = ln2_ & 7;
                    *(u32x4*)(yb + (size_t)rr * 1024 + ch * 8) = *(const LAS u32x4*)(ST + rr * 128 + ((ch ^ (rr & 7)) * 16));
                }
            }
            if (sub == 0) {
#pragma unroll
                for (int s2 = 0; s2 < 2; ++s2)
#pragma unroll
                    for (int dt = 0; dt < 2; ++dt) V0[s2][dt] = *(const bf16x8*)(vbase + (size_t)dt * (128 * 512) + (size_t)((2 * kh + s2) * 512));
                w0[0] = SELW(1, 0, kh); w0[1] = SELW(1, 1, kh);
            }
        }
#undef ATT_LOAD
#undef ATT_LOADQ
#undef tq0
#undef nTw
#undef SELW
    }
}

__device__ __forceinline__ void p_convfix_rows(const Params& p, int layer, int row_lo, int nrows, int t0, int nthr) {
    unsigned char* ws = p.ws; const float* HB = (const float*)(ws + WS_HB); bf16* ACT = (bf16*)(ws + WS_ACT);
    const float* cw = p.ffn_conv_w + (size_t)layer * 3 * NUP; const float* cbv = p.ffn_conv_b + (size_t)layer * NUP;
    const int total = nrows * (DFF / 4);
#pragma unroll 3
    for (int idx = t0; idx < total; idx += nthr) {
        const int row = row_lo + idx / (DFF / 4), c4 = (idx % (DFF / 4)) * 4, grp = row >> 1, w = row & 1, tok = 128 * grp + w;
        const bool first = (tok & 2047) < 2;
        f32x4 y[2];
#pragma unroll
        for (int half = 0; half < 2; ++half) { const int col = half * DFF + c4;
            const f32x4 h0 = *(const f32x4*)(HB + ((size_t)grp * 4 + 2 + w) * NUP + col);
            f32x4 h1, h2; const f32x4 z = {0.f, 0.f, 0.f, 0.f};
            if (w == 0) { h1 = first ? z : *(const f32x4*)(HB + ((size_t)(grp - 1) * 4 + 1) * NUP + col); h2 = first ? z : *(const f32x4*)(HB + ((size_t)(grp - 1) * 4 + 0) * NUP + col); }
            else        { h1 = *(const f32x4*)(HB + ((size_t)grp * 4 + 2) * NUP + col); h2 = first ? z : *(const f32x4*)(HB + ((size_t)(grp - 1) * 4 + 1) * NUP + col); }
            y[half] = *(const f32x4*)(cbv + col) + *(const f32x4*)(cw + 2 * NUP + col) * h0 + *(const f32x4*)(cw + NUP + col) * h1 + *(const f32x4*)(cw + col) * h2; }
        *(u32x2*)(ACT + (size_t)tok * DFF + c4) = pack4(fsilu(y[0][0]) * y[1][0], fsilu(y[0][1]) * y[1][1], fsilu(y[0][2]) * y[1][2], fsilu(y[0][3]) * y[1][3]);
    }
}

__device__ __forceinline__ void p_convfix(const Params& p, int layer, int wave, int lane) { p_convfix_rows(p, layer, 0, 256, blockIdx.x * (NWAVES * 64) + wave * 64 + lane, gridDim.x * NWAVES * 64); }
struct HgX { bf16x8 bq[2][2], kq[2][2], akt[4], bi[4]; };
__device__ __forceinline__ void hg_lds_put(LAS float* buf, int tt, int slot, const f32x16& o, int lane) {
    LAS f32x4* d = (LAS f32x4*)(buf + (tt * 4 + slot) * 1024) + lane;
#pragma unroll
    for (int k = 0; k < 4; ++k) d[k * 64] = (f32x4){o[4 * k], o[4 * k + 1], o[4 * k + 2], o[4 * k + 3]};
}
__device__ __forceinline__ void hg_reader(LAS float* buf, bf16* OB, float* OSSQ, int tokc, int h, int es, int hw, int lane) {
    const int tt = hw >> 2, tl = 8 * (hw & 3) + (lane & 7), part = lane >> 3;
    const LAS f32x4* src = (const LAS f32x4*)(buf + tt * 4 * 1024) + (part >> 1) * 64 + 32 * (part & 1) + tl;
    f32x4 v = src[0];
#pragma unroll
    for (int s = 1; s < 4; ++s) v += src[s * 256];
    float ss = (v[0] * v[0] + v[1] * v[1]) + (v[2] * v[2] + v[3] * v[3]);
    ss += __shfl_xor(ss, 8); ss += __shfl_xor(ss, 16); ss += __shfl_xor(ss, 32);
    const int tok = tokc + 32 * tt + tl;
    *(u32x2*)(OB + (size_t)tok * 1024 + h * 128 + es * 32 + 4 * part) = pack4(v[0], v[1], v[2], v[3]);
    if (part == 0) OSSQ[(size_t)tok * 32 + h * 4 + es] = ss;
}
#define HG_SYNC() do { asm volatile("s_waitcnt lgkmcnt(0)" ::: "memory"); __builtin_amdgcn_s_barrier(); asm volatile("" ::: "memory"); } while (0)
__device__ __forceinline__ void p9_hgrn(const Params& p, LAS unsigned char* lds, int wave, int lane) {
    unsigned char* ws = p.ws;
    const bf16* QM = (const bf16*)(ws + WS_QM); const bf16* KM = (const bf16*)(ws + WS_KM); const bf16* KMT = (const bf16*)(ws + WS_KMT); const bf16* IT = (const bf16*)(ws + WS_IT);
    const float* EB = (const float*)(ws + WS_EB); const float* FAC = (const float*)(ws + WS_FAC);
    bf16* OB = (bf16*)p.out; float* OSSQ = (float*)(ws + WS_OSSQ);
    LAS float* OBUF = (LAS float*)lds;
    LAS float* EFA = (LAS float*)(lds + 65536);
    const int hh = lane >> 5, l31 = lane & 31;
    HG_SYNC();
    for (int ub = blockIdx.x; ub < 256; ub += gridDim.x) {
        const int unit = (gridDim.x == 256) ? (ub & 7) * 32 + (ub >> 3) : ub;
        const int b = unit >> 5, h = (unit >> 2) & 7, es = unit & 3, bh = b * 8 + h, tb0 = b * 2048;
        const float* ebp = EB + ((size_t)(b * 32 * 8 + h)) * 128; const float* fcp = FAC + ((size_t)(b * 32 * 8 + h)) * 128;
        if (wave < 4) {
            const int dt = wave;
            f32x16 S;
#pragma unroll
            for (int q = 0; q < 16; ++q) S[q] = 0.f;
            const bf16* qmp = QM + (size_t)bh * (2048 * 128) + frag_off(l31, 32 * dt + 8 * hh, 128);
            const bf16* kmp = KM + (size_t)bh * (2048 * 128) + frag_off(l31, 32 * dt + 8 * hh, 128);
            const bf16* ktp = KMT + (size_t)bh * (128 * 2048) + frag_off(32 * dt + l31, 8 * hh, 2048);
            const bf16* itp = IT + (size_t)bh * (128 * 2048) + frag_off(es * 32 + l31, 8 * hh, 2048);
#define HGX_LOAD(X, c) do { \
            _Pragma("unroll") for (int t2 = 0; t2 < 2; ++t2) _Pragma("unroll") for (int s2 = 0; s2 < 2; ++s2) { \
                X.bq[t2][s2] = *(const bf16x8*)(qmp + (size_t)(((2 * (c) + t2) * 8 + s2) * 512)); X.kq[t2][s2] = *(const bf16x8*)(kmp + (size_t)(((2 * (c) + t2) * 8 + s2) * 512)); } \
            _Pragma("unroll") for (int k4 = 0; k4 < 4; ++k4) { X.akt[k4] = *(const bf16x8*)(ktp + (4 * (c) + k4) * 512); X.bi[k4] = *(const bf16x8*)(itp + (4 * (c) + k4) * 512); } } while (0)
#define HGX_TILE(X, st, tt, O) do { f32x16 a; _Pragma("unroll") for (int q = 0; q < 16; ++q) a[q] = 0.f; \
                _Pragma("unroll") for (int s2 = 0; s2 < 2; ++s2) a = MFMA32(X.kq[st][s2], X.bq[tt][s2], a); \
                asm volatile("; operands stay live past the MFMAs" : "+v"(a) : "v"(X.kq[st][0]), "v"(X.kq[st][1]), "v"(X.bq[tt][0]), "v"(X.bq[tt][1])); \
                if ((st) == (tt)) { _Pragma("unroll") for (int q = 0; q < 16; ++q) { const int srow = (q & 3) + 8 * (q >> 2) + 4 * hh; a[q] = (l31 >= srow) ? a[q] : 0.f; } } \
                _Pragma("unroll") for (int s2 = 0; s2 < 2; ++s2) { const bf16x8 Pa = pack8(a[8 * s2], a[8 * s2 + 1], a[8 * s2 + 2], a[8 * s2 + 3], a[8 * s2 + 4], a[8 * s2 + 5], a[8 * s2 + 6], a[8 * s2 + 7]); \
                    O = MFMA32(X.bi[2 * (st) + s2], Pa, O); asm volatile("; B operand stays live past the MFMA: a fresh destination must not be allocated over it" : "+v"(O) : "v"(Pa)); } } while (0)
#define HGX_STEP(X, c) do { \
            const LAS float* ef = EFA + (c) * 256 + 32 * dt + 4 * hh; \
            _Pragma("unroll") for (int q4 = 0; q4 < 4; ++q4) { const f32x4 e4 = *(const LAS f32x4*)(ef + 8 * q4); _Pragma("unroll") for (int i = 0; i < 4; ++i) S[4 * q4 + i] *= e4[i]; } \
            bf16x8 So[2]; _Pragma("unroll") for (int s2 = 0; s2 < 2; ++s2) So[s2] = pack8(S[8 * s2], S[8 * s2 + 1], S[8 * s2 + 2], S[8 * s2 + 3], S[8 * s2 + 4], S[8 * s2 + 5], S[8 * s2 + 6], S[8 * s2 + 7]); \
            LAS float* buf = OBUF + ((c) & 1) * 8192; \
            { f32x16 O; _Pragma("unroll") for (int q = 0; q < 16; ++q) O[q] = 0.f; \
              HGX_TILE(X, 0, 0, O); _Pragma("unroll") for (int s2 = 0; s2 < 2; ++s2) O = MFMA32(So[s2], X.bq[0][s2], O); hg_lds_put(buf, 0, dt, O, lane); } \
            { f32x16 O; _Pragma("unroll") for (int q = 0; q < 16; ++q) O[q] = 0.f; \
              HGX_TILE(X, 0, 1, O); HGX_TILE(X, 1, 1, O); _Pragma("unroll") for (int s2 = 0; s2 < 2; ++s2) O = MFMA32(So[s2], X.bq[1][s2], O); hg_lds_put(buf, 1, dt, O, lane); } \
            _Pragma("unroll") for (int k4 = 0; k4 < 4; ++k4) S = MFMA32(X.akt[k4], X.bi[k4], S); \
            _Pragma("unroll") for (int q4 = 0; q4 < 4; ++q4) { const f32x4 f4 = *(const LAS f32x4*)(ef + 128 + 8 * q4); _Pragma("unroll") for (int i = 0; i < 4; ++i) S[4 * q4 + i] *= f4[i]; } \
            HG_SYNC(); } while (0)
            HgX XA, XB_;
            HGX_LOAD(XA, 0);
            HG_SYNC();
#pragma unroll 1
            for (int c = 0; c < 32; c += 2) { HGX_LOAD(XB_, c + 1); HGX_STEP(XA, c); { const int cn = c + 2 < 32 ? c + 2 : 31; HGX_LOAD(XA, cn); } HGX_STEP(XB_, c + 1); }
#undef HGX_LOAD
#undef HGX_STEP
#undef HGX_TILE
        } else {
            const int hq = wave - 4;
            {
                const int j = lane & 31, kh = lane >> 5;
#pragma unroll
                for (int k = 0; k < 4; ++k) { const int cc = 8 * hq + 2 * k + kh;
                    const f32x4 ve = *(const f32x4*)(ebp + cc * 1024 + 4 * j), vf = *(const f32x4*)(fcp + cc * 1024 + 4 * j);
                    *(LAS f32x4*)(EFA + cc * 256 + 4 * j) = ve; *(LAS f32x4*)(EFA + cc * 256 + 128 + 4 * j) = vf; }
            }
            HG_SYNC();
#pragma unroll 1
            for (int c = 0; c < 32; ++c) {
                LAS float* buf = OBUF + (c & 1) * 8192;
                HG_SYNC();
                hg_reader(buf, OB, OSSQ, tb0 + 64 * c, h, es, 2 * hq, lane); hg_reader(buf, OB, OSSQ, tb0 + 64 * c, h, es, 2 * hq + 1, lane);
            }
        }
        HG_SYNC();
    }
}

__device__ __forceinline__ void p10_outnorm(const Params& p, int wave, int lane) {
    unsigned char* ws = p.ws; const bf16* OB = (const bf16*)p.out; const bf16* GATE = (const bf16*)(ws + WS_GATE); const float* OSSQ = (const float*)(ws + WS_OSSQ); bf16* ON = (bf16*)(ws + WS_ON);
    const int gw = blockIdx.x * NWAVES + wave, NGW = gridDim.x * NWAVES;
    const int col = 16 * lane, h = lane >> 3;
    f32x4 n0[2], n1[2];
#pragma unroll
    for (int k = 0; k < 2; ++k) { const int cc = col + 8 * k; n0[k] = *(const f32x4*)(p.c_out_norm + (cc & 127)); n1[k] = *(const f32x4*)(p.c_out_norm + (cc & 127) + 4); }
    for (int m0 = gw; m0 < M; m0 += 4 * NGW) {
        u32x4 o[4][2], g[4][2]; f32x4 sq[4];
#pragma unroll
        for (int r = 0; r < 4; ++r) { const int mr = m0 + r * NGW, m = mr < M ? mr : m0; sq[r] = *(const f32x4*)(OSSQ + (size_t)m * 32 + 4 * h);
#pragma unroll
            for (int k = 0; k < 2; ++k) { o[r][k] = *(const u32x4*)(OB + (size_t)m * 1024 + col + 8 * k); g[r][k] = *(const u32x4*)(GATE + (size_t)m * 1024 + col + 8 * k); } }
#pragma unroll
        for (int r = 0; r < 4; ++r) { const int m = m0 + r * NGW;
            if (m < M) {
                const float rn = 1.0f / sqrtf(((sq[r][0] + sq[r][1]) + (sq[r][2] + sq[r][3])) * (1.0f / 128.0f) + EPS);
#pragma unroll
                for (int k = 0; k < 2; ++k) { const int cc = col + 8 * k;
                    float v[8];
#pragma unroll
                    for (int i = 0; i < 4; ++i) { const unsigned ow = o[r][k][i], gwd = g[r][k][i];
                        v[2 * i] = __builtin_bit_cast(float, ow << 16) * __builtin_bit_cast(float, gwd << 16); v[2 * i + 1] = __builtin_bit_cast(float, ow & 0xffff0000u) * __builtin_bit_cast(float, gwd & 0xffff0000u); }
                    *(bf16x8*)(ON + (size_t)m * 1024 + cc) = pack8(v[0] * rn * n0[k][0], v[1] * rn * n0[k][1], v[2] * rn * n0[k][2], v[3] * rn * n0[k][3], v[4] * rn * n1[k][0], v[5] * rn * n1[k][1], v[6] * rn * n1[k][2], v[7] * rn * n1[k][3]);
                }
            }
        }
    }
}

__device__ __forceinline__ void p15_final(const Params& p, int wave, int lane) {
    const float* SSQ = (const float*)(p.ws + WS_SSQA) + 3 * M; const bf16* XB = (const bf16*)(p.ws + WS_XB);
    const int gw = blockIdx.x * NWAVES + wave, NGW = gridDim.x * NWAVES;
    for (int m = gw; m < M; m += NGW) {
        const float rn = 1.0f / sqrtf(SSQ[m] * (1.0f / DM) + EPS);
        f32x4* xr = (f32x4*)(p.out + (size_t)m * DM) + lane; const f32x4* gr = (const f32x4*)p.final_norm + lane; const u32x2* xb = (const u32x2*)(XB + (size_t)m * DM) + lane;
#pragma unroll
        for (int j = 0; j < 4; ++j) { const u32x2 w = xb[64 * j]; f32x4 v; v[0] = __builtin_bit_cast(float, w.x << 16); v[1] = __builtin_bit_cast(float, w.x & 0xffff0000u); v[2] = __builtin_bit_cast(float, w.y << 16); v[3] = __builtin_bit_cast(float, w.y & 0xffff0000u);
            xr[64 * j] = v * rn * gr[64 * j]; }
    }
}

constexpr int NPHASE = 16;
__global__ void __launch_bounds__(NWAVES * 64, 2) mk_fwd(Params p) {
    extern __shared__ __attribute__((aligned(16))) unsigned char lds_raw[];
    LAS unsigned char* lds = (LAS unsigned char*)lds_raw;
    volatile LAS unsigned* MISC = (volatile LAS unsigned*)(lds + MISC_OFF);
    const int wave = __builtin_amdgcn_readfirstlane(threadIdx.x >> 6);
    unsigned char* ws = p.ws;
    for (int u = wave * 64 + lane_now(); u < (LDS_BYTES - MISC_OFF) / 4; u += NWAVES * 64) ((LAS unsigned*)(lds + MISC_OFF))[u] = 0u;
    __syncthreads();
    const bool one = (MK_N_LAUNCHES == 1);
    XcdBarrier bar; bar.bar = (unsigned*)(ws + WS_CTL) + CW_BAR; bar.x = 0; bar.st = nullptr;
    if (one) bar = xcd_barrier_post((unsigned*)(ws + WS_CTL) + CW_BAR, MISC + 8, wave == 0 && lane_now() == 0);
    const int lo = p.ph_lo, hi = p.ph_hi;
#define IN(k) (lo <= (k) && (k) < hi)
#define LN() lane_now()
#define SEAM(k) do { if (one && lo <= (k) && (k) + 1 < hi) xcd_barrier(bar, wave == 0 && lane_now() == 0); } while (0)
    float* SSQA = (float*)(ws + WS_SSQA); bf16* XB = (bf16*)(ws + WS_XB);
    const int G = gridDim.x, cidx = blockIdx.x;

    if (IN(0)) { p0_prologue(p, lds, wave, LN()); } SEAM(0);
    if (IN(1)) {
        pg8::Gemm g{XB, (const bf16*)(ws + WS_WAB), M, NAB, DM}; pg8::StaticOrder S; S.init(M, NAB, G, cidx);
        EpiAB E{ws, p.ab_idx_k_norm};
        pg8::gemm_phase<EpiAB, pg8::StaticOrder, true, true>(lds, g, S, E, wave);
        if (G == 256 && cidx >= 192) convert_weights<1>(p, (cidx - 192) * NWAVES + wave, 64 * NWAVES, LN());
    } SEAM(1);
    if (IN(2)) { p2_gmlp(p, lds, wave, LN()); p2_indexer(p, lds, wave, LN()); } SEAM(2);
    if (IN(3)) { p3_attention(p, lds, wave, LN()); } SEAM(3);
    if (IN(4)) {
        pg8::Gemm g{(const bf16*)(ws + WS_Y), (const bf16*)(ws + WS_WABO), M, DM, DM}; pg8::StaticOrder S; S.init(M, DM, G, cidx);
        EpiRes E{XB, SSQA};
        pg8::gemm_phase<EpiRes, pg8::StaticOrder, true, true>(lds, g, S, E, wave);
    } SEAM(4);
#define FFN_PHASES(l, pb) do { \
        if (IN(pb)) { \
            pg8::Gemm g{XB, (const bf16*)(ws + ((l) ? WS_WUP1 : WS_WUP0)), M, NUP, DM}; pg8::StaticOrder S; S.init(M, NUP, G, cidx); \
            EpiConv E{SSQA + ((l) ? 2 * M : 0), p.ffn_conv_w + (size_t)(l) * 3 * NUP, p.ffn_conv_b + (size_t)(l) * NUP, (bf16*)(ws + WS_ACT), (float*)(ws + WS_HB)}; \
            pg8::gemm_phase<EpiConv, pg8::StaticOrder, true, true>(lds, g, S, E, wave); \
            if ((l) == 0 && G == 256 && cidx >= 128) convert_weights<2>(p, (cidx - 128) * NWAVES + wave, 128 * NWAVES, LN());     \
        } SEAM(pb); \
        if (G != 256) { if (IN((pb) + 1)) { p_convfix(p, (l), wave, LN()); } SEAM((pb) + 1); }     \
        if (IN((pb) + 2)) { \
            pg8::Gemm g{(const bf16*)(ws + WS_ACT), (const bf16*)(ws + ((l) ? WS_WDN1 : WS_WDN0)), M, DM, DFF}; pg8::StaticOrder S; S.init(M, DM, G, cidx); \
            if (G == 256) { pg8::Unit u0; if (S.next(0, u0)) p_convfix_rows(p, (l), 4 * u0.pm, 4, wave * 64 + LN(), NWAVES * 64);     \
                asm volatile("s_waitcnt vmcnt(0)" ::: "memory"); __syncthreads(); } \
            if ((l) == 0 || G != 256) { EpiRes E{XB, SSQA + ((l) ? 3 * M : M)}; \
                pg8::gemm_phase<EpiRes, pg8::StaticOrder, true, true>(lds, g, S, E, wave); } \
            else { EpiFinal E{XB, p.out, SSQA + 3 * M, (unsigned*)(ws + WS_FCNT), p.final_norm};     \
                pg8::gemm_phase<EpiFinal, pg8::StaticOrder, true, true>(lds, g, S, E, wave); } \
        } if (!((l) == 1 && G == 256)) SEAM((pb) + 2); } while (0)
    FFN_PHASES(0, 5);
    if (IN(8)) {
        pg8::Gemm g{XB, (const bf16*)(ws + WS_WCI), M, NCI, DM}; pg8::StaticOrder S; S.init(M, NCI, G, cidx);
        EpiHg E{ws, p.hgrn_lb};
        pg8::gemm_phase<EpiHg, pg8::StaticOrder, true, true>(lds, g, S, E, wave);
    } SEAM(8);
    if (IN(9)) { p9_hgrn(p, lds, wave, LN()); } SEAM(9);
    if (IN(10)) { p10_outnorm(p, wave, LN()); } SEAM(10);
    if (IN(11)) {
        pg8::Gemm g{(const bf16*)(ws + WS_ON), (const bf16*)(ws + WS_WCO), M, DM, DM}; pg8::StaticOrder S; S.init(M, DM, G, cidx);
        EpiRes E{XB, SSQA + 2 * M};
        pg8::gemm_phase<EpiRes, pg8::StaticOrder, true, true>(lds, g, S, E, wave);
    } SEAM(11);
    FFN_PHASES(1, 12);
    if (IN(15) && G != 256) { p15_final(p, wave, LN()); }
#undef IN
#undef SEAM
}

extern "C" void kernel_launch(void* const* d_in, const int* in_sizes, int n_in, void* d_out, int out_size, void* d_ws, size_t ws_size, hipStream_t stream) {
    static int grid = 0;
    if (grid == 0) {
        if (n_in != 19 || out_size != M * DM || ws_size < WS_END) { fprintf(stderr, "kernel_launch: unexpected shapes (n_in %d out %d ws %zu)\n", n_in, out_size, ws_size); grid = -1; return; }
        int dev = 0, cus = 0, per_cu = 0;
        if (hipGetDevice(&dev) != hipSuccess || hipDeviceGetAttribute(&cus, hipDeviceAttributeMultiprocessorCount, dev) != hipSuccess) { grid = -1; return; }
        if (hipFuncSetAttribute((const void*)mk_fwd, hipFuncAttributeMaxDynamicSharedMemorySize, LDS_BYTES) != hipSuccess) { fprintf(stderr, "kernel_launch: hipFuncSetAttribute failed\n"); grid = -1; return; }
        if (hipOccupancyMaxActiveBlocksPerMultiprocessor(&per_cu, (const void*)mk_fwd, NWAVES * 64, LDS_BYTES) != hipSuccess || per_cu < 1) { fprintf(stderr, "kernel_launch: occupancy query says %d\n", per_cu); }
        (void)hipGetLastError();
        grid = cus;
    }
    if (grid < 0) return;
    if (hipMemsetAsync((char*)d_ws + WS_CTL, 0, CTL_ZERO_BYTES, stream) != hipSuccess) return;
    Params p{};
    const float** pp = (const float**)&p;
    for (int i = 0; i < 19; ++i) pp[i] = (const float*)d_in[i];
    p.out = (float*)d_out; p.ws = (unsigned char*)d_ws;
#if MK_N_LAUNCHES == 1
    p.ph_lo = 0; p.ph_hi = NPHASE;
    hipLaunchKernelGGL(mk_fwd, dim3(grid), dim3(NWAVES * 64), LDS_BYTES, stream, p);
#else
    for (int k = 0; k < NPHASE; ++k) { p.ph_lo = k; p.ph_hi = k + 1; hipLaunchKernelGGL(mk_fwd, dim3(grid), dim3(NWAVES * 64), LDS_BYTES, stream, p); }
#endif
}
```

```cpp
#include <hip/hip_runtime.h>
#include <cstdio>
#include <cstdint>

#ifndef MK_N_LAUNCHES
#define MK_N_LAUNCHES 1
#endif

__device__ __forceinline__ int lane_now() { int l; asm volatile("v_mbcnt_lo_u32_b32 %0, -1, 0\n\tv_mbcnt_hi_u32_b32 %0, -1, %0" : "=v"(l)); return l; }

namespace pg8 {
#define PG8_LAS __attribute__((address_space(3)))
typedef unsigned short bf16_t;
typedef short bf16x8 __attribute__((ext_vector_type(8)));
typedef float f32x4 __attribute__((ext_vector_type(4)));
typedef unsigned u32x4 __attribute__((ext_vector_type(4)));
constexpr int BM = 256, BK = 64, HALF = 128, HTB = HALF * BK * 2  , STAGE_BYTES = 8 * HTB, NXCD = 8, WGM = 8;

__host__ __device__ __forceinline__ int lds_byte(int r, int c) { const int st = (r >> 4) * 2 + (c >> 5), rr = r & 15, cc = c & 31, ob = rr * 64 + cc * 2; return st * 1024 + (ob ^ (((ob >> 9) & 1) << 5)); }
__host__ __device__ __forceinline__ void stage_rc(int b, int& R, int& C) { const int st = b / 1024, sb = b % 1024, swz = sb ^ (((sb >> 9) & 1) << 5); R = (st >> 1) * 16 + swz / 64; C = (st & 1) * 32 + (swz % 64) / 2; }
__host__ __device__ __forceinline__ int perm32(int rho) { const int n = rho >> 4, i = rho & 15; return 8 * (i >> 2) + 4 * n + (i & 3); }

struct Unit { int pm, pn; };
struct Gemm { const bf16_t* A; const bf16_t* Bt; int M, N, K; };

struct StaticOrder {
    int nM, nN, nwg, G, c;
    __host__ __device__ __forceinline__ void init(int M, int N, int G_, int c_) { nM = M / BM; nN = N / BM; nwg = nM * nN; G = G_; c = c_; }
    __host__ __device__ __forceinline__ bool next(int i, Unit& u) const {
        const long L = (long)i * G + c; if (L >= nwg) return false;
        int wgid = (int)L; { const int q = nwg / NXCD, r = nwg % NXCD, xcd = wgid % NXCD, off = wgid / NXCD; wgid = (xcd < r ? xcd * (q + 1) : r * (q + 1) + (xcd - r) * q) + off; }
        const int nig = WGM * nN, gid = wgid / nig, fm = gid * WGM, gsz = (nM - fm) < WGM ? (nM - fm) : WGM;
        u.pm = fm + ((wgid % nig) % gsz); u.pn = (wgid % nig) / gsz; return true;
    }
    __device__ __forceinline__ void a_ready(const Unit&) const {}
    __device__ __forceinline__ void done(const Unit&) const {}
};

template <class Epi, class Sched, bool ALIGN_EPI = false, bool SP2 = false>
__device__ __forceinline__ void gemm_phase(PG8_LAS unsigned char* lds, const Gemm g, const Sched& S, const Epi& E, const int wave_idx) {
    int tid_l = wave_idx * 64 + lane_now();
    const int tid = tid_l, wid = __builtin_amdgcn_readfirstlane(tid >> 6), lane = tid & 63, wr = wid >> 2, wc = wid & 3, fr = lane & 15, fq = lane >> 4;
    const int K = g.K, nt = K / BK;
    unsigned voffA[2], voffB[2];
#pragma unroll
    for (int i = 0; i < 2; ++i) { int R, C; stage_rc(tid * 16 + i * 8192, R, C); const int Rb = Epi::PERM ? ((R & ~31) + perm32(R & 31)) : R;
        const int Rp = (((R >> 6) * 16 + (R & 15)) * 8 + ((R >> 4) & 3)); voffA[i] = (unsigned)(Rp * K + C) * 2u; voffB[i] = (unsigned)(Rb * K + C) * 2u; }
    const size_t kstep = (size_t)(BK * 2);
    const size_t hstepB = (size_t)HALF * K * 2, hstepA = (size_t)4 * K * 2;
    const size_t tstep = 2 * hstepB;
    const unsigned ldsw = (unsigned)wid * 1024u;
    const int aoff = lds_byte(wr * 64 + fr, fq * 8), boff = lds_byte(wc * 32 + fr, fq * 8);
#define PG8_SA(b, h) (((b) * 2 + (h)) * HTB)
#define PG8_SB(b, h) ((4 + (b) * 2 + (h)) * HTB)
#define PG8_STAGE(bufoff, gbase, voff) do { _Pragma("unroll") for (int _i = 0; _i < 2; ++_i) \
        __builtin_amdgcn_global_load_lds((const unsigned*)((const char*)(gbase) + (voff)[_i]), (PG8_LAS unsigned*)(lds + (bufoff) + ldsw + _i * 8192), 16, 0, 0); } while (0)
#define PG8_LDA(dst, b, h) do { _Pragma("unroll") for (int m = 0; m < 4; ++m) _Pragma("unroll") for (int k = 0; k < 2; ++k) dst[m][k] = *(const PG8_LAS bf16x8*)(lds + PG8_SA(b, h) + aoff + m * 2048 + k * 1024); } while (0)
#define PG8_LDB(dst, b, h) do { _Pragma("unroll") for (int n = 0; n < 2; ++n) _Pragma("unroll") for (int k = 0; k < 2; ++k) dst[n][k] = *(const PG8_LAS bf16x8*)(lds + PG8_SB(b, h) + boff + n * 2048 + k * 1024); } while (0)
#define PG8_MMA(ai, bj, At, Bt) do { __builtin_amdgcn_s_setprio(1); _Pragma("unroll") for (int m = 0; m < 4; ++m) _Pragma("unroll") for (int n = 0; n < 2; ++n) _Pragma("unroll") for (int k = 0; k < 2; ++k) \
        acc[ai][bj][m][n] = __builtin_amdgcn_mfma_f32_16x16x32_bf16(Bt[n][k], At[m][k], acc[ai][bj][m][n], 0, 0, 0); __builtin_amdgcn_s_setprio(0); } while (0)
#define PG8_WAIT_V(n) asm volatile("s_waitcnt vmcnt(" #n ")" ::: "memory")
#define PG8_WAIT_L(n) asm volatile("s_waitcnt lgkmcnt(" #n ")" ::: "memory")
#define PG8_BAR __builtin_amdgcn_s_barrier()
#define PG8_SCHED __builtin_amdgcn_sched_barrier(0)
    Unit cur, nxt; int ui = 0;
    if (!S.next(0, cur)) return;
    f32x4 acc[2][2][4][2];
#pragma unroll
    for (int a = 0; a < 2; ++a)
#pragma unroll
        for (int b = 0; b < 2; ++b)
#pragma unroll
            for (int m = 0; m < 4; ++m)
#pragma unroll
                for (int n = 0; n < 2; ++n) acc[a][b][m][n] = (f32x4){0.f, 0.f, 0.f, 0.f};
    bf16x8 At[4][2], B0[2][2], B1[2][2];
    const char* cA = (const char*)g.A + (size_t)cur.pm * tstep; const char* cB = (const char*)g.Bt + (size_t)cur.pn * tstep;
    S.a_ready(cur);
    if constexpr (SP2) {
        PG8_STAGE(PG8_SB(0, 0), cB, voffB); PG8_STAGE(PG8_SB(0, 1), cB + hstepB, voffB); PG8_STAGE(PG8_SA(0, 0), cA, voffA); PG8_STAGE(PG8_SA(0, 1), cA + hstepA, voffA);
        if (wr == 1) PG8_BAR;
        PG8_WAIT_V(2); PG8_BAR;
        PG8_STAGE(PG8_SB(1, 0), cB + kstep, voffB); PG8_STAGE(PG8_SA(1, 0), cA + kstep, voffA); PG8_STAGE(PG8_SB(1, 1), cB + hstepB + kstep, voffB);
        PG8_WAIT_V(6); PG8_BAR;
    } else {
        PG8_STAGE(PG8_SB(0, 0), cB, voffB); PG8_STAGE(PG8_SA(0, 0), cA, voffA); PG8_STAGE(PG8_SB(0, 1), cB + hstepB, voffB); PG8_STAGE(PG8_SA(0, 1), cA + hstepA, voffA);
        if (wr == 1) PG8_BAR;
        PG8_WAIT_V(4); PG8_BAR;
        PG8_STAGE(PG8_SB(1, 0), cB + kstep, voffB); PG8_STAGE(PG8_SA(1, 0), cA + kstep, voffA); PG8_STAGE(PG8_SB(1, 1), cB + hstepB + kstep, voffB);
        PG8_WAIT_V(6); PG8_BAR;
    }
    for (;;) {
        const bool has_next = S.next(ui + 1, nxt);
        const char* nA = has_next ? (const char*)g.A + (size_t)nxt.pm * tstep : cA; const char* nB = has_next ? (const char*)g.Bt + (size_t)nxt.pn * tstep : cB;
        for (int t = 0; t < nt; t += 2) {
            const bool last = (t == nt - 2);
            const char* a1 = cA + (size_t)(t + 1) * kstep;
            const char* a2 = last ? nA : cA + (size_t)(t + 2) * kstep; const char* b2 = last ? nB : cB + (size_t)(t + 2) * kstep;
            const char* a3 = a2 + kstep; const char* b3 = b2 + kstep;
            if (last && has_next) S.a_ready(nxt);
            if constexpr (SP2) {
            PG8_LDB(B0, 0, 0); PG8_LDB(B1, 0, 1); PG8_SCHED; PG8_LDA(At, 0, 0); PG8_STAGE(PG8_SA(1, 1), a1 + hstepA, voffA);
            PG8_WAIT_V(8); PG8_WAIT_L(0); PG8_BAR; PG8_MMA(0, 0, At, B0); PG8_MMA(0, 1, At, B1); PG8_BAR; PG8_SCHED;
            PG8_LDA(At, 0, 1); PG8_STAGE(PG8_SB(0, 0), b2, voffB); PG8_STAGE(PG8_SB(0, 1), b2 + hstepB, voffB); PG8_STAGE(PG8_SA(0, 0), a2, voffA);
            PG8_WAIT_V(8); PG8_WAIT_L(0); PG8_BAR; PG8_MMA(1, 0, At, B0); PG8_MMA(1, 1, At, B1); PG8_BAR; PG8_SCHED;
            PG8_LDB(B0, 1, 0); PG8_LDB(B1, 1, 1); PG8_SCHED; PG8_LDA(At, 1, 0); PG8_STAGE(PG8_SA(0, 1), a2 + hstepA, voffA);
            PG8_WAIT_V(8); PG8_WAIT_L(0); PG8_BAR; PG8_MMA(0, 0, At, B0); PG8_MMA(0, 1, At, B1); PG8_BAR; PG8_SCHED;
            PG8_LDA(At, 1, 1); PG8_STAGE(PG8_SB(1, 0), b3, voffB); PG8_STAGE(PG8_SB(1, 1), b3 + hstepB, voffB); PG8_STAGE(PG8_SA(1, 0), a3, voffA);
            PG8_WAIT_V(8); PG8_WAIT_L(0); PG8_BAR; PG8_MMA(1, 0, At, B0); PG8_MMA(1, 1, At, B1); PG8_BAR; PG8_SCHED;
            } else {
            PG8_LDB(B0, 0, 0); PG8_SCHED; PG8_LDA(At, 0, 0); PG8_STAGE(PG8_SA(1, 1), a1 + hstepA, voffA);
            PG8_WAIT_L(8); PG8_BAR; PG8_WAIT_L(0); PG8_MMA(0, 0, At, B0); PG8_BAR; PG8_SCHED;
            PG8_LDB(B1, 0, 1); PG8_STAGE(PG8_SB(0, 0), b2, voffB);
            PG8_BAR; PG8_WAIT_L(0); PG8_MMA(0, 1, At, B1); PG8_BAR;
            PG8_LDA(At, 0, 1); PG8_STAGE(PG8_SA(0, 0), a2, voffA);
            PG8_BAR; PG8_WAIT_L(0); PG8_MMA(1, 0, At, B0); PG8_BAR; PG8_SCHED;
            PG8_STAGE(PG8_SB(0, 1), b2 + hstepB, voffB);
            PG8_WAIT_V(6); PG8_BAR; PG8_MMA(1, 1, At, B1); PG8_BAR;
            PG8_LDB(B0, 1, 0); PG8_SCHED; PG8_LDA(At, 1, 0); PG8_STAGE(PG8_SA(0, 1), a2 + hstepA, voffA);
            PG8_WAIT_L(8); PG8_BAR; PG8_WAIT_L(0); PG8_MMA(0, 0, At, B0); PG8_BAR; PG8_SCHED;
            PG8_LDB(B1, 1, 1); PG8_STAGE(PG8_SB(1, 0), b3, voffB);
            PG8_BAR; PG8_WAIT_L(0); PG8_MMA(0, 1, At, B1); PG8_BAR;
            PG8_LDA(At, 1, 1); PG8_STAGE(PG8_SA(1, 0), a3, voffA);
            PG8_BAR; PG8_WAIT_L(0); PG8_MMA(1, 0, At, B0); PG8_BAR; PG8_SCHED;
            PG8_STAGE(PG8_SB(1, 1), b3 + hstepB, voffB);
            PG8_WAIT_V(6); PG8_BAR; PG8_MMA(1, 1, At, B1); PG8_BAR;
            }
        }
        if constexpr (ALIGN_EPI) { if (wr == 0) PG8_BAR; }
        if constexpr (!Epi::AFTER_DRAIN) { E(acc, cur, wr, wc, fr, fq); S.done(cur); }
        if (!has_next) break;
#pragma unroll
        for (int a = 0; a < 2; ++a)
#pragma unroll
            for (int b = 0; b < 2; ++b)
#pragma unroll
                for (int m = 0; m < 4; ++m)
#pragma unroll
                    for (int n = 0; n < 2; ++n) acc[a][b][m][n] = (f32x4){0.f, 0.f, 0.f, 0.f};
        cur = nxt; cA = nA; cB = nB; ++ui;
        if constexpr (ALIGN_EPI) { if (wr == 1) PG8_BAR; }
    }
    PG8_WAIT_V(0);
    if constexpr (!ALIGN_EPI) { if (wr == 0) PG8_BAR; }
    PG8_BAR;
    if constexpr (Epi::AFTER_DRAIN) { E.fused(acc, cur, wr, wc, fr, fq, lds, wid, lane); S.done(cur); }
#undef PG8_SA
#undef PG8_SB
#undef PG8_STAGE
#undef PG8_LDA
#undef PG8_LDB
#undef PG8_MMA
#undef PG8_WAIT_V
#undef PG8_WAIT_L
#undef PG8_BAR
#undef PG8_SCHED
}
}

constexpr int NB = 8, SEQ = 2048, DM = 1024, M = NB * SEQ;
constexpr int DFF = 2816, NUP = 2 * DFF;
constexpr int NAB = 3840;
constexpr int NCI = 4096;
constexpr float EPS = 1e-6f, LOG2E = 1.4426950408889634f, LN2 = 0.6931471805599453f;

#define GAS __attribute__((address_space(1)))
#define LAS __attribute__((address_space(3)))
typedef unsigned short bf16;
typedef short bf16x8 __attribute__((ext_vector_type(8)));
typedef float f32x4 __attribute__((ext_vector_type(4)));
typedef float f32x2 __attribute__((ext_vector_type(2)));
typedef float f32x16 __attribute__((ext_vector_type(16)));
typedef unsigned u32x4 __attribute__((ext_vector_type(4)));
typedef unsigned u32x2 __attribute__((ext_vector_type(2)));
typedef __bf16 bf16x2v __attribute__((ext_vector_type(2)));
typedef GAS unsigned gu32;

constexpr size_t MiB = 1u << 20;
constexpr size_t WS_CTL = 0, CTL_ZERO_BYTES = 384 * 1024;
constexpr size_t WS_WCI = 1 * MiB, WS_WCO = 9 * MiB, WS_WUP1 = 11 * MiB, WS_WDN1 = 22 * MiB;
constexpr size_t WS_SSQA = 128 * 1024;
constexpr size_t WS_SSQ0 = 29 * MiB;
constexpr size_t WS_OSSQ = 29 * MiB + 512 * 1024;
constexpr size_t WS_HB = 32 * MiB;
constexpr size_t WS_EB = 43 * MiB, WS_FAC = 44 * MiB;
constexpr size_t WS_XB = 46 * MiB;
constexpr size_t WS_WAB = 78 * MiB, WS_WABO = 86 * MiB, WS_WUP0 = 88 * MiB, WS_WDN0 = 99 * MiB;
constexpr size_t WS_R = 105 * MiB;
constexpr size_t WS_Q = WS_R, WS_K = WS_R + 16 * MiB, WS_VT = WS_R + 32 * MiB, WS_IQ = WS_R + 48 * MiB, WS_U = WS_R + 80 * MiB, WS_VGT = WS_R + 96 * MiB,
                 WS_Y = WS_R + 112 * MiB, WS_SEL = WS_R + 144 * MiB, WS_IK = WS_R + 148 * MiB, WS_IW = WS_R + 150 * MiB;
constexpr size_t WS_SSQV = 28 * MiB;
constexpr size_t WS_ACT = WS_R;
constexpr size_t WS_GATE = 78 * MiB, WS_QM = 110 * MiB, WS_KM = 142 * MiB, WS_KMT = 174 * MiB, WS_IT = 206 * MiB;
constexpr size_t WS_ON = WS_QM;
constexpr size_t WS_END = 256 * MiB;
static_assert(WS_IW + (size_t)M * 16 * 4 <= WS_END && WS_SSQV + (size_t)M * 8 * 4 <= WS_SSQ0 && WS_IT + 32 * MiB <= WS_END && WS_WDN0 + (size_t)DM * DFF * 2 <= WS_R, "ws map");
constexpr int CW_BAR = 4096;
constexpr size_t WS_FCNT = 64 * 1024;

constexpr int RING_BYTES = 131072, LDSX_OFF = RING_BYTES, MISC_OFF = RING_BYTES + 12288, LDS_BYTES = 147456;
constexpr int NWAVES = 8;

#define RLX_AGENT __ATOMIC_RELAXED, __HIP_MEMORY_SCOPE_AGENT
__device__ __forceinline__ unsigned cvt_pk(float lo, float hi) { unsigned r; asm volatile("v_cvt_pk_bf16_f32 %0, %1, %2" : "=v"(r) : "v"(lo), "v"(hi)); return r; }
__device__ __forceinline__ float fexp2(float x) { return __builtin_amdgcn_exp2f(x); }
__device__ __forceinline__ float frcp(float x) { return __builtin_amdgcn_rcpf(x); }
__device__ __forceinline__ float fexp(float x) { return __builtin_amdgcn_exp2f(x * LOG2E); }
__device__ __forceinline__ float fsigmoid(float x) { return frcp(1.f + fexp2(-LOG2E * x)); }
__device__ __forceinline__ float fsilu(float x) { return x * fsigmoid(x); }
__device__ __forceinline__ float fgelu(float x) { const float u = 0.7978845608028654f * (x + 0.044715f * x * x * x); return x * frcp(1.f + fexp2(-2.f * LOG2E * u)); }
__device__ __forceinline__ f32x2 fsilu2(f32x2 x, f32x2 xe) {
    const f32x2 e = {fexp2(xe[0]), fexp2(xe[1])}, d = e + 1.f; const f32x2 rr = {frcp(d[0]), frcp(d[1])}; return x * rr; }
__device__ __forceinline__ f32x2 fgelu2(f32x2 x) {
    constexpr float C1 = -2.f * LOG2E * 0.7978845608028654f, C2 = C1 * 0.044715f;
    const f32x2 x2 = x * x, t = x2 * C2 + C1, a = x * t;
    const f32x2 e = {fexp2(a[0]), fexp2(a[1])}, d = e + 1.f; const f32x2 rr = {frcp(d[0]), frcp(d[1])}; return x * rr; }
__device__ __forceinline__ float bf2f(unsigned short v) { return __builtin_bit_cast(float, (unsigned)v << 16); }
template <int CTRL> __device__ __forceinline__ float dpp_f(float v) { return __builtin_bit_cast(float, __builtin_amdgcn_update_dpp(0, __builtin_bit_cast(int, v), CTRL, 0xF, 0xF, false)); }
__device__ __forceinline__ bf16x8 pack8(float a0, float a1, float a2, float a3, float a4, float a5, float a6, float a7) {
    u32x4 w; w.x = cvt_pk(a0, a1); w.y = cvt_pk(a2, a3); w.z = cvt_pk(a4, a5); w.w = cvt_pk(a6, a7); return __builtin_bit_cast(bf16x8, w); }
__device__ __forceinline__ u32x2 pack4(float a0, float a1, float a2, float a3) { u32x2 w; w.x = cvt_pk(a0, a1); w.y = cvt_pk(a2, a3); return w; }
__device__ __forceinline__ size_t frag_off(int r, int c, int C) { return ((size_t)((r >> 5) * (C >> 4) + (c >> 4)) * 64 + ((c >> 3) & 1) * 32 + (r & 31)) * 8 + (c & 7); }
__device__ __forceinline__ int swap23(int v) { return (v & ~12) | ((v & 4) << 1) | ((v & 8) >> 1); }
#define MFMA32(a, b, c) __builtin_amdgcn_mfma_f32_32x32x16_bf16((a), (b), (c), 0, 0, 0)
__device__ __forceinline__ float wave_sum(float v) {
#pragma unroll
    for (int o = 1; o < 64; o <<= 1) v += __shfl_xor(v, o);
    return v;
}

struct Params {
    const float *x, *rel_bias, *hgrn_lb, *mix_norm, *ffn_norm, *final_norm, *ab_w_in, *ab_idx_k_norm, *ab_gmlp_norm, *ab_w_s, *ab_b_s, *ab_w_out,
                *c_w_in, *c_out_norm, *c_w_out, *ffn_w_up, *ffn_conv_w, *ffn_conv_b, *ffn_w_down;
    float* out; unsigned char* ws; int ph_lo, ph_hi;
};

template <int NP> __device__ __forceinline__ void row_scales(const float* ssq, int tok0, float (&r)[8]) {
#pragma unroll
    for (int j = 0; j < 8; ++j) {
        float s = 0.f;
        if (NP == 1) s = ssq[tok0 + j];
        else {
#pragma unroll
            for (int q = 0; q < NP / 4; ++q) { const f32x4 v = *(const f32x4*)(ssq + (size_t)(tok0 + j) * NP + 4 * q); s += (v[0] + v[1]) + (v[2] + v[3]); }
        }
        r[j] = 1.0f / sqrtf(s * (1.0f / DM) + EPS);
    }
}

#define ACC(j, bj, n, i) acc[(j) >> 2][bj][(j) & 3][n][i]
typedef pg8::Unit Unit;

struct EpiAB {
    static constexpr bool PERM = true, AFTER_DRAIN = false;
    unsigned char* ws; const float* ikg;
    __device__ __forceinline__ void operator()(const f32x4 (&acc)[2][2][4][2], const Unit& u, int wr, int wc, int fr, int fq) const {
        asm volatile("; epilogue-local lane coordinates" : "+v"(fr), "+v"(fq));
        const int tok0 = u.pm * 256 + (wr * 16 + fr) * 8, b = tok0 >> 11, s0 = tok0 & 2047, pn = u.pn;
        bf16* const IK = (bf16*)(ws + WS_IK); float* const IW = (float*)(ws + WS_IW); float* const SSQV = (float*)(ws + WS_SSQV);
        float r[8]; row_scales<1>((const float*)(ws + WS_SSQ0), tok0, r);
        const int cb = 32 * wc + 8 * fq;
        if (pn == 14) {
            if (wc == 0) {
                f32x4 gk[2][2];
#pragma unroll
                for (int bj = 0; bj < 2; ++bj) { gk[bj][0] = *(const f32x4*)(ikg + 32 * bj + 8 * fq); gk[bj][1] = *(const f32x4*)(ikg + 32 * bj + 8 * fq + 4); }
#pragma unroll
                for (int j = 0; j < 8; ++j) { f32x4 x[2][2]; float s = 0.f;
#pragma unroll
                    for (int bj = 0; bj < 2; ++bj)
#pragma unroll
                        for (int n = 0; n < 2; ++n) { x[bj][n] = acc[j >> 2][bj][j & 3][n] * r[j]; s += (x[bj][n][0] * x[bj][n][0] + x[bj][n][1] * x[bj][n][1]) + (x[bj][n][2] * x[bj][n][2] + x[bj][n][3] * x[bj][n][3]); }
                    s += __shfl_xor(s, 16); s += __shfl_xor(s, 32);
                    const float rn = 1.0f / sqrtf(s * (1.0f / 64.0f) + EPS);
#pragma unroll
                    for (int bj = 0; bj < 2; ++bj) { const int d0 = 32 * bj + 8 * fq; const f32x4 g0 = gk[bj][0], g1 = gk[bj][1];
                        const f32x4 y0 = x[bj][0] * rn * g0, y1 = x[bj][1] * rn * g1;
                        *(bf16x8*)(IK + frag_off(tok0 + j, d0, 64)) = pack8(y0[0], y0[1], y0[2], y0[3], y1[0], y1[1], y1[2], y1[3]); }
                    __builtin_amdgcn_sched_barrier(0); }
            } else if (wc == 1 && fq < 2) {
#pragma unroll
                for (int j = 0; j < 8; ++j) { const float rs = r[j] * 0.03125f;
                    *(f32x4*)(IW + (size_t)(tok0 + j) * 16 + 8 * fq) = acc[j >> 2][0][j & 3][0] * rs; *(f32x4*)(IW + (size_t)(tok0 + j) * 16 + 8 * fq + 4) = acc[j >> 2][0][j & 3][1] * rs; }
            }
        } else if (pn == 4 || pn == 5 || pn == 12 || pn == 13) {
            const bool isvg = pn >= 12; bf16* tb = (bf16*)(ws + (isvg ? WS_VGT : WS_VT)); const int pt = isvg ? pn - 12 : pn - 4;
            f32x2 ss2[8];
#pragma unroll
            for (int j = 0; j < 8; ++j) ss2[j] = f32x2{0.f, 0.f};
#pragma unroll
            for (int bj = 0; bj < 2; ++bj) { const int col = pt * 256 + 128 * bj + cb;
#pragma unroll
                for (int n = 0; n < 2; ++n)
#pragma unroll
                    for (int ip = 0; ip < 2; ++ip) { f32x2 v[8];
#pragma unroll
                        for (int j = 0; j < 8; ++j) { const f32x4 a = acc[j >> 2][bj][j & 3][n];
                            v[j] = (ip ? __builtin_shufflevector(a, a, 2, 3) : __builtin_shufflevector(a, a, 0, 1)) * r[j]; if (isvg) { v[j] = fgelu2(v[j]); ss2[j] = ss2[j] + v[j] * v[j]; } }
#pragma unroll
                        for (int e = 0; e < 2; ++e) {
                            bf16* base = tb + (size_t)b * (512 * 2048) + frag_off(col + 4 * n + 2 * ip + e, (s0 & ~15) + 4 * ((s0 >> 3) & 1), 2048);
                            *(u32x2*)base = pack4(v[0][e], v[1][e], v[2][e], v[3][e]); *(u32x2*)(base + 256) = pack4(v[4][e], v[5][e], v[6][e], v[7][e]); }
                        __builtin_amdgcn_sched_barrier(0); } }
            float ss[8];
#pragma unroll
            for (int j = 0; j < 8; ++j) ss[j] = ss2[j][0] + ss2[j][1];
            if (isvg) {
#pragma unroll
                for (int j = 0; j < 8; ++j) { float s = ss[j]; s += __shfl_xor(s, 16); s += __shfl_xor(s, 32); if (fq == 0) SSQV[(size_t)(tok0 + j) * 8 + pt * 4 + wc] = s; }
            }
        } else {
            const bool isqk = pn < 4, isu = pn >= 10;
            bf16* dst = (bf16*)(ws + (isqk ? WS_Q + (size_t)(pn >> 1) * (WS_K - WS_Q) : (isu ? WS_U : WS_IQ)));
            const int pt = isqk ? (pn & 1) : (isu ? pn - 10 : pn - 6);
            const float sc = pn < 2 ? 0.125f * LOG2E : 1.0f;
            const int sA = isqk ? 8 : (isu ? 512 : 0), sB = (isqk || isu) ? 0 : 2048, sC = (isqk || isu) ? 0 : 32;
#pragma unroll
            for (int bj = 0; bj < 2; ++bj) { const int col = pt * 256 + 128 * bj + cb, hd = col >> 6, d0 = col & 63;
                const size_t o0 = isqk ? (size_t)(b * 8 + hd) * (2048 * 64) + frag_off(s0, d0, 64) : (isu ? (size_t)tok0 * 512 + col : frag_off((tok0 >> 1) * 32 + (hd & 3) + 8 * (hd >> 2), d0, 64));
                bf16* dp = dst + o0;
#pragma unroll
                for (int j = 0; j < 8; ++j) { const float rs = r[j] * sc; const f32x4 a0 = acc[j >> 2][bj][j & 3][0], a1 = acc[j >> 2][bj][j & 3][1];
                    f32x2 p0 = __builtin_shufflevector(a0, a0, 0, 1) * rs, p1 = __builtin_shufflevector(a0, a0, 2, 3) * rs, p2 = __builtin_shufflevector(a1, a1, 0, 1) * rs, p3 = __builtin_shufflevector(a1, a1, 2, 3) * rs;
                    if (isu) { p0 = fgelu2(p0); p1 = fgelu2(p1); p2 = fgelu2(p2); p3 = fgelu2(p3); }
                    *(bf16x8*)(dp + (size_t)(j * sA + (j >> 1) * sB + (j & 1) * sC)) = pack8(p0[0], p0[1], p1[0], p1[1], p2[0], p2[1], p3[0], p3[1]);
                    __builtin_amdgcn_sched_barrier(0); } }
        }
    }
};

struct EpiRes {
    static constexpr bool PERM = true, AFTER_DRAIN = false;
    bf16* XB; float* ssq;
    __device__ __forceinline__ void operator()(const f32x4 (&acc)[2][2][4][2], const Unit& u, int wr, int wc, int fr, int fq) const {
        asm volatile("; epilogue-local lane coordinates" : "+v"(fr), "+v"(fq));
        const int tok0 = u.pm * 256 + (wr * 16 + fr) * 8;
        float sj[4];
#pragma unroll
        for (int j = 0; j < 8; ++j) { const size_t ro = (size_t)(tok0 + j) * DM; float s = 0.f;
#pragma unroll
            for (int bj = 0; bj < 2; ++bj) { const int col = u.pn * 256 + 128 * bj + 32 * wc + 8 * fq;
                const u32x4 xb = *(const u32x4*)(XB + ro + col);
                f32x4 v0, v1;
                v0[0] = __builtin_bit_cast(float, xb.x << 16); v0[1] = __builtin_bit_cast(float, xb.x & 0xffff0000u); v0[2] = __builtin_bit_cast(float, xb.y << 16); v0[3] = __builtin_bit_cast(float, xb.y & 0xffff0000u);
                v1[0] = __builtin_bit_cast(float, xb.z << 16); v1[1] = __builtin_bit_cast(float, xb.z & 0xffff0000u); v1[2] = __builtin_bit_cast(float, xb.w << 16); v1[3] = __builtin_bit_cast(float, xb.w & 0xffff0000u);
                v0 += acc[j >> 2][bj][j & 3][0]; v1 += acc[j >> 2][bj][j & 3][1];
                *(bf16x8*)(XB + ro + col) = pack8(v0[0], v0[1], v0[2], v0[3], v1[0], v1[1], v1[2], v1[3]);
                s += (v0[0] * v0[0] + v0[1] * v0[1]) + (v0[2] * v0[2] + v0[3] * v0[3]) + (v1[0] * v1[0] + v1[1] * v1[1]) + (v1[2] * v1[2] + v1[3] * v1[3]); }
            s += __shfl_xor(s, 16); s += __shfl_xor(s, 32);
            sj[j & 3] = s;
            if ((j & 3) == 3) { const float sv = fq == 0 ? sj[0] : (fq == 1 ? sj[1] : (fq == 2 ? sj[2] : sj[3]));
                __hip_atomic_fetch_add(ssq + tok0 + (j & ~3) + fq, sv, __ATOMIC_RELAXED, __HIP_MEMORY_SCOPE_AGENT); }
            __builtin_amdgcn_sched_barrier(0); }
    }
};

struct EpiFinal {
    static constexpr bool PERM = true, AFTER_DRAIN = false;
    const bf16* XB; float* out; float* ssq; unsigned* cnt; const float* gain;
    __device__ __forceinline__ void operator()(f32x4 (&acc)[2][2][4][2], const Unit& u, int wr, int wc, int fr, int fq) const {
        asm volatile("; epilogue-local lane coordinates" : "+v"(fr), "+v"(fq));
        const int tok0 = u.pm * 256 + (wr * 16 + fr) * 8, col0 = u.pn * 256 + 32 * wc + 8 * fq;
        float sj[4];
#pragma unroll
        for (int j = 0; j < 8; ++j) { const size_t ro = (size_t)(tok0 + j) * DM; float s = 0.f;
#pragma unroll
            for (int bj = 0; bj < 2; ++bj) { const int col = col0 + 128 * bj;
                const u32x4 xb = *(const u32x4*)(XB + ro + col);
                f32x4 v0, v1;
                v0[0] = __builtin_bit_cast(float, xb.x << 16); v0[1] = __builtin_bit_cast(float, xb.x & 0xffff0000u); v0[2] = __builtin_bit_cast(float, xb.y << 16); v0[3] = __builtin_bit_cast(float, xb.y & 0xffff0000u);
                v1[0] = __builtin_bit_cast(float, xb.z << 16); v1[1] = __builtin_bit_cast(float, xb.z & 0xffff0000u); v1[2] = __builtin_bit_cast(float, xb.w << 16); v1[3] = __builtin_bit_cast(float, xb.w & 0xffff0000u);
                v0 += acc[j >> 2][bj][j & 3][0]; v1 += acc[j >> 2][bj][j & 3][1];
                acc[j >> 2][bj][j & 3][0] = v0; acc[j >> 2][bj][j & 3][1] = v1;
                s += (v0[0] * v0[0] + v0[1] * v0[1]) + (v0[2] * v0[2] + v0[3] * v0[3]) + (v1[0] * v1[0] + v1[1] * v1[1]) + (v1[2] * v1[2] + v1[3] * v1[3]); }
            s += __shfl_xor(s, 16); s += __shfl_xor(s, 32);
            sj[j & 3] = s;
            if ((j & 3) == 3) { const float sv = fq == 0 ? sj[0] : (fq == 1 ? sj[1] : (fq == 2 ? sj[2] : sj[3]));
                __hip_atomic_fetch_add(ssq + tok0 + (j & ~3) + fq, sv, __ATOMIC_RELAXED, __HIP_MEMORY_SCOPE_AGENT); }
            __builtin_amdgcn_sched_barrier(0); }
        f32x4 gq[2][2];
#pragma unroll
        for (int bj = 0; bj < 2; ++bj) { gq[bj][0] = *(const f32x4*)(gain + col0 + 128 * bj); gq[bj][1] = *(const f32x4*)(gain + col0 + 128 * bj + 4); }
        asm volatile("s_waitcnt vmcnt(0)" ::: "memory");
        unsigned* c = cnt + 64 * u.pm;
        if (fq == 0 && fr == 0) {
            __hip_atomic_fetch_add(c, 1u, __ATOMIC_RELAXED, __HIP_MEMORY_SCOPE_AGENT);
            unsigned spins = 0;
            while (__hip_atomic_load(c, __ATOMIC_RELAXED, __HIP_MEMORY_SCOPE_AGENT) < 32u) { __builtin_amdgcn_s_sleep(2); if (++spins > (1u << 20)) break; }
        }
        asm volatile("" ::: "memory");
        float r[8];
#pragma unroll
        for (int j = 0; j < 8; ++j) { const float s = __hip_atomic_load(ssq + tok0 + j, __ATOMIC_RELAXED, __HIP_MEMORY_SCOPE_AGENT); r[j] = 1.0f / sqrtf(s * (1.0f / DM) + EPS); }
#pragma unroll
        for (int bj = 0; bj < 2; ++bj) { const int col = col0 + 128 * bj; const f32x4 g0 = gq[bj][0], g1 = gq[bj][1];
#pragma unroll
            for (int j = 0; j < 8; ++j) { const size_t ro = (size_t)(tok0 + j) * DM;
                *(f32x4*)(out + ro + col) = acc[j >> 2][bj][j & 3][0] * r[j] * g0; *(f32x4*)(out + ro + col + 4) = acc[j >> 2][bj][j & 3][1] * r[j] * g1; } }
    }
};

struct EpiConv {
    static constexpr bool PERM = true, AFTER_DRAIN = false;
    const float* ssq; const float* cw; const float* cbias; bf16* ACT; float* HB;
    __device__ __forceinline__ void operator()(const f32x4 (&acc)[2][2][4][2], const Unit& u, int wr, int wc, int fr, int fq) const {
        asm volatile("; epilogue-local lane coordinates" : "+v"(fr), "+v"(fq));
        const int tok0 = u.pm * 256 + (wr * 16 + fr) * 8, ca0 = u.pn * 128 + 32 * wc + 8 * fq;
        f32x4 wa[2][3], wb[2][3], ba[2], bb[2];
#pragma unroll
        for (int n = 0; n < 2; ++n) { const int ca = ca0 + 4 * n, cbn = DFF + ca;
#pragma unroll
            for (int tp = 0; tp < 3; ++tp) { wa[n][tp] = *(const f32x4*)(cw + tp * NUP + ca); wb[n][tp] = *(const f32x4*)(cw + tp * NUP + cbn); }
            ba[n] = *(const f32x4*)(cbias + ca); bb[n] = *(const f32x4*)(cbias + cbn); }
        float r[8]; row_scales<1>(ssq, tok0, r);
        const int grp = 2 * u.pm + wr;
        float* hp15 = HB + ((size_t)grp * 4) * NUP; float* hp0 = HB + ((size_t)grp * 4 + 2) * NUP;
        unsigned w[8][4];
#define EC_PAIR(V_) (ip ? __builtin_shufflevector(V_, V_, 2, 3) : __builtin_shufflevector(V_, V_, 0, 1))
#pragma unroll
        for (int n = 0; n < 2; ++n) { const int ca = ca0 + 4 * n, cbn = DFF + ca;
#pragma unroll
            for (int ip = 0; ip < 2; ++ip) {
                const f32x2 WA0 = EC_PAIR(wa[n][0]) * (-LOG2E), WA1 = EC_PAIR(wa[n][1]) * (-LOG2E), WA2 = EC_PAIR(wa[n][2]) * (-LOG2E), BA = EC_PAIR(ba[n]) * (-LOG2E);
                const f32x2 WB0 = EC_PAIR(wb[n][0]) * (-LN2), WB1 = EC_PAIR(wb[n][1]) * (-LN2), WB2 = EC_PAIR(wb[n][2]) * (-LN2), BB = EC_PAIR(bb[n]) * (-LN2);
                f32x2 HA[8], HBv[8];
#pragma unroll
                for (int j = 0; j < 8; ++j) { HA[j] = EC_PAIR(acc[j >> 2][0][j & 3][n]) * r[j]; HBv[j] = EC_PAIR(acc[j >> 2][1][j & 3][n]) * r[j]; }
                const f32x2 PA6 = {dpp_f<0x111>(HA[6][0]), dpp_f<0x111>(HA[6][1])}, PA7 = {dpp_f<0x111>(HA[7][0]), dpp_f<0x111>(HA[7][1])};
                const f32x2 PB6 = {dpp_f<0x111>(HBv[6][0]), dpp_f<0x111>(HBv[6][1])}, PB7 = {dpp_f<0x111>(HBv[7][0]), dpp_f<0x111>(HBv[7][1])};
                const int i0 = 2 * ip;
                if (fr == 15) { *(f32x2*)(hp15 + ca + i0) = HA[6]; *(f32x2*)(hp15 + cbn + i0) = HBv[6]; *(f32x2*)(hp15 + NUP + ca + i0) = HA[7]; *(f32x2*)(hp15 + NUP + cbn + i0) = HBv[7]; }
                if (fr == 0) { *(f32x2*)(hp0 + ca + i0) = HA[0]; *(f32x2*)(hp0 + cbn + i0) = HBv[0]; *(f32x2*)(hp0 + NUP + ca + i0) = HA[1]; *(f32x2*)(hp0 + NUP + cbn + i0) = HBv[1]; }
#pragma unroll
                for (int j = 0; j < 8; ++j) {
                    const f32x2 AM1 = j >= 1 ? HA[j >= 1 ? j - 1 : 0] : PA7, AM2 = j >= 2 ? HA[j >= 2 ? j - 2 : 0] : (j == 1 ? PA7 : PA6);
                    const f32x2 BM1 = j >= 1 ? HBv[j >= 1 ? j - 1 : 0] : PB7, BM2 = j >= 2 ? HBv[j >= 2 ? j - 2 : 0] : (j == 1 ? PB7 : PB6);
                    const f32x2 YA = BA + WA2 * HA[j] + WA1 * AM1 + WA0 * AM2, YB = BB + WB2 * HBv[j] + WB1 * BM1 + WB0 * BM2;
                    const f32x2 E = {fexp2(YA[0]), fexp2(YA[1])};
                    const f32x2 D = E + 1.f;
                    const f32x2 R = {frcp(D[0]), frcp(D[1])};
                    const f32x2 O = (YA * YB) * R;
                    w[j][2 * n + ip] = cvt_pk(O[0], O[1]);
                }
                __builtin_amdgcn_sched_barrier(0);
            }
        }
#undef EC_PAIR
#pragma unroll
        for (int j = 0; j < 8; ++j) if (!(fr == 0 && j < 2)) { u32x4 v; v.x = w[j][0]; v.y = w[j][1]; v.z = w[j][2]; v.w = w[j][3]; *(u32x4*)(ACT + (size_t)(tok0 + j) * DFF + ca0) = v; }
    }
};

struct EpiHg {
    static constexpr bool PERM = true, AFTER_DRAIN = false;
    unsigned char* ws; const float* hlb;
    __device__ __forceinline__ void operator()(const f32x4 (&acc)[2][2][4][2], const Unit& u, int wr, int wc, int fr, int fq) const {
        asm volatile("; epilogue-local lane coordinates" : "+v"(fr), "+v"(fq));
        const int tok0 = u.pm * 256 + (wr * 16 + fr) * 8, b = tok0 >> 11, s0 = tok0 & 2047, pn = u.pn;
        float r[8]; row_scales<1>((const float*)(ws + WS_SSQA) + M, tok0, r);
        const int cb = 32 * wc + 8 * fq;
        if (pn < 8) {
            bf16* const QM = (bf16*)(ws + WS_QM); bf16* const KM = (bf16*)(ws + WS_KM); bf16* const KMT = (bf16*)(ws + WS_KMT); float* const EB = (float*)(ws + WS_EB); float* const FAC = (float*)(ws + WS_FAC);
            const int h = pn, chunk = s0 >> 6, lane = fq * 16 + fr, f7 = fr & 7;
            float lb8[8];
            { const f32x4 l1a = *(const f32x4*)(hlb + 1024 + h * 128 + cb), l1b = *(const f32x4*)(hlb + 1024 + h * 128 + cb + 4), l0a = *(const f32x4*)(hlb + h * 128 + cb), l0b = *(const f32x4*)(hlb + h * 128 + cb + 4);
#pragma unroll
              for (int i = 0; i < 4; ++i) { lb8[i] = fsigmoid(l1a[i] - l0a[i]); lb8[4 + i] = fsigmoid(l1b[i] - l0b[i]); } }
            unsigned wq[8][4], wk[8][4];
            float rf[8];
#pragma unroll
            for (int j = 0; j < 8; ++j) rf[j] = r[j] * (-LOG2E);
#define HG_PAIR(V_) (ip ? __builtin_shufflevector(V_, V_, 2, 3) : __builtin_shufflevector(V_, V_, 0, 1))
#pragma unroll
            for (int n = 0; n < 2; ++n) {
#pragma unroll
                for (int ip = 0; ip < 2; ++ip) { const int d0 = cb + 4 * n + 2 * ip;
                    const f32x2 LB = {lb8[4 * n + 2 * ip], lb8[4 * n + 2 * ip + 1]}, OML = 1.f - LB;
                    f32x2 BC[8], KK[8], QS[8], RUN = {0.f, 0.f};
#pragma unroll
                    for (int j = 0; j < 8; ++j) { const f32x2 QV = HG_PAIR(acc[j >> 2][0][j & 3][n]) * r[j], FE = HG_PAIR(acc[j >> 2][1][j & 3][n]) * rf[j];
                        const f32x2 E1 = {fexp2(FE[0]), fexp2(FE[1])}, D1 = E1 + 1.f;
                        const f32x2 SG = {frcp(D1[0]), frcp(D1[1])};
                        const f32x2 G = LB + OML * SG;
                        const f32x2 LG = {__builtin_amdgcn_logf(G[0]), __builtin_amdgcn_logf(G[1])};
                        RUN = RUN + LG; BC[j] = RUN; KK[j] = OML - OML * SG;
                        const f32x2 QE = QV * (-LOG2E);
                        const f32x2 E2 = {fexp2(QE[0]), fexp2(QE[1])}, D2 = E2 + 1.f;
                        const f32x2 RQ = {frcp(D2[0]), frcp(D2[1])};
                        QS[j] = QV * RQ; }
                    f32x2 EXCL, BREF;
#pragma unroll
                    for (int e = 0; e < 2; ++e) { const float run = RUN[e]; float xs = run, t;
                        t = dpp_f<0x111>(xs); if (f7 >= 1) xs += t;
                        t = dpp_f<0x112>(xs); if (f7 >= 2) xs += t;
                        t = dpp_f<0x114>(xs); if (f7 >= 4) xs += t;
                        const float excl = xs - run, bl = __shfl(xs, (lane & ~7) + 7), bref = __shfl(xs, (lane & ~7) + 3);
                        EXCL[e] = excl; BREF[e] = bref;
                        const int lam = swap23(d0 + e);
                        if (f7 == 0) { const size_t o = ((size_t)((b * 32 + chunk) * 8 + h)) * 128 + lam; EB[o] = fexp2(bref); FAC[o] = fexp2(bl - bref); } }
#pragma unroll
                    for (int j = 0; j < 8; ++j) { const f32x2 BB = EXCL + BC[j], DQ = BB - BREF, DK = BREF - BB;
                        const f32x2 XQ = {fexp2(fminf(DQ[0], 80.f * LOG2E)), fexp2(fminf(DQ[1], 80.f * LOG2E))}, XK = {fexp2(fminf(DK[0], 80.f * LOG2E)), fexp2(fminf(DK[1], 80.f * LOG2E))};
                        QS[j] = QS[j] * XQ; KK[j] = KK[j] * XK;
                        wq[j][2 * n + ip] = cvt_pk(QS[j][0], QS[j][1]); wk[j][2 * n + ip] = cvt_pk(KK[j][0], KK[j][1]); }
#pragma unroll
                    for (int e = 0; e < 2; ++e) { const int lam = swap23(d0 + e);
                        bf16* base = KMT + (size_t)(b * 8 + h) * (128 * 2048) + frag_off(lam, (s0 & ~15) + 4 * ((s0 >> 3) & 1), 2048);
                        *(u32x2*)base = pack4(KK[0][e], KK[1][e], KK[2][e], KK[3][e]); *(u32x2*)(base + 256) = pack4(KK[4][e], KK[5][e], KK[6][e], KK[7][e]); }
                    __builtin_amdgcn_sched_barrier(0);
                }
            }
#undef HG_PAIR
            { const size_t o0 = (size_t)(b * 8 + h) * (2048 * 128) + frag_off(s0, cb, 128);
#pragma unroll
              for (int j = 0; j < 8; ++j) { u32x4 a; a.x = wq[j][0]; a.y = wq[j][1]; a.z = wq[j][2]; a.w = wq[j][3]; u32x4 c; c.x = wk[j][0]; c.y = wk[j][1]; c.z = wk[j][2]; c.w = wk[j][3];
                  *(u32x4*)(QM + o0 + 8 * j) = a; *(u32x4*)(KM + o0 + 8 * j) = c; } }
        } else if (pn < 12) {
            bf16* const IT = (bf16*)(ws + WS_IT);
#pragma unroll
            for (int bj = 0; bj < 2; ++bj) { const int col = (pn - 8) * 256 + 128 * bj + cb;
#pragma unroll
                for (int n = 0; n < 2; ++n)
#pragma unroll
                    for (int i = 0; i < 4; ++i) {
                        const int ci = col + 4 * n + i;
                        bf16* base = IT + (size_t)(b * 8 + (ci >> 7)) * (128 * 2048) + frag_off(ci & 127, (s0 & ~15) + 4 * ((s0 >> 3) & 1), 2048);
                        *(u32x2*)base = pack4(ACC(0, bj, n, i) * r[0], ACC(1, bj, n, i) * r[1], ACC(2, bj, n, i) * r[2], ACC(3, bj, n, i) * r[3]);
                        *(u32x2*)(base + 256) = pack4(ACC(4, bj, n, i) * r[4], ACC(5, bj, n, i) * r[5], ACC(6, bj, n, i) * r[6], ACC(7, bj, n, i) * r[7]);
                        __builtin_amdgcn_sched_barrier(0); } }
        } else {
            bf16* const GATE = (bf16*)(ws + WS_GATE);
#pragma unroll
            for (int bj = 0; bj < 2; ++bj) { const int col = (pn - 12) * 256 + 128 * bj + cb;
#pragma unroll
                for (int j = 0; j < 8; ++j) { const f32x4 a0 = acc[j >> 2][bj][j & 3][0], a1 = acc[j >> 2][bj][j & 3][1]; const float rj = r[j], rfj = rj * (-LOG2E);
                    const f32x2 p0 = __builtin_shufflevector(a0, a0, 0, 1), p1 = __builtin_shufflevector(a0, a0, 2, 3), p2 = __builtin_shufflevector(a1, a1, 0, 1), p3 = __builtin_shufflevector(a1, a1, 2, 3);
                    const f32x2 o0 = fsilu2(p0 * rj, p0 * rfj), o1 = fsilu2(p1 * rj, p1 * rfj), o2 = fsilu2(p2 * rj, p2 * rfj), o3 = fsilu2(p3 * rj, p3 * rfj);
                    *(bf16x8*)(GATE + (size_t)(tok0 + j) * 1024 + col) = pack8(o0[0], o0[1], o1[0], o1[1], o2[0], o2[1], o3[0], o3[1]);
                    __builtin_amdgcn_sched_barrier(0); } }
        }
    }
};

#define XB_TMO      128
#define XB_XCNT(j)  (256  + 64 * (j))
#define XB_XSUB(j)  (1280 + 64 * (j))
#define XB_XGEN(j)  (2304 + 64 * (j))
#define XB_TOP      3328
#define XB_TOPGEN   3392
#define XCD_BAR_WORDS 3456
#define XB_SPIN_CAP (1u << 18)
__device__ __forceinline__ unsigned xb_ld(unsigned* p)              { return __hip_atomic_load(p, __ATOMIC_RELAXED, __HIP_MEMORY_SCOPE_AGENT); }
__device__ __forceinline__ unsigned xb_add(unsigned* p, unsigned v) { return __hip_atomic_fetch_add(p, v, __ATOMIC_RELAXED, __HIP_MEMORY_SCOPE_AGENT); }
__device__ __forceinline__ unsigned xb_xcc_id() { return (unsigned)__builtin_amdgcn_s_getreg((3 << 11) | 20) & 0xFu; }
#define XB_SPIN(cond, bar) do { unsigned _sp = 0; while (cond) { __builtin_amdgcn_s_sleep(1); \
    if ((++_sp & 255u) == 0u) { if (xb_ld(&(bar)[XB_TMO])) break; if (_sp > XB_SPIN_CAP) { atomicAdd(&(bar)[XB_TMO], 1u); break; } } } } while (0)
struct XcdBarrier { unsigned* bar; unsigned x; volatile LAS unsigned* st; };
__device__ __forceinline__ XcdBarrier xcd_barrier_post(unsigned* bar, volatile LAS unsigned* st, bool t0) {
    XcdBarrier b; b.bar = bar; b.x = xb_xcc_id(); b.st = st;
    if (t0) (void)xb_add(&bar[XB_XCNT(b.x)], 1u);
    return b;
}
__device__ __forceinline__ void xcd_barrier_complete(unsigned* bar, unsigned x, unsigned& nloc, unsigned& nx) {
    const unsigned G = gridDim.x * gridDim.y * gridDim.z;
    unsigned sum, cnt, mine, sp = 0u;
    for (;;) {
        sum = 0u; cnt = 0u; mine = 0u;
#pragma unroll
        for (unsigned j = 0; j < 16; ++j) { const unsigned c = xb_ld(&bar[XB_XCNT(j)]); sum += c; cnt += (c > 0u) ? 1u : 0u; mine = (j == x) ? c : mine; }
        if (sum == G) break;
        __builtin_amdgcn_s_sleep(1);
        if ((++sp & 255u) == 0u) { if (xb_ld(&bar[XB_TMO])) break; if (sp > XB_SPIN_CAP) { atomicAdd(&bar[XB_TMO], 1u); break; } }
    }
    nloc = mine > 0u ? mine : 1u; nx = cnt > 0u ? cnt : 1u;
}
__device__ __forceinline__ void xcd_barrier(const XcdBarrier& b, bool t0) {
    asm volatile("s_waitcnt vmcnt(0)" ::: "memory");
    __syncthreads();
    if (t0) {
        unsigned* bar = b.bar;
        __builtin_amdgcn_s_waitcnt(0);
        unsigned nloc = b.st[0], nx = b.st[1];
        if (nloc == 0u) { xcd_barrier_complete(bar, b.x, nloc, nx); b.st[0] = nloc; b.st[1] = nx; }
        const unsigned old = xb_add(&bar[XB_XSUB(b.x)], 1u);
        const unsigned gen = old / nloc;
        if (old + 1u == (gen + 1u) * nloc) {
            __builtin_amdgcn_fence(__ATOMIC_RELEASE, "agent");
            asm volatile("s_waitcnt vmcnt(0)" ::: "memory");
            const unsigned og = xb_add(&bar[XB_TOP], 1u);
            const unsigned tg = og / nx;
            if (og + 1u == (tg + 1u) * nx) xb_add(&bar[XB_TOPGEN], 1u);
            else XB_SPIN(xb_ld(&bar[XB_TOPGEN]) == tg, bar);
            __builtin_amdgcn_fence(__ATOMIC_ACQUIRE, "agent");
            xb_add(&bar[XB_XGEN(b.x)], 1u);
            asm volatile("s_waitcnt vmcnt(0)" ::: "memory");
        } else {
            XB_SPIN(xb_ld(&bar[XB_XGEN(b.x)]) == gen, bar);
            __builtin_amdgcn_fence(__ATOMIC_ACQUIRE, "agent");
            asm volatile("s_waitcnt vmcnt(0)" ::: "memory");
        }
    }
    __syncthreads();
}

__device__ __forceinline__ void conv_item(const float* W, int K, int N, int src0, int nvalid, const float* gain, bf16* WT, int dst_row0, int kb, LAS float* scr, int lane) {
    const int k0 = 64 * kb, cl = lane & 31;
#pragma unroll 8
    for (int i = 0; i < 32; ++i) { const int kk = 2 * i + (lane >> 5); float v = 0.f; if (cl < nvalid) { v = W[(size_t)(k0 + kk) * N + src0 + cl]; if (gain) v *= gain[k0 + kk]; } scr[kk * 33 + cl] = v; }
    asm volatile("s_waitcnt lgkmcnt(0)" ::: "memory");
    const int c = lane & 7;
#pragma unroll
    for (int j = 0; j < 4; ++j) { const int n = (lane >> 3) + 8 * j; const LAS float* s = scr + (8 * c) * 33 + n;
        u32x4 o; o.x = cvt_pk(s[0 * 33], s[1 * 33]); o.y = cvt_pk(s[2 * 33], s[3 * 33]); o.z = cvt_pk(s[4 * 33], s[5 * 33]); o.w = cvt_pk(s[6 * 33], s[7 * 33]);
        *(u32x4*)(WT + (size_t)(dst_row0 + n) * K + k0 + 8 * c) = o; }
    asm volatile("s_waitcnt lgkmcnt(0)" ::: "memory");
}
__device__ __forceinline__ void map_ab(int nb, int& src, int& nv) {
    nv = 32;
    if (nb < 80) src = 32 * nb;
    else if (nb < 96) src = 2640 + 32 * (nb - 80);
    else if (nb < 112) src = 3152 + 32 * (nb - 96);
    else { const int t = nb - 112; if (t == 0) src = 2560; else if (t == 1) { src = 2624; nv = 16; } else if (t == 4) src = 2592; else { src = 0; nv = 0; } }
}
__device__ __forceinline__ int map_up(int nb) { const int pn = nb >> 3, t = nb & 7; return (t < 4 ? 0 : DFF) + 128 * pn + 32 * (t & 3); }
__device__ __forceinline__ int map_ci(int nb) { if (nb < 64) { const int h = nb >> 3, t = nb & 7; return (t < 4 ? 0 : 1024) + 128 * h + 32 * (t & 3); } return 32 * nb; }

template <int MAT> __device__ __forceinline__ void conv64_item(const float* W, int K, int N, const float* gain, bf16* WT, int kb, int nt, int lane) {
    const int n = 128 * nt + 2 * lane, nb = n >> 5, wi = n & 31;
    int src = 32 * nb, nv = 32;
    if (MAT == 0) map_ab(nb, src, nv); else if (MAT == 1) src = map_up(nb); else if (MAT == 2) src = map_ci(nb);
    const bool valid = wi < nv;
    const float* wp = W + (size_t)(64 * kb) * N + src + wi;
    f32x2 v[64];
#pragma unroll
    for (int kk = 0; kk < 64; ++kk) v[kk] = valid ? __builtin_nontemporal_load((const f32x2*)(wp + (size_t)kk * N)) : (f32x2){0.f, 0.f};
    if (gain) {
#pragma unroll
        for (int k4 = 0; k4 < 16; ++k4) { const f32x4 g = *(const f32x4*)(gain + 64 * kb + 4 * k4);
#pragma unroll
            for (int i = 0; i < 4; ++i) v[4 * k4 + i] = v[4 * k4 + i] * g[i]; }
    }
    bf16* op = WT + (size_t)n * K + 64 * kb;
#pragma unroll
    for (int i = 0; i < 2; ++i)
#pragma unroll
        for (int k8 = 0; k8 < 8; ++k8)
            *(bf16x8*)(op + (size_t)i * K + 8 * k8) = pack8(v[8 * k8][i], v[8 * k8 + 1][i], v[8 * k8 + 2][i], v[8 * k8 + 3][i], v[8 * k8 + 4][i], v[8 * k8 + 5][i], v[8 * k8 + 6][i], v[8 * k8 + 7][i]);
}
template <int GRP> __device__ __forceinline__ void convert_weights(const Params& p, int gw, int NGW, int lane) {
    unsigned char* ws = p.ws;
    constexpr int I_AB = 16 * 30, I_ABO = 16 * 8, I_CI = 16 * 32, I_CO = 16 * 8, I_UP = 16 * 44, I_DN = 44 * 8;
    if (GRP == 0) {
#pragma unroll 1
        for (int r = gw; r < I_AB; r += NGW) conv64_item<0>(p.ab_w_in, 1024, 3664, p.mix_norm, (bf16*)(ws + WS_WAB), r / 30, r % 30, lane);
    } else if (GRP == 1) {
#pragma unroll 1
        for (int it = gw; it < I_ABO + I_UP + I_DN; it += NGW) { int r = it;
            if (r < I_ABO) { conv64_item<3>(p.ab_w_out, 1024, 1024, nullptr, (bf16*)(ws + WS_WABO), r / 8, r % 8, lane); continue; } r -= I_ABO;
            if (r < I_UP) { conv64_item<1>(p.ffn_w_up, 1024, NUP, p.ffn_norm, (bf16*)(ws + WS_WUP0), r / 44, r % 44, lane); continue; } r -= I_UP;
            conv64_item<3>(p.ffn_w_down, DFF, 1024, nullptr, (bf16*)(ws + WS_WDN0), r / 8, r % 8, lane); }
    } else {
#pragma unroll 1
        for (int it = gw; it < I_CI + I_CO + I_UP + I_DN; it += NGW) { int r = it;
            if (r < I_CI) { conv64_item<2>(p.c_w_in, 1024, 4096, p.mix_norm + 1024, (bf16*)(ws + WS_WCI), r / 32, r % 32, lane); continue; } r -= I_CI;
            if (r < I_CO) { conv64_item<3>(p.c_w_out, 1024, 1024, nullptr, (bf16*)(ws + WS_WCO), r / 8, r % 8, lane); continue; } r -= I_CO;
            if (r < I_UP) { conv64_item<1>(p.ffn_w_up + (size_t)1024 * NUP, 1024, NUP, p.ffn_norm + 1024, (bf16*)(ws + WS_WUP1), r / 44, r % 44, lane); continue; } r -= I_UP;
            conv64_item<3>(p.ffn_w_down + (size_t)DFF * 1024, DFF, 1024, nullptr, (bf16*)(ws + WS_WDN1), r / 8, r % 8, lane); }
    }
}
__device__ __forceinline__ void p0_prologue(const Params& p, LAS unsigned char* lds, int wave, int lane) {
    unsigned char* ws = p.ws;
    const int gw = blockIdx.x * NWAVES + wave, NGW = gridDim.x * NWAVES;
    convert_weights<0>(p, gw, NGW, lane);
    if (gridDim.x != 256) { convert_weights<1>(p, gw, NGW, lane); convert_weights<2>(p, gw, NGW, lane); }
    bf16* XB = (bf16*)(ws + WS_XB); float* SSQ0 = (float*)(ws + WS_SSQ0);
    for (int m0 = gw; m0 < M; m0 += 4 * NGW) {
        f32x4 v[4][4];
#pragma unroll
        for (int r = 0; r < 4; ++r) { const int mr = m0 + r * NGW; const f32x4* xr = (const f32x4*)(p.x + (size_t)(mr < M ? mr : m0) * DM) + 2 * lane;
#pragma unroll
            for (int j = 0; j < 4; ++j) v[r][j] = __builtin_nontemporal_load(xr + 128 * (j >> 1) + (j & 1)); }
#pragma unroll
        for (int r = 0; r < 4; ++r) { const int m = m0 + r * NGW;
            if (m < M) {
                float s = 0.f;
#pragma unroll
                for (int j = 0; j < 4; ++j) s += (v[r][j][0] * v[r][j][0] + v[r][j][1] * v[r][j][1]) + (v[r][j][2] * v[r][j][2] + v[r][j][3] * v[r][j][3]);
                s = wave_sum(s);
                bf16x8* o = (bf16x8*)(XB + (size_t)m * DM) + lane;
#pragma unroll
                for (int h = 0; h < 2; ++h) o[64 * h] = pack8(v[r][2 * h][0], v[r][2 * h][1], v[r][2 * h][2], v[r][2 * h][3], v[r][2 * h + 1][0], v[r][2 * h + 1][1], v[r][2 * h + 1][2], v[r][2 * h + 1][3]);
                if (lane == 0) SSQ0[m] = s;
            }
        }
    }
}

__device__ __forceinline__ void gmlp_unit(const Params& p, LAS unsigned char* lds, int unit, int wave, int lane_in) {
    unsigned char* ws = p.ws;
    const int lane = lane_now();
    (void)lane_in;
    const int b = unit >> 5, nblk = (unit >> 1) & 15, T0 = b * 2048 + 128 * nblk, tid = wave * 64 + lane, hh = lane >> 5, l31 = lane & 31, g = 4 * (unit & 1) + (wave & 3);
    LAS float* R = (LAS float*)lds;
    const float* SSQV = (const float*)(ws + WS_SSQV);
    const bf16* U = (const bf16*)(ws + WS_U);
    u32x2 uu[2][2][4]; f32x4 gnv[2][4]; float bsv[2];
#define GM_EPI_LOAD() do { const int ln_ = lane_now(), hq_ = ln_ >> 5, lq_ = ln_ & 31;     \
    _Pragma("unroll") for (int il = 0; il < 2; ++il) { const int i = 32 * (2 * (wave >> 2) + il) + lq_; bsv[il] = p.ab_b_s[g * 128 + i]; \
        _Pragma("unroll") for (int ct = 0; ct < 2; ++ct) _Pragma("unroll") for (int q4 = 0; q4 < 4; ++q4) uu[il][ct][q4] = *(const u32x2*)(U + (size_t)(T0 + i) * 512 + 64 * g + 32 * ct + 8 * q4 + 4 * hq_); } \
    _Pragma("unroll") for (int ct = 0; ct < 2; ++ct) _Pragma("unroll") for (int q4 = 0; q4 < 4; ++q4) gnv[ct][q4] = *(const f32x4*)(p.ab_gmlp_norm + 64 * g + 32 * ct + 8 * q4 + 4 * hq_); } while (0)
    const bf16* VGT = (const bf16*)(ws + WS_VGT);
    const int itp = wave >> 2, nks = itp == 0 ? 4 : 8;
    const float* Wg = p.ab_w_s + (size_t)g * 128 * 128;
    bf16x8 Ab[3][2]; f32x4 Wb[3][2][2];
#define GM_LOAD(SLOT_, KS_) do { \
        _Pragma("unroll") for (int ct = 0; ct < 2; ++ct) Ab[SLOT_][ct] = *(const bf16x8*)(VGT + (size_t)b * (512 * 2048) + frag_off(64 * g + 32 * ct + l31, 128 * nblk + 16 * (KS_) + 8 * hh, 2048)); \
        _Pragma("unroll") for (int il = 0; il < 2; ++il) { const float* wr_ = Wg + (size_t)(32 * (2 * itp + il) + l31) * 128 + 16 * (KS_) + 4 * hh; \
            Wb[SLOT_][il][0] = *(const f32x4*)wr_; Wb[SLOT_][il][1] = *(const f32x4*)(wr_ + 8); } } while (0)
    GM_LOAD(0, 0); GM_LOAD(1, 1); GM_LOAD(2, 2);
    if (tid < 128) { const f32x4 a = *(const f32x4*)(SSQV + (size_t)(T0 + tid) * 8), c = *(const f32x4*)(SSQV + (size_t)(T0 + tid) * 8 + 4);
        R[tid] = 1.0f / sqrtf(((a[0] + a[1]) + (a[2] + a[3]) + (c[0] + c[1]) + (c[2] + c[3])) * (1.0f / 512.0f) + EPS); }
    __syncthreads();
    bf16* Y = (bf16*)(ws + WS_Y);
    {
        f32x16 acc[2][2];
#pragma unroll
        for (int ct = 0; ct < 2; ++ct)
#pragma unroll
            for (int il = 0; il < 2; ++il)
#pragma unroll
                for (int q = 0; q < 16; ++q) acc[ct][il][q] = 0.f;
#define GM_STEP(KS_) do { const int ja = 16 * (KS_) + 4 * hh;                  \
            const f32x4 r0 = *(const LAS f32x4*)(R + ja), r1 = *(const LAS f32x4*)(R + ja + 8); \
            _Pragma("unroll") for (int il = 0; il < 2; ++il) { \
                const f32x4 w0 = Wb[(KS_) % 3][il][0] * r0, w1 = Wb[(KS_) % 3][il][1] * r1; \
                const bf16x8 B = pack8(w0[0], w0[1], w0[2], w0[3], w1[0], w1[1], w1[2], w1[3]); \
                _Pragma("unroll") for (int ct = 0; ct < 2; ++ct) { acc[ct][il] = MFMA32(Ab[(KS_) % 3][ct], B, acc[ct][il]); \
                    asm volatile("; operands stay live past the MFMA: a fresh destination must not be allocated over them" : "+v"(acc[ct][il]) : "v"(Ab[(KS_) % 3][ct]), "v"(B)); } } } while (0)
        if (nks == 8) {
            GM_STEP(0); GM_LOAD(0, 3); GM_STEP(1); GM_LOAD(1, 4); GM_STEP(2); GM_LOAD(2, 5); GM_STEP(3); GM_LOAD(0, 6); GM_STEP(4); GM_LOAD(1, 7);
            GM_STEP(5); GM_EPI_LOAD(); GM_STEP(6); GM_STEP(7);
        } else { GM_STEP(0); GM_LOAD(0, 3); GM_STEP(1); GM_STEP(2); GM_EPI_LOAD(); GM_STEP(3); }
#undef GM_STEP
#undef GM_LOAD
#undef GM_EPI_LOAD
#pragma unroll
        for (int il = 0; il < 2; ++il) { const int le_ = lane_now(), he_ = le_ >> 5; const int i = 32 * (2 * itp + il) + (le_ & 31), tok = T0 + i; const float bs = bsv[il];
#pragma unroll
            for (int ct = 0; ct < 2; ++ct) { u32x2 X[4];
#pragma unroll
                for (int q4 = 0; q4 < 4; ++q4) {
                    const f32x4 gn = gnv[ct][q4];
                    const u32x2 ux = uu[il][ct][q4];
                    const float u0 = __builtin_bit_cast(float, ux.x << 16), u1 = __builtin_bit_cast(float, ux.x & 0xffff0000u), u2 = __builtin_bit_cast(float, ux.y << 16), u3 = __builtin_bit_cast(float, ux.y & 0xffff0000u);
                    X[q4] = pack4(u0 * (acc[ct][il][4 * q4 + 0] * gn[0] + bs), u1 * (acc[ct][il][4 * q4 + 1] * gn[1] + bs), u2 * (acc[ct][il][4 * q4 + 2] * gn[2] + bs), u3 * (acc[ct][il][4 * q4 + 3] * gn[3] + bs)); }
#pragma unroll
                for (int qp = 0; qp < 2; ++qp) {
                    const u32x2 sx = __builtin_amdgcn_permlane32_swap(X[2 * qp].x, X[2 * qp + 1].x, false, false), sy = __builtin_amdgcn_permlane32_swap(X[2 * qp].y, X[2 * qp + 1].y, false, false);
                    const u32x4 v = {sx[0], sy[0], sx[1], sy[1]};
                    *(u32x4*)(Y + (size_t)tok * 1024 + 512 + 64 * g + 32 * ct + 8 * (2 * qp + he_)) = v; } } }
    }
    __syncthreads();
}

template <int CTRL, int RM> __device__ __forceinline__ int dpp_i(int v) { return __builtin_amdgcn_update_dpp(0, v, CTRL, RM, 0xF, false); }
__device__ __forceinline__ void half_sums(int v, int& s0, int& s1) {
    v += dpp_i<0x111, 0xF>(v); v += dpp_i<0x112, 0xF>(v); v += dpp_i<0x114, 0xF>(v); v += dpp_i<0x118, 0xF>(v);
    v += dpp_i<0x142, 0xA>(v);
    s0 = __builtin_amdgcn_readlane(v, 31); s1 = __builtin_amdgcn_readlane(v, 63);
}
__device__ __forceinline__ int count_ge_all(const LAS unsigned* SC, int n8, unsigned cand, int lane) {
    int cnt = 0;
#pragma unroll 1
    for (int i = 0; i < n8; i += 8) { unsigned u8[8];
#pragma unroll
        for (int k = 0; k < 8; ++k) u8[k] = SC[(i + k) * 64 + lane];
#pragma unroll
        for (int k = 0; k < 8; ++k) asm volatile("v_cmp_ge_u32 vcc, %1, %2\n\tv_addc_co_u32 %0, vcc, 0, %0, vcc" : "+v"(cnt) : "v"(u8[k]), "v"(cand) : "vcc"); }
    return cnt;
}
__device__ __forceinline__ void indexer_select(const Params& p, LAS unsigned* SC, LAS unsigned* LIST, int tq0, int c, int lane) {
    unsigned long long* SEL = (unsigned long long*)(p.ws + WS_SEL);
    const int hh = lane >> 5, n32 = 2 * (c + 1);
    const int n8 = (n32 + 7) & ~7;
    for (int kt = n32; kt < n8; ++kt) SC[kt * 64 + lane] = 0u;
    unsigned T0 = 0u, T1 = 0u; bool ex0 = false, ex1 = false;
    const int ng = n8 >> 3;
    unsigned H[8][4];
#pragma unroll
    for (int g = 0; g < 8; ++g)
        if (g < ng) {
#pragma unroll
            for (int k2 = 0; k2 < 4; ++k2) { const unsigned a = SC[(8 * g + 2 * k2) * 64 + lane], b2 = SC[(8 * g + 2 * k2 + 1) * 64 + lane]; H[g][k2] = (a >> 16) | (b2 & 0xFFFF0000u); }
        } else {
#pragma unroll
            for (int k2 = 0; k2 < 4; ++k2) H[g][k2] = 0u;
        }
#pragma unroll 1
    for (int bit = 31; bit >= 16; --bit) {
        const unsigned c0 = ex0 ? T0 : (T0 | (1u << bit)), c1 = ex1 ? T1 : (T1 | (1u << bit));
        const unsigned cm = ((hh ? c1 : c0) >> 16) - 1u, CM = cm | (cm << 16);
        unsigned acc = 0u;
#pragma unroll
        for (int g = 0; g < 8; ++g)
            if (g < ng) {
#pragma unroll
                for (int k2 = 0; k2 < 4; ++k2) { unsigned d_;
                    asm("v_pk_sub_u16 %0, %1, %2 clamp" : "=v"(d_) : "v"(H[g][k2]), "v"(CM));
                    asm("v_pk_min_u16 %0, %1, %2" : "=v"(d_) : "v"(d_), "v"(0x00010001u));
                    asm("v_pk_add_u16 %0, %1, %2" : "=v"(acc) : "v"(acc), "v"(d_)); }
            }
        int n0, n1; half_sums((int)((acc & 0xFFFFu) + (acc >> 16)), n0, n1);
        if (!ex0 && n0 >= 256) { T0 = c0; ex0 = (n0 == 256); }
        if (!ex1 && n1 >= 256) { T1 = c1; ex1 = (n1 == 256); }
        if (ex0 && ex1) break;
    }
    int need0 = 0, need1 = 0;
    if (!(ex0 && ex1)) {
        const unsigned Tl = hh ? T1 : T0;
#pragma unroll
        for (int s = 0; s < 5; ++s) LIST[s * 64 + lane] = 0u;
        int m = 0, cge = 0;
#pragma unroll 1
        for (int i = 0; i < n8; i += 8) { unsigned u8[8];
#pragma unroll
            for (int k = 0; k < 8; ++k) u8[k] = SC[(i + k) * 64 + lane];
#pragma unroll
            for (int k = 0; k < 8; ++k) { const unsigned d = u8[k] - Tl; cge += (u8[k] >= Tl) ? 1 : 0;
                if (u8[k] >= Tl && d < (1u << 16)) { if (m < 5) LIST[m * 64 + lane] = u8[k]; ++m; } } }
        int ge0, ge1, mb0, mb1; half_sums(cge, ge0, ge1); half_sums(m, mb0, mb1);
        const int G0 = ge0 - mb0, G1 = ge1 - mb1;
        const bool overflow = __ballot(m > 5) != 0ull;
        unsigned v[5];
#pragma unroll
        for (int s = 0; s < 5; ++s) v[s] = LIST[s * 64 + lane];
#pragma unroll 1
        for (int bit = 15; bit >= 0; --bit) {
            const unsigned c0 = ex0 ? T0 : (T0 | (1u << bit)), c1 = ex1 ? T1 : (T1 | (1u << bit));
            const unsigned cand = hh ? c1 : c0;
            int n0, n1;
            if (overflow) half_sums(count_ge_all(SC, n8, cand, lane), n0, n1);
            else { int cnt = 0;
#pragma unroll
                for (int s = 0; s < 5; ++s) cnt += (v[s] >= cand) ? 1 : 0;
                half_sums(cnt, n0, n1); n0 += G0; n1 += G1; }
            if (!ex0 && n0 >= 256) { T0 = c0; ex0 = (n0 == 256); }
            if (!ex1 && n1 >= 256) { T1 = c1; ex1 = (n1 == 256); }
            if (ex0 && ex1) break;
        }
        if (!(ex0 && ex1)) { const unsigned Tf = hh ? T1 : T0; int g0, g1;
            if (overflow) { int cnt = 0;
#pragma unroll 1
                for (int i = 0; i < n8; i += 8) { unsigned u8[8];
#pragma unroll
                    for (int k = 0; k < 8; ++k) u8[k] = SC[(i + k) * 64 + lane];
#pragma unroll
                    for (int k = 0; k < 8; ++k) cnt += (u8[k] > Tf) ? 1 : 0; }
                half_sums(cnt, g0, g1);
            } else { int cnt = 0;
#pragma unroll
                for (int s = 0; s < 5; ++s) cnt += (v[s] > Tf) ? 1 : 0;
                half_sums(cnt, g0, g1); g0 += G0; g1 += G1; }
            need0 = ex0 ? 0 : 256 - g0; need1 = ex1 ? 0 : 256 - g1; }
    }
    const unsigned T = hh ? T1 : T0;
    const bool exl = hh ? ex1 : ex0;
#pragma unroll 1
    for (int i0 = 0; i0 < n8; i0 += 8) {
        unsigned u8[8];
#pragma unroll
        for (int k = 0; k < 8; ++k) u8[k] = SC[(i0 + k) * 64 + lane];
        unsigned s0[8], s1[8];
#pragma unroll
        for (int k = 0; k < 8; ++k) { const unsigned long long mg = __ballot(exl ? (u8[k] >= T) : (u8[k] > T)); s0[k] = (unsigned)mg; s1[k] = (unsigned)(mg >> 32); }
        if (need0 > 0 || need1 > 0) {
#pragma unroll
            for (int k = 0; k < 8; ++k) { const unsigned long long me = __ballot(!exl && u8[k] == T);
                unsigned t0 = (unsigned)me, t1 = (unsigned)(me >> 32);
                while (t0 != 0u && need0 > 0) { const unsigned low = t0 & (0u - t0); s0[k] |= low; t0 ^= low; --need0; }
                while (t1 != 0u && need1 > 0) { const unsigned low = t1 & (0u - t1); s1[k] |= low; t1 ^= low; --need1; } }
        }
        int val = 0;
        asm("v_writelane_b32 %0, %1, 0" : "+v"(val) : "s"(s0[0])); asm("v_writelane_b32 %0, %1, 32" : "+v"(val) : "s"(s1[0]));
        asm("v_writelane_b32 %0, %1, 1" : "+v"(val) : "s"(s0[1])); asm("v_writelane_b32 %0, %1, 33" : "+v"(val) : "s"(s1[1]));
        asm("v_writelane_b32 %0, %1, 2" : "+v"(val) : "s"(s0[2])); asm("v_writelane_b32 %0, %1, 34" : "+v"(val) : "s"(s1[2]));
        asm("v_writelane_b32 %0, %1, 3" : "+v"(val) : "s"(s0[3])); asm("v_writelane_b32 %0, %1, 35" : "+v"(val) : "s"(s1[3]));
        asm("v_writelane_b32 %0, %1, 4" : "+v"(val) : "s"(s0[4])); asm("v_writelane_b32 %0, %1, 36" : "+v"(val) : "s"(s1[4]));
        asm("v_writelane_b32 %0, %1, 5" : "+v"(val) : "s"(s0[5])); asm("v_writelane_b32 %0, %1, 37" : "+v"(val) : "s"(s1[5]));
        asm("v_writelane_b32 %0, %1, 6" : "+v"(val) : "s"(s0[6])); asm("v_writelane_b32 %0, %1, 38" : "+v"(val) : "s"(s1[6]));
        asm("v_writelane_b32 %0, %1, 7" : "+v"(val) : "s"(s0[7])); asm("v_writelane_b32 %0, %1, 39" : "+v"(val) : "s"(s1[7]));
        if ((lane & 31) < 8) ((unsigned*)SEL)[(size_t)(tq0 + hh) * 64 + i0 + (lane & 31)] = (unsigned)val;
    }
}

__device__ __forceinline__ void indexer_unit(const Params& p, LAS unsigned char* lds, int b, int c, int qg, int wave, int lane) {
    unsigned char* ws = p.ws;
    const int tq0 = b * 2048 + 64 * c + 16 * qg, hh = lane >> 5, l31 = lane & 31, tid = wave * 64 + lane;
    if (c < 4) {
        if (tid < 64) { const int q = tid >> 2, kt = tid & 3; if (kt <= c) ((unsigned long long*)(ws + WS_SEL))[(size_t)(tq0 + q) * 32 + kt] = ~0ull; }
        return;
    }
    LAS unsigned* SCall = (LAS unsigned*)lds;
    LAS float* WQ = (LAS float*)(lds + LDSX_OFF);
    const bf16* IQ = (const bf16*)(ws + WS_IQ); const bf16* IK = (const bf16*)(ws + WS_IK); const float* IW = (const float*)(ws + WS_IW);
    const int n32 = 2 * (c + 1);
    const bf16* ikp = IK + frag_off(b * 2048 + l31, 8 * hh, 64);
    bf16x8 Bt[8][4];
#pragma unroll
    for (int j = 0; j < 8; ++j) { const int kt = wave + 8 * j < n32 ? wave + 8 * j : wave;
#pragma unroll
        for (int ks = 0; ks < 4; ++ks) Bt[j][ks] = *(const bf16x8*)(ikp + (size_t)((kt * 4 + ks) * 512)); }
    const bf16* iqp = IQ + frag_off((tq0 >> 1) * 32 + l31, 8 * hh, 64);
    bf16x8 Ac[4];
#pragma unroll
    for (int ks = 0; ks < 4; ++ks) Ac[ks] = *(const bf16x8*)(iqp + ks * 512);
    { float wq_ = 0.f; if (tid < 256) wq_ = IW[(size_t)tq0 * 16 + tid]; asm volatile("" : "+v"(wq_)); if (tid < 256) WQ[tid] = wq_; }
    __syncthreads();
#pragma unroll 1
    for (int mt = 0; mt < 8; ++mt) {
        const int mtn = mt + 1 < 8 ? mt + 1 : mt;
        bf16x8 An[4];
#pragma unroll
        for (int ks = 0; ks < 4; ++ks) An[ks] = *(const bf16x8*)(iqp + (size_t)((mtn * 4 + ks) * 512));
        const LAS f32x4* wq = (const LAS f32x4*)(WQ + (2 * mt + hh) * 16);
        const f32x4 w0 = wq[0], w1 = wq[1], w2 = wq[2], w3 = wq[3];
#pragma unroll
        for (int j = 0; j < 8; ++j) {
            if (wave + 8 * j < n32) {
                f32x16 a;
#pragma unroll
                for (int q = 0; q < 16; ++q) a[q] = 0.f;
#pragma unroll
                for (int ks = 0; ks < 4; ++ks) a = MFMA32(Ac[ks], Bt[j][ks], a);
                asm volatile("s_nop 10" : "+v"(a));
                float s4[4];
#define IDX_RELU(T_, A_) asm("v_max_f32 %0, 0, %1" : "=v"(T_) : "v"(A_))
#pragma unroll
                for (int i = 0; i < 4; ++i) { float t_; IDX_RELU(t_, a[i]); asm("v_mul_f32 %0, %1, %2" : "=v"(s4[i]) : "v"(w0[i]), "v"(t_)); }
#pragma unroll
                for (int i = 0; i < 4; ++i) { float t_; IDX_RELU(t_, a[4 + i]); asm("v_fmac_f32 %0, %1, %2" : "+v"(s4[i]) : "v"(w1[i]), "v"(t_)); }
#pragma unroll
                for (int i = 0; i < 4; ++i) { float t_; IDX_RELU(t_, a[8 + i]); asm("v_fmac_f32 %0, %1, %2" : "+v"(s4[i]) : "v"(w2[i]), "v"(t_)); }
#pragma unroll
                for (int i = 0; i < 4; ++i) { float t_; IDX_RELU(t_, a[12 + i]); asm("v_fmac_f32 %0, %1, %2" : "+v"(s4[i]) : "v"(w3[i]), "v"(t_)); }
#undef IDX_RELU
                float sc;
                asm("v_add_f32 %0, %1, %2" : "=v"(sc) : "v"(s4[0]), "v"(s4[1])); asm("v_add_f32 %0, %0, %1" : "+v"(s4[2]) : "v"(s4[3])); asm("v_add_f32 %0, %0, %1" : "+v"(sc) : "v"(s4[2]));
                unsigned bits = __builtin_bit_cast(unsigned, sc); bits ^= (bits >> 31) ? 0xFFFFFFFFu : 0x80000000u;
                SCall[mt * 4096 + (wave + 8 * j) * 64 + lane] = bits;
            }
        }
#pragma unroll
        for (int ks = 0; ks < 4; ++ks) Ac[ks] = An[ks];
    }
    __syncthreads();
    indexer_select(p, SCall + wave * 4096, (LAS unsigned*)(lds + LDSX_OFF + 1024) + wave * 320, tq0 + 2 * wave, c, lane);
}

__device__ __forceinline__ void p2_gmlp(const Params& p, LAS unsigned char* lds, int wave, int lane) {
    for (int u = blockIdx.x; u < 256; u += gridDim.x) gmlp_unit(p, lds, u, wave, lane);
}
__device__ __forceinline__ void p2_indexer(const Params& p, LAS unsigned char* lds, int wave, int lane) {
#pragma unroll 1
    for (int it = blockIdx.x; it < 512; it += gridDim.x) {
        const int b = it & 7, cp = (it >> 3) & 15, qg = it >> 7;
#pragma unroll 1
        for (int sub = 0; sub < 2; ++sub) indexer_unit(p, lds, b, sub ? cp : 31 - cp, qg, wave, lane);
    }
}

__device__ __forceinline__ void p3_attention(const Params& p, LAS unsigned char* lds, int wave, int lane) {
    unsigned char* ws = p.ws;
    LAS unsigned* SELL = (LAS unsigned*)(lds + 8192 + 4 * 17 * 1024);
    LAS float* BT = (LAS float*)lds;
    const bf16* Q = (const bf16*)(ws + WS_Q); const bf16* K = (const bf16*)(ws + WS_K); const bf16* VT = (const bf16*)(ws + WS_VT); bf16* Y = (bf16*)(ws + WS_Y);
    const unsigned long long* SEL = (const unsigned long long*)(ws + WS_SEL);
    for (int item = blockIdx.x; item < 256; item += gridDim.x) {
        const int lane_ = lane_now(), hh = lane_ >> 5, l31 = lane_ & 31;
        const int b = item & 7, g = (item >> 3) & 1, cp = item >> 4;
        const int hd = wave & 3, head = 4 * g + hd, kh = wave >> 2, bh = b * 8 + head;
        const LAS float* bt = BT + head * 256;
        int c = 31 - cp;
#define tq0 (64 * c + l31)
#define nTw (c + 1)
#define SELW(S_, NQ_, T_) SELL[((S_) * 64 + 32 * (NQ_) + l31) * 65 + (T_)]
        const bf16* kbase = K + (size_t)bh * (2048 * 64) + (size_t)(hh * 32 + l31) * 8;
        const bf16* vbase = VT + (size_t)b * (512 * 2048) + frag_off(head * 64 + l31, 8 * hh, 2048);
        bf16x8 Qo[2][4], K0[4], K1[4], V0[2][2], V1[2][2]; unsigned w0[2], w1[2];
#define ATT_LOAD(KX, VX, WX, I, SUB_) do { const int T_ = kh + 2 * ((I) < nTw ? (I) : nTw - 1); \
                _Pragma("unroll") for (int ks = 0; ks < 4; ++ks) KX[ks] = *(const bf16x8*)(kbase + (size_t)((T_ * 4 + ks) * 512)); \
                _Pragma("unroll") for (int s2 = 0; s2 < 2; ++s2) _Pragma("unroll") for (int dt = 0; dt < 2; ++dt) VX[s2][dt] = *(const bf16x8*)(vbase + (size_t)dt * (128 * 512) + (size_t)((2 * T_ + s2) * 512)); \
                WX[0] = SELW(SUB_, 0, T_); WX[1] = SELW(SUB_, 1, T_); } while (0)
#define ATT_LOADQ() do { _Pragma("unroll") for (int nq = 0; nq < 2; ++nq) _Pragma("unroll") for (int ks = 0; ks < 4; ++ks) \
                Qo[nq][ks] = *(const bf16x8*)(Q + (size_t)bh * (2048 * 64) + frag_off(tq0 + 32 * nq, 16 * ks + 8 * hh, 64)); } while (0)
        ATT_LOADQ();
#pragma unroll
        for (int ks = 0; ks < 4; ++ks) K0[ks] = *(const bf16x8*)(kbase + (size_t)((kh * 4 + ks) * 512));
#pragma unroll
        for (int s2 = 0; s2 < 2; ++s2)
#pragma unroll
            for (int dt = 0; dt < 2; ++dt) V0[s2][dt] = *(const bf16x8*)(vbase + (size_t)dt * (128 * 512) + (size_t)((2 * kh + s2) * 512));
        if (item != (int)blockIdx.x) __syncthreads();
        {
            const int tid_ = wave * 64 + lane_;
            u32x4 sv_[4]; float bv_[4];
#pragma unroll
            for (int j = 0; j < 4; ++j) {
                const int k_ = tid_ + 512 * j, s_ = k_ >> 10, row_ = (k_ >> 4) & 63, part_ = k_ & 15;
                sv_[j] = *(const u32x4*)((const unsigned*)SEL + (size_t)(b * 2048 + 64 * (s_ ? cp : 31 - cp) + row_) * 64 + 4 * part_);
            }
            if (item == (int)blockIdx.x) {
#pragma unroll
                for (int j = 0; j < 4; ++j) { const int idx = tid_ + 512 * j;
                    const int h = idx >> 8, rel = (idx & 255) - 191, n = rel < 0 ? -rel : rel;
                    int bk = rel > 0 ? 16 : 0;
                    if (n < 8) bk += n; else { int lg = 33 - __builtin_clz((unsigned)(n * n)); bk += lg < 15 ? lg : 15; }
                    bv_[j] = p.rel_bias[bk * 8 + h]; }
            }
#pragma unroll
            for (int j = 0; j < 4; ++j) {
                const int k_ = tid_ + 512 * j, s_ = k_ >> 10, row_ = (k_ >> 4) & 63, part_ = k_ & 15;
                LAS unsigned* d_ = SELL + (s_ * 64 + row_) * 65 + 4 * part_;
                d_[0] = sv_[j][0]; d_[1] = sv_[j][1]; d_[2] = sv_[j][2]; d_[3] = sv_[j][3];
            }
            if (item == (int)blockIdx.x) {
#pragma unroll
                for (int j = 0; j < 4; ++j) BT[tid_ + 512 * j] = bv_[j] * LOG2E;
            }
        }
        __syncthreads();
        w0[0] = SELW(0, 0, kh); w0[1] = SELW(0, 1, kh);
        const float bfar = bt[0];
#pragma unroll 1
        for (int sub = 0; sub < 2; ++sub) {
            f32x16 O[2][2];
#pragma unroll
            for (int q = 0; q < 16; ++q) { O[0][0][q] = 0.f; O[0][1][q] = 0.f; O[1][0][q] = 0.f; O[1][1][q] = 0.f; }
            float mrun[2] = {-1e30f, -1e30f}, lsum[2] = {0.f, 0.f};
#define ATT_PAIR(J, KB0, KB1) { int m0_, m1_; asm("v_bfe_i32 %0, %1, " #KB0 ", 1" : "=v"(m0_) : "v"(w)); asm("v_bfe_i32 %0, %1, " #KB1 ", 1" : "=v"(m1_) : "v"(w)); \
                float a0_, a1_; asm("v_add_f32 %0, %1, %2" : "=v"(a0_) : "v"(S[nq][2 * J]), "v"(sh_)); asm("v_add_f32 %0, %1, %2" : "=v"(a1_) : "v"(S[nq][2 * J + 1]), "v"(sh_)); \
                const float e0_ = __builtin_bit_cast(float, __builtin_bit_cast(unsigned, fexp2(a0_)) & (unsigned)m0_), e1_ = __builtin_bit_cast(float, __builtin_bit_cast(unsigned, fexp2(a1_)) & (unsigned)m1_); \
                pk[J] = cvt_pk(e0_, e1_); \
                asm("v_add_f32 %0, %0, %1" : "+v"(ps0_) : "v"(e0_)); asm("v_add_f32 %0, %0, %1" : "+v"(ps1_) : "v"(e1_)); }
#define ATT_STEP(NEAR) do { \
                ATT_LOAD(K1, V1, w1, i + 1, sub); \
                const int T = kh + 2 * i; \
                f32x16 S[2]; \
                _Pragma("unroll") for (int nq = 0; nq < 2; ++nq) { \
                    _Pragma("unroll") for (int q = 0; q < 16; ++q) S[nq][q] = 0.f; \
                    _Pragma("unroll") for (int ks = 0; ks < 4; ++ks) S[nq] = MFMA32(K0[ks], Qo[nq][ks], S[nq]); \
                    asm volatile("; operands stay live past the MFMAs: a fresh destination must not be allocated over them" : "+v"(S[nq]) : "v"(K0[0]), "v"(K0[1]), "v"(K0[2]), "v"(K0[3])); \
                } \
                _Pragma("unroll") for (int nq = 0; nq < 2; ++nq) { \
                    if (NEAR) { const LAS float* btp = bt + (32 * T - tq0 - 32 * nq + 191) + 4 * hh; \
                        _Pragma("unroll") for (int q = 0; q < 16; ++q) S[nq][q] += btp[(q & 3) + 8 * (q >> 2)]; } \
                    float tmax = S[nq][0]; \
                    _Pragma("unroll") for (int q = 1; q < 16; ++q) tmax = fmaxf(tmax, S[nq][q]); \
                    if (!(NEAR)) tmax += bfar; \
                      \
                    { const u32x2 r_ = __builtin_amdgcn_permlane32_swap(__builtin_bit_cast(unsigned, tmax), __builtin_bit_cast(unsigned, tmax), false, false); \
                      tmax = fmaxf(__builtin_bit_cast(float, r_[0]), __builtin_bit_cast(float, r_[1])); } \
                    if (__builtin_amdgcn_ballot_w64(tmax > mrun[nq] + 8.0f)) {     \
                        const float mnew = fmaxf(mrun[nq], tmax), alpha = fexp2(mrun[nq] - mnew); \
                        mrun[nq] = mnew; lsum[nq] *= alpha; \
                        _Pragma("unroll") for (int q = 0; q < 16; ++q) { O[nq][0][q] *= alpha; O[nq][1][q] *= alpha; } \
                    } \
                    const unsigned w = w0[nq] >> (4 * hh);                  \
                    const float sh_ = (NEAR) ? -mrun[nq] : bfar - mrun[nq]; \
                    unsigned pk[8]; float ps0_ = 0.f, ps1_ = 0.f; \
                    ATT_PAIR(0, 0, 1) ATT_PAIR(1, 2, 3) ATT_PAIR(2, 8, 9) ATT_PAIR(3, 10, 11) ATT_PAIR(4, 16, 17) ATT_PAIR(5, 18, 19) ATT_PAIR(6, 24, 25) ATT_PAIR(7, 26, 27) \
                    lsum[nq] += ps0_ + ps1_; \
                    _Pragma("unroll") for (int s2 = 0; s2 < 2; ++s2) { \
                        const bf16x8 Po = __builtin_bit_cast(bf16x8, u32x4{pk[4 * s2], pk[4 * s2 + 1], pk[4 * s2 + 2], pk[4 * s2 + 3]}); \
                        _Pragma("unroll") for (int dt = 0; dt < 2; ++dt) O[nq][dt] = MFMA32(V0[s2][dt], Po, O[nq][dt]); \
                    } \
                } \
                _Pragma("unroll") for (int ks = 0; ks < 4; ++ks) K0[ks] = K1[ks]; \
                _Pragma("unroll") for (int s2 = 0; s2 < 2; ++s2) _Pragma("unroll") for (int dt = 0; dt < 2; ++dt) V0[s2][dt] = V1[s2][dt]; \
                w0[0] = w1[0]; w0[1] = w1[1]; } while (0)
            const int nfar = c > 2 ? c - 2 : 0;
            int i = 0;
#pragma unroll 1
            for (; i < nfar; ++i) ATT_STEP(false);
#pragma unroll 1
            for (; i < nTw; ++i) ATT_STEP(true);
#undef ATT_STEP
#undef ATT_PAIR
            const int cs_ = c;
            if (sub == 0) {
                c = cp;
                ATT_LOADQ();
#pragma unroll
                for (int ks = 0; ks < 4; ++ks) K0[ks] = *(const bf16x8*)(kbase + (size_t)((kh * 4 + ks) * 512));
            }
            LAS float* MG = (LAS float*)(lds + 8192 + hd * (17 * 1024));
            __syncthreads();
            if (kh == 1) {
#pragma unroll
                for (int nq = 0; nq < 2; ++nq) {
#pragma unroll
                    for (int dt = 0; dt < 2; ++dt)
#pragma unroll
                        for (int q4 = 0; q4 < 4; ++q4)
                            *(LAS f32x4*)(MG + ((nq * 2 + dt) * 4 + q4) * 256 + lane_ * 4) = f32x4{O[nq][dt][4 * q4], O[nq][dt][4 * q4 + 1], O[nq][dt][4 * q4 + 2], O[nq][dt][4 * q4 + 3]};
                    MG[4096 + nq * 64 + lane_] = mrun[nq]; MG[4096 + 128 + nq * 64 + lane_] = lsum[nq];
                }
            }
            __syncthreads();
            if (kh == 0) {
                LAS unsigned char* ST = (LAS unsigned char*)MG;
#pragma unroll
                for (int nq = 0; nq < 2; ++nq) {
                    const float mB = MG[4096 + nq * 64 + lane_], lB = MG[4096 + 128 + nq * 64 + lane_];
                    const float m = fmaxf(mrun[nq], mB);
                    float fa = fexp2(mrun[nq] - m), fb = fexp2(mB - m);
                    float l = lsum[nq] * fa + lB * fb;
                    l += __shfl_xor(l, 32);
                    const float inv = 1.0f / l;
                    fa *= inv; fb *= inv;
#pragma unroll
                    for (int dt = 0; dt < 2; ++dt)
#pragma unroll
                        for (int q4 = 0; q4 < 4; ++q4) {
                            const f32x4 ob = *(const LAS f32x4*)(MG + ((nq * 2 + dt) * 4 + q4) * 256 + lane_ * 4);
#pragma unroll
                            for (int i = 0; i < 4; ++i) O[nq][dt][4 * q4 + i] = O[nq][dt][4 * q4 + i] * fa + ob[i] * fb;
                        }
#pragma unroll
                    for (int dt = 0; dt < 2; ++dt)
#pragma unroll
                        for (int q4 = 0; q4 < 4; ++q4) {
                            const int r = 32 * nq + l31, u = 8 * dt + 2 * q4 + hh;
                            *(LAS u32x2*)(ST + r * 128 + ((u ^ ((r & 7) << 1)) * 8)) = pack4(O[nq][dt][4 * q4], O[nq][dt][4 * q4 + 1], O[nq][dt][4 * q4 + 2], O[nq][dt][4 * q4 + 3]);
                        }
                    __builtin_amdgcn_sched_barrier(0);
                }
                const int ln2_ = lane_now();
                bf16* yb = Y + (size_t)(b * 2048 + 64 * cs_) * 1024 + head * 64;
#pragma unroll
                for (int it = 0; it < 8; ++it) {
                    const int rr = 8 * it + (ln2_ >> 3), ch = ln2_ & 7;
                    *(u32x4*)(yb + (size_t)rr * 1024 + ch * 8) = *(const LAS u32x4*)(ST + rr * 128 + ((ch ^ (rr & 7)) * 16));
                }
            }
            if (sub == 0) {
#pragma unroll
                for (int s2 = 0; s2 < 2; ++s2)
#pragma unroll
                    for (int dt = 0; dt < 2; ++dt) V0[s2][dt] = *(const bf16x8*)(vbase + (size_t)dt * (128 * 512) + (size_t)((2 * kh + s2) * 512));
                w0[0] = SELW(1, 0, kh); w0[1] = SELW(1, 1, kh);
            }
        }
#undef ATT_LOAD
#undef ATT_LOADQ
#undef tq0
#undef nTw
#undef SELW
    }
}

__device__ __forceinline__ void p_convfix_rows(const Params& p, int layer, int row_lo, int nrows, int t0, int nthr) {
    unsigned char* ws = p.ws; const float* HB = (const float*)(ws + WS_HB); bf16* ACT = (bf16*)(ws + WS_ACT);
    const float* cw = p.ffn_conv_w + (size_t)layer * 3 * NUP; const float* cbv = p.ffn_conv_b + (size_t)layer * NUP;
    const int total = nrows * (DFF / 4);
#pragma unroll 3
    for (int idx = t0; idx < total; idx += nthr) {
        const int row = row_lo + idx / (DFF / 4), c4 = (idx % (DFF / 4)) * 4, grp = row >> 1, w = row & 1, tok = 128 * grp + w;
        const bool first = (tok & 2047) < 2;
        f32x4 y[2];
#pragma unroll
        for (int half = 0; half < 2; ++half) { const int col = half * DFF + c4;
            const f32x4 h0 = *(const f32x4*)(HB + ((size_t)grp * 4 + 2 + w) * NUP + col);
            f32x4 h1, h2; const f32x4 z = {0.f, 0.f, 0.f, 0.f};
            if (w == 0) { h1 = first ? z : *(const f32x4*)(HB + ((size_t)(grp - 1) * 4 + 1) * NUP + col); h2 = first ? z : *(const f32x4*)(HB + ((size_t)(grp - 1) * 4 + 0) * NUP + col); }
            else        { h1 = *(const f32x4*)(HB + ((size_t)grp * 4 + 2) * NUP + col); h2 = first ? z : *(const f32x4*)(HB + ((size_t)(grp - 1) * 4 + 1) * NUP + col); }
            y[half] = *(const f32x4*)(cbv + col) + *(const f32x4*)(cw + 2 * NUP + col) * h0 + *(const f32x4*)(cw + NUP + col) * h1 + *(const f32x4*)(cw + col) * h2; }
        *(u32x2*)(ACT + (size_t)tok * DFF + c4) = pack4(fsilu(y[0][0]) * y[1][0], fsilu(y[0][1]) * y[1][1], fsilu(y[0][2]) * y[1][2], fsilu(y[0][3]) * y[1][3]);
    }
}

__device__ __forceinline__ void p_convfix(const Params& p, int layer, int wave, int lane) { p_convfix_rows(p, layer, 0, 256, blockIdx.x * (NWAVES * 64) + wave * 64 + lane, gridDim.x * NWAVES * 64); }
struct HgX { bf16x8 bq[2][2], kq[2][2], akt[4], bi[4]; };
__device__ __forceinline__ void hg_lds_put(LAS float* buf, int tt, int slot, const f32x16& o, int lane) {
    LAS f32x4* d = (LAS f32x4*)(buf + (tt * 4 + slot) * 1024) + lane;
#pragma unroll
    for (int k = 0; k < 4; ++k) d[k * 64] = (f32x4){o[4 * k], o[4 * k + 1], o[4 * k + 2], o[4 * k + 3]};
}
__device__ __forceinline__ void hg_reader(LAS float* buf, bf16* OB, float* OSSQ, int tokc, int h, int es, int hw, int lane) {
    const int tt = hw >> 2, tl = 8 * (hw & 3) + (lane & 7), part = lane >> 3;
    const LAS f32x4* src = (const LAS f32x4*)(buf + tt * 4 * 1024) + (part >> 1) * 64 + 32 * (part & 1) + tl;
    f32x4 v = src[0];
#pragma unroll
    for (int s = 1; s < 4; ++s) v += src[s * 256];
    float ss = (v[0] * v[0] + v[1] * v[1]) + (v[2] * v[2] + v[3] * v[3]);
    ss += __shfl_xor(ss, 8); ss += __shfl_xor(ss, 16); ss += __shfl_xor(ss, 32);
    const int tok = tokc + 32 * tt + tl;
    *(u32x2*)(OB + (size_t)tok * 1024 + h * 128 + es * 32 + 4 * part) = pack4(v[0], v[1], v[2], v[3]);
    if (part == 0) OSSQ[(size_t)tok * 32 + h * 4 + es] = ss;
}
#define HG_SYNC() do { asm volatile("s_waitcnt lgkmcnt(0)" ::: "memory"); __builtin_amdgcn_s_barrier(); asm volatile("" ::: "memory"); } while (0)
__device__ __forceinline__ void p9_hgrn(const Params& p, LAS unsigned char* lds, int wave, int lane) {
    unsigned char* ws = p.ws;
    const bf16* QM = (const bf16*)(ws + WS_QM); const bf16* KM = (const bf16*)(ws + WS_KM); const bf16* KMT = (const bf16*)(ws + WS_KMT); const bf16* IT = (const bf16*)(ws + WS_IT);
    const float* EB = (const float*)(ws + WS_EB); const float* FAC = (const float*)(ws + WS_FAC);
    bf16* OB = (bf16*)p.out; float* OSSQ = (float*)(ws + WS_OSSQ);
    LAS float* OBUF = (LAS float*)lds;
    LAS float* EFA = (LAS float*)(lds + 65536);
    const int hh = lane >> 5, l31 = lane & 31;
    HG_SYNC();
    for (int ub = blockIdx.x; ub < 256; ub += gridDim.x) {
        const int unit = (gridDim.x == 256) ? (ub & 7) * 32 + (ub >> 3) : ub;
        const int b = unit >> 5, h = (unit >> 2) & 7, es = unit & 3, bh = b * 8 + h, tb0 = b * 2048;
        const float* ebp = EB + ((size_t)(b * 32 * 8 + h)) * 128; const float* fcp = FAC + ((size_t)(b * 32 * 8 + h)) * 128;
        if (wave < 4) {
            const int dt = wave;
            f32x16 S;
#pragma unroll
            for (int q = 0; q < 16; ++q) S[q] = 0.f;
            const bf16* qmp = QM + (size_t)bh * (2048 * 128) + frag_off(l31, 32 * dt + 8 * hh, 128);
            const bf16* kmp = KM + (size_t)bh * (2048 * 128) + frag_off(l31, 32 * dt + 8 * hh, 128);
            const bf16* ktp = KMT + (size_t)bh * (128 * 2048) + frag_off(32 * dt + l31, 8 * hh, 2048);
            const bf16* itp = IT + (size_t)bh * (128 * 2048) + frag_off(es * 32 + l31, 8 * hh, 2048);
#define HGX_LOAD(X, c) do { \
            _Pragma("unroll") for (int t2 = 0; t2 < 2; ++t2) _Pragma("unroll") for (int s2 = 0; s2 < 2; ++s2) { \
                X.bq[t2][s2] = *(const bf16x8*)(qmp + (size_t)(((2 * (c) + t2) * 8 + s2) * 512)); X.kq[t2][s2] = *(const bf16x8*)(kmp + (size_t)(((2 * (c) + t2) * 8 + s2) * 512)); } \
            _Pragma("unroll") for (int k4 = 0; k4 < 4; ++k4) { X.akt[k4] = *(const bf16x8*)(ktp + (4 * (c) + k4) * 512); X.bi[k4] = *(const bf16x8*)(itp + (4 * (c) + k4) * 512); } } while (0)
#define HGX_TILE(X, st, tt, O) do { f32x16 a; _Pragma("unroll") for (int q = 0; q < 16; ++q) a[q] = 0.f; \
                _Pragma("unroll") for (int s2 = 0; s2 < 2; ++s2) a = MFMA32(X.kq[st][s2], X.bq[tt][s2], a); \
                asm volatile("; operands stay live past the MFMAs" : "+v"(a) : "v"(X.kq[st][0]), "v"(X.kq[st][1]), "v"(X.bq[tt][0]), "v"(X.bq[tt][1])); \
                if ((st) == (tt)) { _Pragma("unroll") for (int q = 0; q < 16; ++q) { const int srow = (q & 3) + 8 * (q >> 2) + 4 * hh; a[q] = (l31 >= srow) ? a[q] : 0.f; } } \
                _Pragma("unroll") for (int s2 = 0; s2 < 2; ++s2) { const bf16x8 Pa = pack8(a[8 * s2], a[8 * s2 + 1], a[8 * s2 + 2], a[8 * s2 + 3], a[8 * s2 + 4], a[8 * s2 + 5], a[8 * s2 + 6], a[8 * s2 + 7]); \
                    O = MFMA32(X.bi[2 * (st) + s2], Pa, O); asm volatile("; B operand stays live past the MFMA: a fresh destination must not be allocated over it" : "+v"(O) : "v"(Pa)); } } while (0)
#define HGX_STEP(X, c) do { \
            const LAS float* ef = EFA + (c) * 256 + 32 * dt + 4 * hh; \
            _Pragma("unroll") for (int q4 = 0; q4 < 4; ++q4) { const f32x4 e4 = *(const LAS f32x4*)(ef + 8 * q4); _Pragma("unroll") for (int i = 0; i < 4; ++i) S[4 * q4 + i] *= e4[i]; } \
            bf16x8 So[2]; _Pragma("unroll") for (int s2 = 0; s2 < 2; ++s2) So[s2] = pack8(S[8 * s2], S[8 * s2 + 1], S[8 * s2 + 2], S[8 * s2 + 3], S[8 * s2 + 4], S[8 * s2 + 5], S[8 * s2 + 6], S[8 * s2 + 7]); \
            LAS float* buf = OBUF + ((c) & 1) * 8192; \
            { f32x16 O; _Pragma("unroll") for (int q = 0; q < 16; ++q) O[q] = 0.f; \
              HGX_TILE(X, 0, 0, O); _Pragma("unroll") for (int s2 = 0; s2 < 2; ++s2) O = MFMA32(So[s2], X.bq[0][s2], O); hg_lds_put(buf, 0, dt, O, lane); } \
            { f32x16 O; _Pragma("unroll") for (int q = 0; q < 16; ++q) O[q] = 0.f; \
              HGX_TILE(X, 0, 1, O); HGX_TILE(X, 1, 1, O); _Pragma("unroll") for (int s2 = 0; s2 < 2; ++s2) O = MFMA32(So[s2], X.bq[1][s2], O); hg_lds_put(buf, 1, dt, O, lane); } \
            _Pragma("unroll") for (int k4 = 0; k4 < 4; ++k4) S = MFMA32(X.akt[k4], X.bi[k4], S); \
            _Pragma("unroll") for (int q4 = 0; q4 < 4; ++q4) { const f32x4 f4 = *(const LAS f32x4*)(ef + 128 + 8 * q4); _Pragma("unroll") for (int i = 0; i < 4; ++i) S[4 * q4 + i] *= f4[i]; } \
            HG_SYNC(); } while (0)
            HgX XA, XB_;
            HGX_LOAD(XA, 0);
            HG_SYNC();
#pragma unroll 1
            for (int c = 0; c < 32; c += 2) { HGX_LOAD(XB_, c + 1); HGX_STEP(XA, c); { const int cn = c + 2 < 32 ? c + 2 : 31; HGX_LOAD(XA, cn); } HGX_STEP(XB_, c + 1); }
#undef HGX_LOAD
#undef HGX_STEP
#undef HGX_TILE
        } else {
            const int hq = wave - 4;
            {
                const int j = lane & 31, kh = lane >> 5;
#pragma unroll
                for (int k = 0; k < 4; ++k) { const int cc = 8 * hq + 2 * k + kh;
                    const f32x4 ve = *(const f32x4*)(ebp + cc * 1024 + 4 * j), vf = *(const f32x4*)(fcp + cc * 1024 + 4 * j);
                    *(LAS f32x4*)(EFA + cc * 256 + 4 * j) = ve; *(LAS f32x4*)(EFA + cc * 256 + 128 + 4 * j) = vf; }
            }
            HG_SYNC();
#pragma unroll 1
            for (int c = 0; c < 32; ++c) {
                LAS float* buf = OBUF + (c & 1) * 8192;
                HG_SYNC();
                hg_reader(buf, OB, OSSQ, tb0 + 64 * c, h, es, 2 * hq, lane); hg_reader(buf, OB, OSSQ, tb0 + 64 * c, h, es, 2 * hq + 1, lane);
            }
        }
        HG_SYNC();
    }
}

__device__ __forceinline__ void p10_outnorm(const Params& p, int wave, int lane) {
    unsigned char* ws = p.ws; const bf16* OB = (const bf16*)p.out; const bf16* GATE = (const bf16*)(ws + WS_GATE); const float* OSSQ = (const float*)(ws + WS_OSSQ); bf16* ON = (bf16*)(ws + WS_ON);
    const int gw = blockIdx.x * NWAVES + wave, NGW = gridDim.x * NWAVES;
    const int col = 16 * lane, h = lane >> 3;
    f32x4 n0[2], n1[2];
#pragma unroll
    for (int k = 0; k < 2; ++k) { const int cc = col + 8 * k; n0[k] = *(const f32x4*)(p.c_out_norm + (cc & 127)); n1[k] = *(const f32x4*)(p.c_out_norm + (cc & 127) + 4); }
    for (int m0 = gw; m0 < M; m0 += 4 * NGW) {
        u32x4 o[4][2], g[4][2]; f32x4 sq[4];
#pragma unroll
        for (int r = 0; r < 4; ++r) { const int mr = m0 + r * NGW, m = mr < M ? mr : m0; sq[r] = *(const f32x4*)(OSSQ + (size_t)m * 32 + 4 * h);
#pragma unroll
            for (int k = 0; k < 2; ++k) { o[r][k] = *(const u32x4*)(OB + (size_t)m * 1024 + col + 8 * k); g[r][k] = *(const u32x4*)(GATE + (size_t)m * 1024 + col + 8 * k); } }
#pragma unroll
        for (int r = 0; r < 4; ++r) { const int m = m0 + r * NGW;
            if (m < M) {
                const float rn = 1.0f / sqrtf(((sq[r][0] + sq[r][1]) + (sq[r][2] + sq[r][3])) * (1.0f / 128.0f) + EPS);
#pragma unroll
                for (int k = 0; k < 2; ++k) { const int cc = col + 8 * k;
                    float v[8];
#pragma unroll
                    for (int i = 0; i < 4; ++i) { const unsigned ow = o[r][k][i], gwd = g[r][k][i];
                        v[2 * i] = __builtin_bit_cast(float, ow << 16) * __builtin_bit_cast(float, gwd << 16); v[2 * i + 1] = __builtin_bit_cast(float, ow & 0xffff0000u) * __builtin_bit_cast(float, gwd & 0xffff0000u); }
                    *(bf16x8*)(ON + (size_t)m * 1024 + cc) = pack8(v[0] * rn * n0[k][0], v[1] * rn * n0[k][1], v[2] * rn * n0[k][2], v[3] * rn * n0[k][3], v[4] * rn * n1[k][0], v[5] * rn * n1[k][1], v[6] * rn * n1[k][2], v[7] * rn * n1[k][3]);
                }
            }
        }
    }
}

__device__ __forceinline__ void p15_final(const Params& p, int wave, int lane) {
    const float* SSQ = (const float*)(p.ws + WS_SSQA) + 3 * M; const bf16* XB = (const bf16*)(p.ws + WS_XB);
    const int gw = blockIdx.x * NWAVES + wave, NGW = gridDim.x * NWAVES;
    for (int m = gw; m < M; m += NGW) {
        const float rn = 1.0f / sqrtf(SSQ[m] * (1.0f / DM) + EPS);
        f32x4* xr = (f32x4*)(p.out + (size_t)m * DM) + lane; const f32x4* gr = (const f32x4*)p.final_norm + lane; const u32x2* xb = (const u32x2*)(XB + (size_t)m * DM) + lane;
#pragma unroll
        for (int j = 0; j < 4; ++j) { const u32x2 w = xb[64 * j]; f32x4 v; v[0] = __builtin_bit_cast(float, w.x << 16); v[1] = __builtin_bit_cast(float, w.x & 0xffff0000u); v[2] = __builtin_bit_cast(float, w.y << 16); v[3] = __builtin_bit_cast(float, w.y & 0xffff0000u);
            xr[64 * j] = v * rn * gr[64 * j]; }
    }
}

constexpr int NPHASE = 16;
__global__ void __launch_bounds__(NWAVES * 64, 2) mk_fwd(Params p) {
    extern __shared__ __attribute__((aligned(16))) unsigned char lds_raw[];
    LAS unsigned char* lds = (LAS unsigned char*)lds_raw;
    volatile LAS unsigned* MISC = (volatile LAS unsigned*)(lds + MISC_OFF);
    const int wave = __builtin_amdgcn_readfirstlane(threadIdx.x >> 6);
    unsigned char* ws = p.ws;
    for (int u = wave * 64 + lane_now(); u < (LDS_BYTES - MISC_OFF) / 4; u += NWAVES * 64) ((LAS unsigned*)(lds + MISC_OFF))[u] = 0u;
    __syncthreads();
    const bool one = (MK_N_LAUNCHES == 1);
    XcdBarrier bar; bar.bar = (unsigned*)(ws + WS_CTL) + CW_BAR; bar.x = 0; bar.st = nullptr;
    if (one) bar = xcd_barrier_post((unsigned*)(ws + WS_CTL) + CW_BAR, MISC + 8, wave == 0 && lane_now() == 0);
    const int lo = p.ph_lo, hi = p.ph_hi;
#define IN(k) (lo <= (k) && (k) < hi)
#define LN() lane_now()
#define SEAM(k) do { if (one && lo <= (k) && (k) + 1 < hi) xcd_barrier(bar, wave == 0 && lane_now() == 0); } while (0)
    float* SSQA = (float*)(ws + WS_SSQA); bf16* XB = (bf16*)(ws + WS_XB);
    const int G = gridDim.x, cidx = blockIdx.x;

    if (IN(0)) { p0_prologue(p, lds, wave, LN()); } SEAM(0);
    if (IN(1)) {
        pg8::Gemm g{XB, (const bf16*)(ws + WS_WAB), M, NAB, DM}; pg8::StaticOrder S; S.init(M, NAB, G, cidx);
        EpiAB E{ws, p.ab_idx_k_norm};
        pg8::gemm_phase<EpiAB, pg8::StaticOrder, true, true>(lds, g, S, E, wave);
        if (G == 256 && cidx >= 192) convert_weights<1>(p, (cidx - 192) * NWAVES + wave, 64 * NWAVES, LN());
    } SEAM(1);
    if (IN(2)) { p2_gmlp(p, lds, wave, LN()); p2_indexer(p, lds, wave, LN()); } SEAM(2);
    if (IN(3)) { p3_attention(p, lds, wave, LN()); } SEAM(3);
    if (IN(4)) {
        pg8::Gemm g{(const bf16*)(ws + WS_Y), (const bf16*)(ws + WS_WABO), M, DM, DM}; pg8::StaticOrder S; S.init(M, DM, G, cidx);
        EpiRes E{XB, SSQA};
        pg8::gemm_phase<EpiRes, pg8::StaticOrder, true, true>(lds, g, S, E, wave);
    } SEAM(4);
#define FFN_PHASES(l, pb) do { \
        if (IN(pb)) { \
            pg8::Gemm g{XB, (const bf16*)(ws + ((l) ? WS_WUP1 : WS_WUP0)), M, NUP, DM}; pg8::StaticOrder S; S.init(M, NUP, G, cidx); \
            EpiConv E{SSQA + ((l) ? 2 * M : 0), p.ffn_conv_w + (size_t)(l) * 3 * NUP, p.ffn_conv_b + (size_t)(l) * NUP, (bf16*)(ws + WS_ACT), (float*)(ws + WS_HB)}; \
            pg8::gemm_phase<EpiConv, pg8::StaticOrder, true, true>(lds, g, S, E, wave); \
            if ((l) == 0 && G == 256 && cidx >= 128) convert_weights<2>(p, (cidx - 128) * NWAVES + wave, 128 * NWAVES, LN());     \
        } SEAM(pb); \
        if (G != 256) { if (IN((pb) + 1)) { p_convfix(p, (l), wave, LN()); } SEAM((pb) + 1); }     \
        if (IN((pb) + 2)) { \
            pg8::Gemm g{(const bf16*)(ws + WS_ACT), (const bf16*)(ws + ((l) ? WS_WDN1 : WS_WDN0)), M, DM, DFF}; pg8::StaticOrder S; S.init(M, DM, G, cidx); \
            if (G == 256) { pg8::Unit u0; if (S.next(0, u0)) p_convfix_rows(p, (l), 4 * u0.pm, 4, wave * 64 + LN(), NWAVES * 64);     \
                asm volatile("s_waitcnt vmcnt(0)" ::: "memory"); __syncthreads(); } \
            if ((l) == 0 || G != 256) { EpiRes E{XB, SSQA + ((l) ? 3 * M : M)}; \
                pg8::gemm_phase<EpiRes, pg8::StaticOrder, true, true>(lds, g, S, E, wave); } \
            else { EpiFinal E{XB, p.out, SSQA + 3 * M, (unsigned*)(ws + WS_FCNT), p.final_norm};     \
                pg8::gemm_phase<EpiFinal, pg8::StaticOrder, true, true>(lds, g, S, E, wave); } \
        } if (!((l) == 1 && G == 256)) SEAM((pb) + 2); } while (0)
    FFN_PHASES(0, 5);
    if (IN(8)) {
        pg8::Gemm g{XB, (const bf16*)(ws + WS_WCI), M, NCI, DM}; pg8::StaticOrder S; S.init(M, NCI, G, cidx);
        EpiHg E{ws, p.hgrn_lb};
        pg8::gemm_phase<EpiHg, pg8::StaticOrder, true, true>(lds, g, S, E, wave);
    } SEAM(8);
    if (IN(9)) { p9_hgrn(p, lds, wave, LN()); } SEAM(9);
    if (IN(10)) { p10_outnorm(p, wave, LN()); } SEAM(10);
    if (IN(11)) {
        pg8::Gemm g{(const bf16*)(ws + WS_ON), (const bf16*)(ws + WS_WCO), M, DM, DM}; pg8::StaticOrder S; S.init(M, DM, G, cidx);
        EpiRes E{XB, SSQA + 2 * M};
        pg8::gemm_phase<EpiRes, pg8::StaticOrder, true, true>(lds, g, S, E, wave);
    } SEAM(11);
    FFN_PHASES(1, 12);
    if (IN(15) && G != 256) { p15_final(p, wave, LN()); }
#undef IN
#undef SEAM
}

extern "C" void kernel_launch(void* const* d_in, const int* in_sizes, int n_in, void* d_out, int out_size, void* d_ws, size_t ws_size, hipStream_t stream) {
    static int grid = 0;
    if (grid == 0) {
        if (n_in != 19 || out_size != M * DM || ws_size < WS_END) { fprintf(stderr, "kernel_launch: unexpected shapes (n_in %d out %d ws %zu)\n", n_in, out_size, ws_size); grid = -1; return; }
        int dev = 0, cus = 0, per_cu = 0;
        if (hipGetDevice(&dev) != hipSuccess || hipDeviceGetAttribute(&cus, hipDeviceAttributeMultiprocessorCount, dev) != hipSuccess) { grid = -1; return; }
        if (hipFuncSetAttribute((const void*)mk_fwd, hipFuncAttributeMaxDynamicSharedMemorySize, LDS_BYTES) != hipSuccess) { fprintf(stderr, "kernel_launch: hipFuncSetAttribute failed\n"); grid = -1; return; }
        if (hipOccupancyMaxActiveBlocksPerMultiprocessor(&per_cu, (const void*)mk_fwd, NWAVES * 64, LDS_BYTES) != hipSuccess || per_cu < 1) { fprintf(stderr, "kernel_launch: occupancy query says %d\n", per_cu); }
        (void)hipGetLastError();
        grid = cus;
    }
    if (grid < 0) return;
    if (hipMemsetAsync((char*)d_ws + WS_CTL, 0, CTL_ZERO_BYTES, stream) != hipSuccess) return;
    Params p{};
    const float** pp = (const float**)&p;
    for (int i = 0; i < 19; ++i) pp[i] = (const float*)d_in[i];
    p.out = (float*)d_out; p.ws = (unsigned char*)d_ws;
#if MK_N_LAUNCHES == 1
    p.ph_lo = 0; p.ph_hi = NPHASE;
    hipLaunchKernelGGL(mk_fwd, dim3(grid), dim3(NWAVES * 64), LDS_BYTES, stream, p);
#else
    for (int k = 0; k < NPHASE; ++k) { p.ph_lo = k; p.ph_hi = k + 1; hipLaunchKernelGGL(mk_fwd, dim3(grid), dim3(NWAVES * 64), LDS_BYTES, stream, p); }
#endif
}
```

```cpp
#include <hip/hip_runtime.h>
#include <cstdio>
#include <cstdint>

#ifndef MK_N_LAUNCHES
#define MK_N_LAUNCHES 1
#endif

__device__ __forceinline__ int lane_now() { int l; asm volatile("v_mbcnt_lo_u32_b32 %0, -1, 0\n\tv_mbcnt_hi_u32_b32 %0, -1, %0" : "=v"(l)); return l; }

namespace pg8 {
#define PG8_LAS __attribute__((address_space(3)))
typedef unsigned short bf16_t;
typedef short bf16x8 __attribute__((ext_vector_type(8)));
typedef float f32x4 __attribute__((ext_vector_type(4)));
typedef unsigned u32x4 __attribute__((ext_vector_type(4)));
constexpr int BM = 256, BK = 64, HALF = 128, HTB = HALF * BK * 2  , STAGE_BYTES = 8 * HTB, NXCD = 8, WGM = 8;

__host__ __device__ __forceinline__ int lds_byte(int r, int c) { const int st = (r >> 4) * 2 + (c >> 5), rr = r & 15, cc = c & 31, ob = rr * 64 + cc * 2; return st * 1024 + (ob ^ (((ob >> 9) & 1) << 5)); }
__host__ __device__ __forceinline__ void stage_rc(int b, int& R, int& C) { const int st = b / 1024, sb = b % 1024, swz = sb ^ (((sb >> 9) & 1) << 5); R = (st >> 1) * 16 + swz / 64; C = (st & 1) * 32 + (swz % 64) / 2; }
__host__ __device__ __forceinline__ int perm32(int rho) { const int n = rho >> 4, i = rho & 15; return 8 * (i >> 2) + 4 * n + (i & 3); }

struct Unit { int pm, pn; };
struct Gemm { const bf16_t* A; const bf16_t* Bt; int M, N, K; };

struct StaticOrder {
    int nM, nN, nwg, G, c;
    __host__ __device__ __forceinline__ void init(int M, int N, int G_, int c_) { nM = M / BM; nN = N / BM; nwg = nM * nN; G = G_; c = c_; }
    __host__ __device__ __forceinline__ bool next(int i, Unit& u) const {
        const long L = (long)i * G + c; if (L >= nwg) return false;
        int wgid = (int)L; { const int q = nwg / NXCD, r = nwg % NXCD, xcd = wgid % NXCD, off = wgid / NXCD; wgid = (xcd < r ? xcd * (q + 1) : r * (q + 1) + (xcd - r) * q) + off; }
        const int nig = WGM * nN, gid = wgid / nig, fm = gid * WGM, gsz = (nM - fm) < WGM ? (nM - fm) : WGM;
        u.pm = fm + ((wgid % nig) % gsz); u.pn = (wgid % nig) / gsz; return true;
    }
    __device__ __forceinline__ void a_ready(const Unit&) const {}
    __device__ __forceinline__ void done(const Unit&) const {}
};

template <class Epi, class Sched, bool ALIGN_EPI = false, bool SP2 = false>
__device__ __forceinline__ void gemm_phase(PG8_LAS unsigned char* lds, const Gemm g, const Sched& S, const Epi& E, const int wave_idx) {
    int tid_l = wave_idx * 64 + lane_now();
    const int tid = tid_l, wid = __builtin_amdgcn_readfirstlane(tid >> 6), lane = tid & 63, wr = wid >> 2, wc = wid & 3, fr = lane & 15, fq = lane >> 4;
    const int K = g.K, nt = K / BK;
    unsigned voffA[2], voffB[2];
#pragma unroll
    for (int i = 0; i < 2; ++i) { int R, C; stage_rc(tid * 16 + i * 8192, R, C); const int Rb = Epi::PERM ? ((R & ~31) + perm32(R & 31)) : R;
        const int Rp = (((R >> 6) * 16 + (R & 15)) * 8 + ((R >> 4) & 3)); voffA[i] = (unsigned)(Rp * K + C) * 2u; voffB[i] = (unsigned)(Rb * K + C) * 2u; }
    const size_t kstep = (size_t)(BK * 2);
    const size_t hstepB = (size_t)HALF * K * 2, hstepA = (size_t)4 * K * 2;
    const size_t tstep = 2 * hstepB;
    const unsigned ldsw = (unsigned)wid * 1024u;
    const int aoff = lds_byte(wr * 64 + fr, fq * 8), boff = lds_byte(wc * 32 + fr, fq * 8);
#define PG8_SA(b, h) (((b) * 2 + (h)) * HTB)
#define PG8_SB(b, h) ((4 + (b) * 2 + (h)) * HTB)
#define PG8_STAGE(bufoff, gbase, voff) do { _Pragma("unroll") for (int _i = 0; _i < 2; ++_i) \
        __builtin_amdgcn_global_load_lds((const unsigned*)((const char*)(gbase) + (voff)[_i]), (PG8_LAS unsigned*)(lds + (bufoff) + ldsw + _i * 8192), 16, 0, 0); } while (0)
#define PG8_LDA(dst, b, h) do { _Pragma("unroll") for (int m = 0; m < 4; ++m) _Pragma("unroll") for (int k = 0; k < 2; ++k) dst[m][k] = *(const PG8_LAS bf16x8*)(lds + PG8_SA(b, h) + aoff + m * 2048 + k * 1024); } while (0)
#define PG8_LDB(dst, b, h) do { _Pragma("unroll") for (int n = 0; n < 2; ++n) _Pragma("unroll") for (int k = 0; k < 2; ++k) dst[n][k] = *(const PG8_LAS bf16x8*)(lds + PG8_SB(b, h) + boff + n * 2048 + k * 1024); } while (0)
#define PG8_MMA(ai, bj, At, Bt) do { __builtin_amdgcn_s_setprio(1); _Pragma("unroll") for (int m = 0; m < 4; ++m) _Pragma("unroll") for (int n = 0; n < 2; ++n) _Pragma("unroll") for (int k = 0; k < 2; ++k) \
        acc[ai][bj][m][n] = __builtin_amdgcn_mfma_f32_16x16x32_bf16(Bt[n][k], At[m][k], acc[ai][bj][m][n], 0, 0, 0); __builtin_amdgcn_s_setprio(0); } while (0)
#define PG8_WAIT_V(n) asm volatile("s_waitcnt vmcnt(" #n ")" ::: "memory")
#define PG8_WAIT_L(n) asm volatile("s_waitcnt lgkmcnt(" #n ")" ::: "memory")
#define PG8_BAR __builtin_amdgcn_s_barrier()
#define PG8_SCHED __builtin_amdgcn_sched_barrier(0)
    Unit cur, nxt; int ui = 0;
    if (!S.next(0, cur)) return;
    f32x4 acc[2][2][4][2];
#pragma unroll
    for (int a = 0; a < 2; ++a)
#pragma unroll
        for (int b = 0; b < 2; ++b)
#pragma unroll
            for (int m = 0; m < 4; ++m)
#pragma unroll
                for (int n = 0; n < 2; ++n) acc[a][b][m][n] = (f32x4){0.f, 0.f, 0.f, 0.f};
    bf16x8 At[4][2], B0[2][2], B1[2][2];
    const char* cA = (const char*)g.A + (size_t)cur.pm * tstep; const char* cB = (const char*)g.Bt + (size_t)cur.pn * tstep;
    S.a_ready(cur);
    if constexpr (SP2) {
        PG8_STAGE(PG8_SB(0, 0), cB, voffB); PG8_STAGE(PG8_SB(0, 1), cB + hstepB, voffB); PG8_STAGE(PG8_SA(0, 0), cA, voffA); PG8_STAGE(PG8_SA(0, 1), cA + hstepA, voffA);
        if (wr == 1) PG8_BAR;
        PG8_WAIT_V(2); PG8_BAR;
        PG8_STAGE(PG8_SB(1, 0), cB + kstep, voffB); PG8_STAGE(PG8_SA(1, 0), cA + kstep, voffA); PG8_STAGE(PG8_SB(1, 1), cB + hstepB + kstep, voffB);
        PG8_WAIT_V(6); PG8_BAR;
    } else {
        PG8_STAGE(PG8_SB(0, 0), cB, voffB); PG8_STAGE(PG8_SA(0, 0), cA, voffA); PG8_STAGE(PG8_SB(0, 1), cB + hstepB, voffB); PG8_STAGE(PG8_SA(0, 1), cA + hstepA, voffA);
        if (wr == 1) PG8_BAR;
        PG8_WAIT_V(4); PG8_BAR;
        PG8_STAGE(PG8_SB(1, 0), cB + kstep, voffB); PG8_STAGE(PG8_SA(1, 0), cA + kstep, voffA); PG8_STAGE(PG8_SB(1, 1), cB + hstepB + kstep, voffB);
        PG8_WAIT_V(6); PG8_BAR;
    }
    for (;;) {
        const bool has_next = S.next(ui + 1, nxt);
        const char* nA = has_next ? (const char*)g.A + (size_t)nxt.pm * tstep : cA; const char* nB = has_next ? (const char*)g.Bt + (size_t)nxt.pn * tstep : cB;
        for (int t = 0; t < nt; t += 2) {
            const bool last = (t == nt - 2);
            const char* a1 = cA + (size_t)(t + 1) * kstep;
            const char* a2 = last ? nA : cA + (size_t)(t + 2) * kstep; const char* b2 = last ? nB : cB + (size_t)(t + 2) * kstep;
            const char* a3 = a2 + kstep; const char* b3 = b2 + kstep;
            if (last && has_next) S.a_ready(nxt);
            if constexpr (SP2) {
            PG8_LDB(B0, 0, 0); PG8_LDB(B1, 0, 1); PG8_SCHED; PG8_LDA(At, 0, 0); PG8_STAGE(PG8_SA(1, 1), a1 + hstepA, voffA);
            PG8_WAIT_V(8); PG8_WAIT_L(0); PG8_BAR; PG8_MMA(0, 0, At, B0); PG8_MMA(0, 1, At, B1); PG8_BAR; PG8_SCHED;
            PG8_LDA(At, 0, 1); PG8_STAGE(PG8_SB(0, 0), b2, voffB); PG8_STAGE(PG8_SB(0, 1), b2 + hstepB, voffB); PG8_STAGE(PG8_SA(0, 0), a2, voffA);
            PG8_WAIT_V(8); PG8_WAIT_L(0); PG8_BAR; PG8_MMA(1, 0, At, B0); PG8_MMA(1, 1, At, B1); PG8_BAR; PG8_SCHED;
            PG8_LDB(B0, 1, 0); PG8_LDB(B1, 1, 1); PG8_SCHED; PG8_LDA(At, 1, 0); PG8_STAGE(PG8_SA(0, 1), a2 + hstepA, voffA);
            PG8_WAIT_V(8); PG8_WAIT_L(0); PG8_BAR; PG8_MMA(0, 0, At, B0); PG8_MMA(0, 1, At, B1); PG8_BAR; PG8_SCHED;
            PG8_LDA(At, 1, 1); PG8_STAGE(PG8_SB(1, 0), b3, voffB); PG8_STAGE(PG8_SB(1, 1), b3 + hstepB, voffB); PG8_STAGE(PG8_SA(1, 0), a3, voffA);
            PG8_WAIT_V(8); PG8_WAIT_L(0); PG8_BAR; PG8_MMA(1, 0, At, B0); PG8_MMA(1, 1, At, B1); PG8_BAR; PG8_SCHED;
            } else {
            PG8_LDB(B0, 0, 0); PG8_SCHED; PG8_LDA(At, 0, 0); PG8_STAGE(PG8_SA(1, 1), a1 + hstepA, voffA);
            PG8_WAIT_L(8); PG8_BAR; PG8_WAIT_L(0); PG8_MMA(0, 0, At, B0); PG8_BAR; PG8_SCHED;
            PG8_LDB(B1, 0, 1); PG8_STAGE(PG8_SB(0, 0), b2, voffB);
            PG8_BAR; PG8_WAIT_L(0); PG8_MMA(0, 1, At, B1); PG8_BAR;
            PG8_LDA(At, 0, 1); PG8_STAGE(PG8_SA(0, 0), a2, voffA);
            PG8_BAR; PG8_WAIT_L(0); PG8_MMA(1, 0, At, B0); PG8_BAR; PG8_SCHED;
            PG8_STAGE(PG8_SB(0, 1), b2 + hstepB, voffB);
            PG8_WAIT_V(6); PG8_BAR; PG8_MMA(1, 1, At, B1); PG8_BAR;
            PG8_LDB(B0, 1, 0); PG8_SCHED; PG8_LDA(At, 1, 0); PG8_STAGE(PG8_SA(0, 1), a2 + hstepA, voffA);
            PG8_WAIT_L(8); PG8_BAR; PG8_WAIT_L(0); PG8_MMA(0, 0, At, B0); PG8_BAR; PG8_SCHED;
            PG8_LDB(B1, 1, 1); PG8_STAGE(PG8_SB(1, 0), b3, voffB);
            PG8_BAR; PG8_WAIT_L(0); PG8_MMA(0, 1, At, B1); PG8_BAR;
            PG8_LDA(At, 1, 1); PG8_STAGE(PG8_SA(1, 0), a3, voffA);
            PG8_BAR; PG8_WAIT_L(0); PG8_MMA(1, 0, At, B0); PG8_BAR; PG8_SCHED;
            PG8_STAGE(PG8_SB(1, 1), b3 + hstepB, voffB);
            PG8_WAIT_V(6); PG8_BAR; PG8_MMA(1, 1, At, B1); PG8_BAR;
            }
        }
        if constexpr (ALIGN_EPI) { if (wr == 0) PG8_BAR; }
        if constexpr (!Epi::AFTER_DRAIN) { E(acc, cur, wr, wc, fr, fq); S.done(cur); }
        if (!has_next) break;
#pragma unroll
        for (int a = 0; a < 2; ++a)
#pragma unroll
            for (int b = 0; b < 2; ++b)
#pragma unroll
                for (int m = 0; m < 4; ++m)
#pragma unroll
                    for (int n = 0; n < 2; ++n) acc[a][b][m][n] = (f32x4){0.f, 0.f, 0.f, 0.f};
        cur = nxt; cA = nA; cB = nB; ++ui;
        if constexpr (ALIGN_EPI) { if (wr == 1) PG8_BAR; }
    }
    PG8_WAIT_V(0);
    if constexpr (!ALIGN_EPI) { if (wr == 0) PG8_BAR; }
    PG8_BAR;
    if constexpr (Epi::AFTER_DRAIN) { E.fused(acc, cur, wr, wc, fr, fq, lds, wid, lane); S.done(cur); }
#undef PG8_SA
#undef PG8_SB
#undef PG8_STAGE
#undef PG8_LDA
#undef PG8_LDB
#undef PG8_MMA
#undef PG8_WAIT_V
#undef PG8_WAIT_L
#undef PG8_BAR
#undef PG8_SCHED
}
}

constexpr int NB = 8, SEQ = 2048, DM = 1024, M = NB * SEQ;
constexpr int DFF = 2816, NUP = 2 * DFF;
constexpr int NAB = 3840;
constexpr int NCI = 4096;
constexpr float EPS = 1e-6f, LOG2E = 1.4426950408889634f, LN2 = 0.6931471805599453f;

#define GAS __attribute__((address_space(1)))
#define LAS __attribute__((address_space(3)))
typedef unsigned short bf16;
typedef short bf16x8 __attribute__((ext_vector_type(8)));
typedef float f32x4 __attribute__((ext_vector_type(4)));
typedef float f32x2 __attribute__((ext_vector_type(2)));
typedef float f32x16 __attribute__((ext_vector_type(16)));
typedef unsigned u32x4 __attribute__((ext_vector_type(4)));
typedef unsigned u32x2 __attribute__((ext_vector_type(2)));
typedef __bf16 bf16x2v __attribute__((ext_vector_type(2)));
typedef GAS unsigned gu32;

constexpr size_t MiB = 1u << 20;
constexpr size_t WS_CTL = 0, CTL_ZERO_BYTES = 1 * MiB;
constexpr size_t WS_WCI = 1 * MiB, WS_WCO = 9 * MiB, WS_WUP1 = 11 * MiB, WS_WDN1 = 22 * MiB;
constexpr size_t WS_SSQA = 128 * 1024;
constexpr size_t WS_SSQ0 = 29 * MiB;
constexpr size_t WS_OSSQ = 29 * MiB + 512 * 1024;
constexpr size_t WS_HB = 32 * MiB;
constexpr size_t WS_EB = 43 * MiB, WS_FAC = 44 * MiB;
constexpr size_t WS_XB = 46 * MiB;
constexpr size_t WS_WAB = 78 * MiB, WS_WABO = 86 * MiB, WS_WUP0 = 88 * MiB, WS_WDN0 = 99 * MiB;
constexpr size_t WS_R = 105 * MiB;
constexpr size_t WS_Q = WS_R, WS_K = WS_R + 16 * MiB, WS_VT = WS_R + 32 * MiB, WS_IQ = WS_R + 48 * MiB, WS_U = WS_R + 80 * MiB, WS_VGT = WS_R + 96 * MiB,
                 WS_Y = WS_R + 112 * MiB, WS_SEL = WS_R + 144 * MiB, WS_IK = WS_R + 148 * MiB, WS_IW = WS_R + 150 * MiB;
constexpr size_t WS_SSQV = 28 * MiB;
constexpr size_t WS_ACT = WS_R;
constexpr size_t WS_GATE = 78 * MiB, WS_QM = 110 * MiB, WS_KM = 142 * MiB, WS_KMT = 174 * MiB, WS_IT = 206 * MiB;
constexpr size_t WS_ON = WS_QM;
constexpr size_t WS_END = 256 * MiB;
static_assert(WS_IW + (size_t)M * 16 * 4 <= WS_END && WS_SSQV + (size_t)M * 8 * 4 <= WS_SSQ0 && WS_IT + 32 * MiB <= WS_END && WS_WDN0 + (size_t)DM * DFF * 2 <= WS_R, "ws map");
constexpr int CW_BAR = 4096;
constexpr size_t WS_FCNT = 64 * 1024;

constexpr int RING_BYTES = 131072, LDSX_OFF = RING_BYTES, MISC_OFF = RING_BYTES + 12288, LDS_BYTES = 147456;
constexpr int NWAVES = 8;

#define RLX_AGENT __ATOMIC_RELAXED, __HIP_MEMORY_SCOPE_AGENT
__device__ __forceinline__ unsigned cvt_pk(float lo, float hi) { unsigned r; asm volatile("v_cvt_pk_bf16_f32 %0, %1, %2" : "=v"(r) : "v"(lo), "v"(hi)); return r; }
__device__ __forceinline__ float fexp2(float x) { return __builtin_amdgcn_exp2f(x); }
__device__ __forceinline__ float frcp(float x) { return __builtin_amdgcn_rcpf(x); }
__device__ __forceinline__ float fexp(float x) { return __builtin_amdgcn_exp2f(x * LOG2E); }
__device__ __forceinline__ float fsigmoid(float x) { return frcp(1.f + fexp2(-LOG2E * x)); }
__device__ __forceinline__ float fsilu(float x) { return x * fsigmoid(x); }
__device__ __forceinline__ float fgelu(float x) { const float u = 0.7978845608028654f * (x + 0.044715f * x * x * x); return x * frcp(1.f + fexp2(-2.f * LOG2E * u)); }
__device__ __forceinline__ f32x2 fsilu2(f32x2 x, f32x2 xe) {
    const f32x2 e = {fexp2(xe[0]), fexp2(xe[1])}, d = e + 1.f; const f32x2 rr = {frcp(d[0]), frcp(d[1])}; return x * rr; }
__device__ __forceinline__ f32x2 fgelu2(f32x2 x) {
    constexpr float C1 = -2.f * LOG2E * 0.7978845608028654f, C2 = C1 * 0.044715f;
    const f32x2 x2 = x * x, t = x2 * C2 + C1, a = x * t;
    const f32x2 e = {fexp2(a[0]), fexp2(a[1])}, d = e + 1.f; const f32x2 rr = {frcp(d[0]), frcp(d[1])}; return x * rr; }
__device__ __forceinline__ float bf2f(unsigned short v) { return __builtin_bit_cast(float, (unsigned)v << 16); }
template <int CTRL> __device__ __forceinline__ float dpp_f(float v) { return __builtin_bit_cast(float, __builtin_amdgcn_update_dpp(0, __builtin_bit_cast(int, v), CTRL, 0xF, 0xF, false)); }
__device__ __forceinline__ bf16x8 pack8(float a0, float a1, float a2, float a3, float a4, float a5, float a6, float a7) {
    u32x4 w; w.x = cvt_pk(a0, a1); w.y = cvt_pk(a2, a3); w.z = cvt_pk(a4, a5); w.w = cvt_pk(a6, a7); return __builtin_bit_cast(bf16x8, w); }
__device__ __forceinline__ u32x2 pack4(float a0, float a1, float a2, float a3) { u32x2 w; w.x = cvt_pk(a0, a1); w.y = cvt_pk(a2, a3); return w; }
__device__ __forceinline__ size_t frag_off(int r, int c, int C) { return ((size_t)((r >> 5) * (C >> 4) + (c >> 4)) * 64 + ((c >> 3) & 1) * 32 + (r & 31)) * 8 + (c & 7); }
__device__ __forceinline__ int swap23(int v) { return (v & ~12) | ((v & 4) << 1) | ((v & 8) >> 1); }
#define MFMA32(a, b, c) __builtin_amdgcn_mfma_f32_32x32x16_bf16((a), (b), (c), 0, 0, 0)
__device__ __forceinline__ float wave_sum(float v) {
#pragma unroll
    for (int o = 1; o < 64; o <<= 1) v += __shfl_xor(v, o);
    return v;
}

struct Params {
    const float *x, *rel_bias, *hgrn_lb, *mix_norm, *ffn_norm, *final_norm, *ab_w_in, *ab_idx_k_norm, *ab_gmlp_norm, *ab_w_s, *ab_b_s, *ab_w_out,
                *c_w_in, *c_out_norm, *c_w_out, *ffn_w_up, *ffn_conv_w, *ffn_conv_b, *ffn_w_down;
    float* out; unsigned char* ws; int ph_lo, ph_hi;
};

template <int NP> __device__ __forceinline__ void row_scales(const float* ssq, int tok0, float (&r)[8]) {
#pragma unroll
    for (int j = 0; j < 8; ++j) {
        float s = 0.f;
        if (NP == 1) s = ssq[tok0 + j];
        else {
#pragma unroll
            for (int q = 0; q < NP / 4; ++q) { const f32x4 v = *(const f32x4*)(ssq + (size_t)(tok0 + j) * NP + 4 * q); s += (v[0] + v[1]) + (v[2] + v[3]); }
        }
        r[j] = 1.0f / sqrtf(s * (1.0f / DM) + EPS);
    }
}

#define ACC(j, bj, n, i) acc[(j) >> 2][bj][(j) & 3][n][i]
typedef pg8::Unit Unit;

struct EpiAB {
    static constexpr bool PERM = true, AFTER_DRAIN = false;
    unsigned char* ws; const float* ikg;
    __device__ __forceinline__ void operator()(const f32x4 (&acc)[2][2][4][2], const Unit& u, int wr, int wc, int fr, int fq) const {
        asm volatile("; epilogue-local lane coordinates" : "+v"(fr), "+v"(fq));
        const int tok0 = u.pm * 256 + (wr * 16 + fr) * 8, b = tok0 >> 11, s0 = tok0 & 2047, pn = u.pn;
        bf16* const IK = (bf16*)(ws + WS_IK); float* const IW = (float*)(ws + WS_IW); float* const SSQV = (float*)(ws + WS_SSQV);
        float r[8]; row_scales<1>((const float*)(ws + WS_SSQ0), tok0, r);
        const int cb = 32 * wc + 8 * fq;
        if (pn == 14) {
            if (wc == 0) {
                f32x4 gk[2][2];
#pragma unroll
                for (int bj = 0; bj < 2; ++bj) { gk[bj][0] = *(const f32x4*)(ikg + 32 * bj + 8 * fq); gk[bj][1] = *(const f32x4*)(ikg + 32 * bj + 8 * fq + 4); }
#pragma unroll
                for (int j = 0; j < 8; ++j) { f32x4 x[2][2]; float s = 0.f;
#pragma unroll
                    for (int bj = 0; bj < 2; ++bj)
#pragma unroll
                        for (int n = 0; n < 2; ++n) { x[bj][n] = acc[j >> 2][bj][j & 3][n] * r[j]; s += (x[bj][n][0] * x[bj][n][0] + x[bj][n][1] * x[bj][n][1]) + (x[bj][n][2] * x[bj][n][2] + x[bj][n][3] * x[bj][n][3]); }
                    s += __shfl_xor(s, 16); s += __shfl_xor(s, 32);
                    const float rn = 1.0f / sqrtf(s * (1.0f / 64.0f) + EPS);
#pragma unroll
                    for (int bj = 0; bj < 2; ++bj) { const int d0 = 32 * bj + 8 * fq; const f32x4 g0 = gk[bj][0], g1 = gk[bj][1];
                        const f32x4 y0 = x[bj][0] * rn * g0, y1 = x[bj][1] * rn * g1;
                        *(bf16x8*)(IK + frag_off(tok0 + j, d0, 64)) = pack8(y0[0], y0[1], y0[2], y0[3], y1[0], y1[1], y1[2], y1[3]); }
                    __builtin_amdgcn_sched_barrier(0); }
            } else if (wc == 1 && fq < 2) {
#pragma unroll
                for (int j = 0; j < 8; ++j) { const float rs = r[j] * 0.03125f;
                    *(f32x4*)(IW + (size_t)(tok0 + j) * 16 + 8 * fq) = acc[j >> 2][0][j & 3][0] * rs; *(f32x4*)(IW + (size_t)(tok0 + j) * 16 + 8 * fq + 4) = acc[j >> 2][0][j & 3][1] * rs; }
            }
        } else if (pn == 4 || pn == 5 || pn == 12 || pn == 13) {
            const bool isvg = pn >= 12; bf16* tb = (bf16*)(ws + (isvg ? WS_VGT : WS_VT)); const int pt = isvg ? pn - 12 : pn - 4;
            f32x2 ss2[8];
#pragma unroll
            for (int j = 0; j < 8; ++j) ss2[j] = f32x2{0.f, 0.f};
#pragma unroll
            for (int bj = 0; bj < 2; ++bj) { const int col = pt * 256 + 128 * bj + cb;
#pragma unroll
                for (int n = 0; n < 2; ++n)
#pragma unroll
                    for (int ip = 0; ip < 2; ++ip) { f32x2 v[8];
#pragma unroll
                        for (int j = 0; j < 8; ++j) { const f32x4 a = acc[j >> 2][bj][j & 3][n];
                            v[j] = (ip ? __builtin_shufflevector(a, a, 2, 3) : __builtin_shufflevector(a, a, 0, 1)) * r[j]; if (isvg) { v[j] = fgelu2(v[j]); ss2[j] = ss2[j] + v[j] * v[j]; } }
#pragma unroll
                        for (int e = 0; e < 2; ++e) {
                            bf16* base = tb + (size_t)b * (512 * 2048) + frag_off(col + 4 * n + 2 * ip + e, (s0 & ~15) + 4 * ((s0 >> 3) & 1), 2048);
                            *(u32x2*)base = pack4(v[0][e], v[1][e], v[2][e], v[3][e]); *(u32x2*)(base + 256) = pack4(v[4][e], v[5][e], v[6][e], v[7][e]); }
                        __builtin_amdgcn_sched_barrier(0); } }
            float ss[8];
#pragma unroll
            for (int j = 0; j < 8; ++j) ss[j] = ss2[j][0] + ss2[j][1];
            if (isvg) {
#pragma unroll
                for (int j = 0; j < 8; ++j) { float s = ss[j]; s += __shfl_xor(s, 16); s += __shfl_xor(s, 32); if (fq == 0) SSQV[(size_t)(tok0 + j) * 8 + pt * 4 + wc] = s; }
            }
        } else {
            const bool isqk = pn < 4, isu = pn >= 10;
            bf16* dst = (bf16*)(ws + (isqk ? WS_Q + (size_t)(pn >> 1) * (WS_K - WS_Q) : (isu ? WS_U : WS_IQ)));
            const int pt = isqk ? (pn & 1) : (isu ? pn - 10 : pn - 6);
            const float sc = pn < 2 ? 0.125f * LOG2E : 1.0f;
            const int sA = isqk ? 8 : (isu ? 512 : 0), sB = (isqk || isu) ? 0 : 2048, sC = (isqk || isu) ? 0 : 32;
#pragma unroll
            for (int bj = 0; bj < 2; ++bj) { const int col = pt * 256 + 128 * bj + cb, hd = col >> 6, d0 = col & 63;
                const size_t o0 = isqk ? (size_t)(b * 8 + hd) * (2048 * 64) + frag_off(s0, d0, 64) : (isu ? (size_t)tok0 * 512 + col : frag_off((tok0 >> 1) * 32 + (hd & 3) + 8 * (hd >> 2), d0, 64));
                bf16* dp = dst + o0;
#pragma unroll
                for (int j = 0; j < 8; ++j) { const float rs = r[j] * sc; const f32x4 a0 = acc[j >> 2][bj][j & 3][0], a1 = acc[j >> 2][bj][j & 3][1];
                    f32x2 p0 = __builtin_shufflevector(a0, a0, 0, 1) * rs, p1 = __builtin_shufflevector(a0, a0, 2, 3) * rs, p2 = __builtin_shufflevector(a1, a1, 0, 1) * rs, p3 = __builtin_shufflevector(a1, a1, 2, 3) * rs;
                    if (isu) { p0 = fgelu2(p0); p1 = fgelu2(p1); p2 = fgelu2(p2); p3 = fgelu2(p3); }
                    *(bf16x8*)(dp + (size_t)(j * sA + (j >> 1) * sB + (j & 1) * sC)) = pack8(p0[0], p0[1], p1[0], p1[1], p2[0], p2[1], p3[0], p3[1]);
                    __builtin_amdgcn_sched_barrier(0); } }
        }
    }
};

struct EpiRes {
    static constexpr bool PERM = true, AFTER_DRAIN = false;
    bf16* XB; float* ssq;
    __device__ __forceinline__ void operator()(const f32x4 (&acc)[2][2][4][2], const Unit& u, int wr, int wc, int fr, int fq) const {
        asm volatile("; epilogue-local lane coordinates" : "+v"(fr), "+v"(fq));
        const int tok0 = u.pm * 256 + (wr * 16 + fr) * 8;
        float sj[4];
#pragma unroll
        for (int j = 0; j < 8; ++j) { const size_t ro = (size_t)(tok0 + j) * DM; float s = 0.f;
#pragma unroll
            for (int bj = 0; bj < 2; ++bj) { const int col = u.pn * 256 + 128 * bj + 32 * wc + 8 * fq;
                const u32x4 xb = *(const u32x4*)(XB + ro + col);
                f32x4 v0, v1;
                v0[0] = __builtin_bit_cast(float, xb.x << 16); v0[1] = __builtin_bit_cast(float, xb.x & 0xffff0000u); v0[2] = __builtin_bit_cast(float, xb.y << 16); v0[3] = __builtin_bit_cast(float, xb.y & 0xffff0000u);
                v1[0] = __builtin_bit_cast(float, xb.z << 16); v1[1] = __builtin_bit_cast(float, xb.z & 0xffff0000u); v1[2] = __builtin_bit_cast(float, xb.w << 16); v1[3] = __builtin_bit_cast(float, xb.w & 0xffff0000u);
                v0 += acc[j >> 2][bj][j & 3][0]; v1 += acc[j >> 2][bj][j & 3][1];
                *(bf16x8*)(XB + ro + col) = pack8(v0[0], v0[1], v0[2], v0[3], v1[0], v1[1], v1[2], v1[3]);
                s += (v0[0] * v0[0] + v0[1] * v0[1]) + (v0[2] * v0[2] + v0[3] * v0[3]) + (v1[0] * v1[0] + v1[1] * v1[1]) + (v1[2] * v1[2] + v1[3] * v1[3]); }
            s += __shfl_xor(s, 16); s += __shfl_xor(s, 32);
            sj[j & 3] = s;
            if ((j & 3) == 3) { const float sv = fq == 0 ? sj[0] : (fq == 1 ? sj[1] : (fq == 2 ? sj[2] : sj[3]));
                __hip_atomic_fetch_add(ssq + tok0 + (j & ~3) + fq, sv, __ATOMIC_RELAXED, __HIP_MEMORY_SCOPE_AGENT); }
            __builtin_amdgcn_sched_barrier(0); }
    }
};

struct EpiFinal {
    static constexpr bool PERM = true, AFTER_DRAIN = false;
    const bf16* XB; float* out; float* ssq; unsigned* cnt; const float* gain;
    __device__ __forceinline__ void operator()(f32x4 (&acc)[2][2][4][2], const Unit& u, int wr, int wc, int fr, int fq) const {
        asm volatile("; epilogue-local lane coordinates" : "+v"(fr), "+v"(fq));
        const int tok0 = u.pm * 256 + (wr * 16 + fr) * 8, col0 = u.pn * 256 + 32 * wc + 8 * fq;
        float sj[4];
#pragma unroll
        for (int j = 0; j < 8; ++j) { const size_t ro = (size_t)(tok0 + j) * DM; float s = 0.f;
#pragma unroll
            for (int bj = 0; bj < 2; ++bj) { const int col = col0 + 128 * bj;
                const u32x4 xb = *(const u32x4*)(XB + ro + col);
                f32x4 v0, v1;
                v0[0] = __builtin_bit_cast(float, xb.x << 16); v0[1] = __builtin_bit_cast(float, xb.x & 0xffff0000u); v0[2] = __builtin_bit_cast(float, xb.y << 16); v0[3] = __builtin_bit_cast(float, xb.y & 0xffff0000u);
                v1[0] = __builtin_bit_cast(float, xb.z << 16); v1[1] = __builtin_bit_cast(float, xb.z & 0xffff0000u); v1[2] = __builtin_bit_cast(float, xb.w << 16); v1[3] = __builtin_bit_cast(float, xb.w & 0xffff0000u);
                v0 += acc[j >> 2][bj][j & 3][0]; v1 += acc[j >> 2][bj][j & 3][1];
                acc[j >> 2][bj][j & 3][0] = v0; acc[j >> 2][bj][j & 3][1] = v1;
                s += (v0[0] * v0[0] + v0[1] * v0[1]) + (v0[2] * v0[2] + v0[3] * v0[3]) + (v1[0] * v1[0] + v1[1] * v1[1]) + (v1[2] * v1[2] + v1[3] * v1[3]); }
            s += __shfl_xor(s, 16); s += __shfl_xor(s, 32);
            sj[j & 3] = s;
            if ((j & 3) == 3) { const float sv = fq == 0 ? sj[0] : (fq == 1 ? sj[1] : (fq == 2 ? sj[2] : sj[3]));
                __hip_atomic_fetch_add(ssq + tok0 + (j & ~3) + fq, sv, __ATOMIC_RELAXED, __HIP_MEMORY_SCOPE_AGENT); }
            __builtin_amdgcn_sched_barrier(0); }
        f32x4 gq[2][2];
#pragma unroll
        for (int bj = 0; bj < 2; ++bj) { gq[bj][0] = *(const f32x4*)(gain + col0 + 128 * bj); gq[bj][1] = *(const f32x4*)(gain + col0 + 128 * bj + 4); }
        asm volatile("s_waitcnt vmcnt(0)" ::: "memory");
        unsigned* c = cnt + 64 * u.pm;
        if (fq == 0 && fr == 0) {
            __hip_atomic_fetch_add(c, 1u, __ATOMIC_RELAXED, __HIP_MEMORY_SCOPE_AGENT);
            unsigned spins = 0;
            while (__hip_atomic_load(c, __ATOMIC_RELAXED, __HIP_MEMORY_SCOPE_AGENT) < 32u) { __builtin_amdgcn_s_sleep(2); if (++spins > (1u << 20)) break; }
        }
        asm volatile("" ::: "memory");
        float r[8];
#pragma unroll
        for (int j = 0; j < 8; ++j) { const float s = __hip_atomic_load(ssq + tok0 + j, __ATOMIC_RELAXED, __HIP_MEMORY_SCOPE_AGENT); r[j] = 1.0f / sqrtf(s * (1.0f / DM) + EPS); }
#pragma unroll
        for (int bj = 0; bj < 2; ++bj) { const int col = col0 + 128 * bj; const f32x4 g0 = gq[bj][0], g1 = gq[bj][1];
#pragma unroll
            for (int j = 0; j < 8; ++j) { const size_t ro = (size_t)(tok0 + j) * DM;
                *(f32x4*)(out + ro + col) = acc[j >> 2][bj][j & 3][0] * r[j] * g0; *(f32x4*)(out + ro + col + 4) = acc[j >> 2][bj][j & 3][1] * r[j] * g1; } }
    }
};

struct EpiConv {
    static constexpr bool PERM = true, AFTER_DRAIN = false;
    const float* ssq; const float* cw; const float* cbias; bf16* ACT; float* HB;
    __device__ __forceinline__ void operator()(const f32x4 (&acc)[2][2][4][2], const Unit& u, int wr, int wc, int fr, int fq) const {
        asm volatile("; epilogue-local lane coordinates" : "+v"(fr), "+v"(fq));
        const int tok0 = u.pm * 256 + (wr * 16 + fr) * 8, ca0 = u.pn * 128 + 32 * wc + 8 * fq;
        f32x4 wa[2][3], wb[2][3], ba[2], bb[2];
#pragma unroll
        for (int n = 0; n < 2; ++n) { const int ca = ca0 + 4 * n, cbn = DFF + ca;
#pragma unroll
            for (int tp = 0; tp < 3; ++tp) { wa[n][tp] = *(const f32x4*)(cw + tp * NUP + ca); wb[n][tp] = *(const f32x4*)(cw + tp * NUP + cbn); }
            ba[n] = *(const f32x4*)(cbias + ca); bb[n] = *(const f32x4*)(cbias + cbn); }
        float r[8]; row_scales<1>(ssq, tok0, r);
        const int grp = 2 * u.pm + wr;
        float* hp15 = HB + ((size_t)grp * 4) * NUP; float* hp0 = HB + ((size_t)grp * 4 + 2) * NUP;
        unsigned w[8][4];
#define EC_PAIR(V_) (ip ? __builtin_shufflevector(V_, V_, 2, 3) : __builtin_shufflevector(V_, V_, 0, 1))
#pragma unroll
        for (int n = 0; n < 2; ++n) { const int ca = ca0 + 4 * n, cbn = DFF + ca;
#pragma unroll
            for (int ip = 0; ip < 2; ++ip) {
                const f32x2 WA0 = EC_PAIR(wa[n][0]) * (-LOG2E), WA1 = EC_PAIR(wa[n][1]) * (-LOG2E), WA2 = EC_PAIR(wa[n][2]) * (-LOG2E), BA = EC_PAIR(ba[n]) * (-LOG2E);
                const f32x2 WB0 = EC_PAIR(wb[n][0]) * (-LN2), WB1 = EC_PAIR(wb[n][1]) * (-LN2), WB2 = EC_PAIR(wb[n][2]) * (-LN2), BB = EC_PAIR(bb[n]) * (-LN2);
                f32x2 HA[8], HBv[8];
#pragma unroll
                for (int j = 0; j < 8; ++j) { HA[j] = EC_PAIR(acc[j >> 2][0][j & 3][n]) * r[j]; HBv[j] = EC_PAIR(acc[j >> 2][1][j & 3][n]) * r[j]; }
                const f32x2 PA6 = {dpp_f<0x111>(HA[6][0]), dpp_f<0x111>(HA[6][1])}, PA7 = {dpp_f<0x111>(HA[7][0]), dpp_f<0x111>(HA[7][1])};
                const f32x2 PB6 = {dpp_f<0x111>(HBv[6][0]), dpp_f<0x111>(HBv[6][1])}, PB7 = {dpp_f<0x111>(HBv[7][0]), dpp_f<0x111>(HBv[7][1])};
                const int i0 = 2 * ip;
                if (fr == 15) { *(f32x2*)(hp15 + ca + i0) = HA[6]; *(f32x2*)(hp15 + cbn + i0) = HBv[6]; *(f32x2*)(hp15 + NUP + ca + i0) = HA[7]; *(f32x2*)(hp15 + NUP + cbn + i0) = HBv[7]; }
                if (fr == 0) { *(f32x2*)(hp0 + ca + i0) = HA[0]; *(f32x2*)(hp0 + cbn + i0) = HBv[0]; *(f32x2*)(hp0 + NUP + ca + i0) = HA[1]; *(f32x2*)(hp0 + NUP + cbn + i0) = HBv[1]; }
#pragma unroll
                for (int j = 0; j < 8; ++j) {
                    const f32x2 AM1 = j >= 1 ? HA[j >= 1 ? j - 1 : 0] : PA7, AM2 = j >= 2 ? HA[j >= 2 ? j - 2 : 0] : (j == 1 ? PA7 : PA6);
                    const f32x2 BM1 = j >= 1 ? HBv[j >= 1 ? j - 1 : 0] : PB7, BM2 = j >= 2 ? HBv[j >= 2 ? j - 2 : 0] : (j == 1 ? PB7 : PB6);
                    const f32x2 YA = BA + WA2 * HA[j] + WA1 * AM1 + WA0 * AM2, YB = BB + WB2 * HBv[j] + WB1 * BM1 + WB0 * BM2;
                    const f32x2 E = {fexp2(YA[0]), fexp2(YA[1])};
                    const f32x2 D = E + 1.f;
                    const f32x2 R = {frcp(D[0]), frcp(D[1])};
                    const f32x2 O = (YA * YB) * R;
                    w[j][2 * n + ip] = cvt_pk(O[0], O[1]);
                }
                __builtin_amdgcn_sched_barrier(0);
            }
        }
#undef EC_PAIR
#pragma unroll
        for (int j = 0; j < 8; ++j) if (!(fr == 0 && j < 2)) { u32x4 v; v.x = w[j][0]; v.y = w[j][1]; v.z = w[j][2]; v.w = w[j][3]; *(u32x4*)(ACT + (size_t)(tok0 + j) * DFF + ca0) = v; }
    }
};

struct EpiHg {
    static constexpr bool PERM = true, AFTER_DRAIN = false;
    unsigned char* ws; const float* hlb;
    __device__ __forceinline__ void operator()(const f32x4 (&acc)[2][2][4][2], const Unit& u, int wr, int wc, int fr, int fq) const {
        asm volatile("; epilogue-local lane coordinates" : "+v"(fr), "+v"(fq));
        const int tok0 = u.pm * 256 + (wr * 16 + fr) * 8, b = tok0 >> 11, s0 = tok0 & 2047, pn = u.pn;
        float r[8]; row_scales<1>((const float*)(ws + WS_SSQA) + M, tok0, r);
        const int cb = 32 * wc + 8 * fq;
        if (pn < 8) {
            bf16* const QM = (bf16*)(ws + WS_QM); bf16* const KM = (bf16*)(ws + WS_KM); bf16* const KMT = (bf16*)(ws + WS_KMT); float* const EB = (float*)(ws + WS_EB); float* const FAC = (float*)(ws + WS_FAC);
            const int h = pn, chunk = s0 >> 6, lane = fq * 16 + fr, f7 = fr & 7;
            float lb8[8];
            { const f32x4 l1a = *(const f32x4*)(hlb + 1024 + h * 128 + cb), l1b = *(const f32x4*)(hlb + 1024 + h * 128 + cb + 4), l0a = *(const f32x4*)(hlb + h * 128 + cb), l0b = *(const f32x4*)(hlb + h * 128 + cb + 4);
#pragma unroll
              for (int i = 0; i < 4; ++i) { lb8[i] = fsigmoid(l1a[i] - l0a[i]); lb8[4 + i] = fsigmoid(l1b[i] - l0b[i]); } }
            unsigned wq[8][4], wk[8][4];
            float rf[8];
#pragma unroll
            for (int j = 0; j < 8; ++j) rf[j] = r[j] * (-LOG2E);
#define HG_PAIR(V_) (ip ? __builtin_shufflevector(V_, V_, 2, 3) : __builtin_shufflevector(V_, V_, 0, 1))
#pragma unroll
            for (int n = 0; n < 2; ++n) {
#pragma unroll
                for (int ip = 0; ip < 2; ++ip) { const int d0 = cb + 4 * n + 2 * ip;
                    const f32x2 LB = {lb8[4 * n + 2 * ip], lb8[4 * n + 2 * ip + 1]}, OML = 1.f - LB;
                    f32x2 BC[8], KK[8], QS[8], RUN = {0.f, 0.f};
#pragma unroll
                    for (int j = 0; j < 8; ++j) { const f32x2 QV = HG_PAIR(acc[j >> 2][0][j & 3][n]) * r[j], FE = HG_PAIR(acc[j >> 2][1][j & 3][n]) * rf[j];
                        const f32x2 E1 = {fexp2(FE[0]), fexp2(FE[1])}, D1 = E1 + 1.f;
                        const f32x2 SG = {frcp(D1[0]), frcp(D1[1])};
                        const f32x2 G = LB + OML * SG;
                        const f32x2 LG = {__builtin_amdgcn_logf(G[0]), __builtin_amdgcn_logf(G[1])};
                        RUN = RUN + LG; BC[j] = RUN; KK[j] = OML - OML * SG;
                        const f32x2 QE = QV * (-LOG2E);
                        const f32x2 E2 = {fexp2(QE[0]), fexp2(QE[1])}, D2 = E2 + 1.f;
                        const f32x2 RQ = {frcp(D2[0]), frcp(D2[1])};
                        QS[j] = QV * RQ; }
                    f32x2 EXCL, BREF;
#pragma unroll
                    for (int e = 0; e < 2; ++e) { const float run = RUN[e]; float xs = run, t;
                        t = dpp_f<0x111>(xs); if (f7 >= 1) xs += t;
                        t = dpp_f<0x112>(xs); if (f7 >= 2) xs += t;
                        t = dpp_f<0x114>(xs); if (f7 >= 4) xs += t;
                        const float excl = xs - run, bl = __shfl(xs, (lane & ~7) + 7), bref = __shfl(xs, (lane & ~7) + 3);
                        EXCL[e] = excl; BREF[e] = bref;
                        const int lam = swap23(d0 + e);
                        if (f7 == 0) { const size_t o = ((size_t)((b * 32 + chunk) * 8 + h)) * 128 + lam; EB[o] = fexp2(bref); FAC[o] = fexp2(bl - bref); } }
#pragma unroll
                    for (int j = 0; j < 8; ++j) { const f32x2 BB = EXCL + BC[j], DQ = BB - BREF, DK = BREF - BB;
                        const f32x2 XQ = {fexp2(fminf(DQ[0], 80.f * LOG2E)), fexp2(fminf(DQ[1], 80.f * LOG2E))}, XK = {fexp2(fminf(DK[0], 80.f * LOG2E)), fexp2(fminf(DK[1], 80.f * LOG2E))};
                        QS[j] = QS[j] * XQ; KK[j] = KK[j] * XK;
                        wq[j][2 * n + ip] = cvt_pk(QS[j][0], QS[j][1]); wk[j][2 * n + ip] = cvt_pk(KK[j][0], KK[j][1]); }
#pragma unroll
                    for (int e = 0; e < 2; ++e) { const int lam = swap23(d0 + e);
                        bf16* base = KMT + (size_t)(b * 8 + h) * (128 * 2048) + frag_off(lam, (s0 & ~15) + 4 * ((s0 >> 3) & 1), 2048);
                        *(u32x2*)base = pack4(KK[0][e], KK[1][e], KK[2][e], KK[3][e]); *(u32x2*)(base + 256) = pack4(KK[4][e], KK[5][e], KK[6][e], KK[7][e]); }
                    __builtin_amdgcn_sched_barrier(0);
                }
            }
#undef HG_PAIR
            { const size_t o0 = (size_t)(b * 8 + h) * (2048 * 128) + frag_off(s0, cb, 128);
#pragma unroll
              for (int j = 0; j < 8; ++j) { u32x4 a; a.x = wq[j][0]; a.y = wq[j][1]; a.z = wq[j][2]; a.w = wq[j][3]; u32x4 c; c.x = wk[j][0]; c.y = wk[j][1]; c.z = wk[j][2]; c.w = wk[j][3];
                  *(u32x4*)(QM + o0 + 8 * j) = a; *(u32x4*)(KM + o0 + 8 * j) = c; } }
        } else if (pn < 12) {
            bf16* const IT = (bf16*)(ws + WS_IT);
#pragma unroll
            for (int bj = 0; bj < 2; ++bj) { const int col = (pn - 8) * 256 + 128 * bj + cb;
#pragma unroll
                for (int n = 0; n < 2; ++n)
#pragma unroll
                    for (int i = 0; i < 4; ++i) {
                        const int ci = col + 4 * n + i;
                        bf16* base = IT + (size_t)(b * 8 + (ci >> 7)) * (128 * 2048) + frag_off(ci & 127, (s0 & ~15) + 4 * ((s0 >> 3) & 1), 2048);
                        *(u32x2*)base = pack4(ACC(0, bj, n, i) * r[0], ACC(1, bj, n, i) * r[1], ACC(2, bj, n, i) * r[2], ACC(3, bj, n, i) * r[3]);
                        *(u32x2*)(base + 256) = pack4(ACC(4, bj, n, i) * r[4], ACC(5, bj, n, i) * r[5], ACC(6, bj, n, i) * r[6], ACC(7, bj, n, i) * r[7]);
                        __builtin_amdgcn_sched_barrier(0); } }
        } else {
            bf16* const GATE = (bf16*)(ws + WS_GATE);
#pragma unroll
            for (int bj = 0; bj < 2; ++bj) { const int col = (pn - 12) * 256 + 128 * bj + cb;
#pragma unroll
                for (int j = 0; j < 8; ++j) { const f32x4 a0 = acc[j >> 2][bj][j & 3][0], a1 = acc[j >> 2][bj][j & 3][1]; const float rj = r[j], rfj = rj * (-LOG2E);
                    const f32x2 p0 = __builtin_shufflevector(a0, a0, 0, 1), p1 = __builtin_shufflevector(a0, a0, 2, 3), p2 = __builtin_shufflevector(a1, a1, 0, 1), p3 = __builtin_shufflevector(a1, a1, 2, 3);
                    const f32x2 o0 = fsilu2(p0 * rj, p0 * rfj), o1 = fsilu2(p1 * rj, p1 * rfj), o2 = fsilu2(p2 * rj, p2 * rfj), o3 = fsilu2(p3 * rj, p3 * rfj);
                    *(bf16x8*)(GATE + (size_t)(tok0 + j) * 1024 + col) = pack8(o0[0], o0[1], o1[0], o1[1], o2[0], o2[1], o3[0], o3[1]);
                    __builtin_amdgcn_sched_barrier(0); } }
        }
    }
};

#define XB_TMO      128
#define XB_XCNT(j)  (256  + 64 * (j))
#define XB_XSUB(j)  (1280 + 64 * (j))
#define XB_XGEN(j)  (2304 + 64 * (j))
#define XB_TOP      3328
#define XB_TOPGEN   3392
#define XCD_BAR_WORDS 3456
#define XB_SPIN_CAP (1u << 18)
__device__ __forceinline__ unsigned xb_ld(unsigned* p)              { return __hip_atomic_load(p, __ATOMIC_RELAXED, __HIP_MEMORY_SCOPE_AGENT); }
__device__ __forceinline__ unsigned xb_add(unsigned* p, unsigned v) { return __hip_atomic_fetch_add(p, v, __ATOMIC_RELAXED, __HIP_MEMORY_SCOPE_AGENT); }
__device__ __forceinline__ unsigned xb_xcc_id() { return (unsigned)__builtin_amdgcn_s_getreg((3 << 11) | 20) & 0xFu; }
#define XB_SPIN(cond, bar) do { unsigned _sp = 0; while (cond) { __builtin_amdgcn_s_sleep(1); \
    if ((++_sp & 255u) == 0u) { if (xb_ld(&(bar)[XB_TMO])) break; if (_sp > XB_SPIN_CAP) { atomicAdd(&(bar)[XB_TMO], 1u); break; } } } } while (0)
struct XcdBarrier { unsigned* bar; unsigned x; volatile LAS unsigned* st; };
__device__ __forceinline__ XcdBarrier xcd_barrier_post(unsigned* bar, volatile LAS unsigned* st, bool t0) {
    XcdBarrier b; b.bar = bar; b.x = xb_xcc_id(); b.st = st;
    if (t0) (void)xb_add(&bar[XB_XCNT(b.x)], 1u);
    return b;
}
__device__ __forceinline__ void xcd_barrier_complete(unsigned* bar, unsigned x, unsigned& nloc, unsigned& nx) {
    const unsigned G = gridDim.x * gridDim.y * gridDim.z;
    unsigned sum, cnt, mine, sp = 0u;
    for (;;) {
        sum = 0u; cnt = 0u; mine = 0u;
#pragma unroll
        for (unsigned j = 0; j < 16; ++j) { const unsigned c = xb_ld(&bar[XB_XCNT(j)]); sum += c; cnt += (c > 0u) ? 1u : 0u; mine = (j == x) ? c : mine; }
        if (sum == G) break;
        __builtin_amdgcn_s_sleep(1);
        if ((++sp & 255u) == 0u) { if (xb_ld(&bar[XB_TMO])) break; if (sp > XB_SPIN_CAP) { atomicAdd(&bar[XB_TMO], 1u); break; } }
    }
    nloc = mine > 0u ? mine : 1u; nx = cnt > 0u ? cnt : 1u;
}
__device__ __forceinline__ void xcd_barrier(const XcdBarrier& b, bool t0) {
    asm volatile("s_waitcnt vmcnt(0)" ::: "memory");
    __syncthreads();
    if (t0) {
        unsigned* bar = b.bar;
        __builtin_amdgcn_s_waitcnt(0);
        unsigned nloc = b.st[0], nx = b.st[1];
        if (nloc == 0u) { xcd_barrier_complete(bar, b.x, nloc, nx); b.st[0] = nloc; b.st[1] = nx; }
        const unsigned old = xb_add(&bar[XB_XSUB(b.x)], 1u);
        const unsigned gen = old / nloc;
        if (old + 1u == (gen + 1u) * nloc) {
            __builtin_amdgcn_fence(__ATOMIC_RELEASE, "agent");
            asm volatile("s_waitcnt vmcnt(0)" ::: "memory");
            const unsigned og = xb_add(&bar[XB_TOP], 1u);
            const unsigned tg = og / nx;
            if (og + 1u == (tg + 1u) * nx) xb_add(&bar[XB_TOPGEN], 1u);
            else XB_SPIN(xb_ld(&bar[XB_TOPGEN]) == tg, bar);
            __builtin_amdgcn_fence(__ATOMIC_ACQUIRE, "agent");
            xb_add(&bar[XB_XGEN(b.x)], 1u);
            asm volatile("s_waitcnt vmcnt(0)" ::: "memory");
        } else {
            XB_SPIN(xb_ld(&bar[XB_XGEN(b.x)]) == gen, bar);
            __builtin_amdgcn_fence(__ATOMIC_ACQUIRE, "agent");
            asm volatile("s_waitcnt vmcnt(0)" ::: "memory");
        }
    }
    __syncthreads();
}

__device__ __forceinline__ void conv_item(const float* W, int K, int N, int src0, int nvalid, const float* gain, bf16* WT, int dst_row0, int kb, LAS float* scr, int lane) {
    const int k0 = 64 * kb, cl = lane & 31;
#pragma unroll 8
    for (int i = 0; i < 32; ++i) { const int kk = 2 * i + (lane >> 5); float v = 0.f; if (cl < nvalid) { v = W[(size_t)(k0 + kk) * N + src0 + cl]; if (gain) v *= gain[k0 + kk]; } scr[kk * 33 + cl] = v; }
    asm volatile("s_waitcnt lgkmcnt(0)" ::: "memory");
    const int c = lane & 7;
#pragma unroll
    for (int j = 0; j < 4; ++j) { const int n = (lane >> 3) + 8 * j; const LAS float* s = scr + (8 * c) * 33 + n;
        u32x4 o; o.x = cvt_pk(s[0 * 33], s[1 * 33]); o.y = cvt_pk(s[2 * 33], s[3 * 33]); o.z = cvt_pk(s[4 * 33], s[5 * 33]); o.w = cvt_pk(s[6 * 33], s[7 * 33]);
        *(u32x4*)(WT + (size_t)(dst_row0 + n) * K + k0 + 8 * c) = o; }
    asm volatile("s_waitcnt lgkmcnt(0)" ::: "memory");
}
__device__ __forceinline__ void map_ab(int nb, int& src, int& nv) {
    nv = 32;
    if (nb < 80) src = 32 * nb;
    else if (nb < 96) src = 2640 + 32 * (nb - 80);
    else if (nb < 112) src = 3152 + 32 * (nb - 96);
    else { const int t = nb - 112; if (t == 0) src = 2560; else if (t == 1) { src = 2624; nv = 16; } else if (t == 4) src = 2592; else { src = 0; nv = 0; } }
}
__device__ __forceinline__ int map_up(int nb) { const int pn = nb >> 3, t = nb & 7; return (t < 4 ? 0 : DFF) + 128 * pn + 32 * (t & 3); }
__device__ __forceinline__ int map_ci(int nb) { if (nb < 64) { const int h = nb >> 3, t = nb & 7; return (t < 4 ? 0 : 1024) + 128 * h + 32 * (t & 3); } return 32 * nb; }

template <int MAT> __device__ __forceinline__ void conv64_item(const float* W, int K, int N, const float* gain, bf16* WT, int kb, int nt, int lane) {
    const int n = 128 * nt + 2 * lane, nb = n >> 5, wi = n & 31;
    int src = 32 * nb, nv = 32;
    if (MAT == 0) map_ab(nb, src, nv); else if (MAT == 1) src = map_up(nb); else if (MAT == 2) src = map_ci(nb);
    const bool valid = wi < nv;
    const float* wp = W + (size_t)(64 * kb) * N + src + wi;
    f32x2 v[64];
#pragma unroll
    for (int kk = 0; kk < 64; ++kk) v[kk] = valid ? __builtin_nontemporal_load((const f32x2*)(wp + (size_t)kk * N)) : (f32x2){0.f, 0.f};
    if (gain) {
#pragma unroll
        for (int k4 = 0; k4 < 16; ++k4) { const f32x4 g = *(const f32x4*)(gain + 64 * kb + 4 * k4);
#pragma unroll
            for (int i = 0; i < 4; ++i) v[4 * k4 + i] = v[4 * k4 + i] * g[i]; }
    }
    bf16* op = WT + (size_t)n * K + 64 * kb;
#pragma unroll
    for (int i = 0; i < 2; ++i)
#pragma unroll
        for (int k8 = 0; k8 < 8; ++k8)
            *(bf16x8*)(op + (size_t)i * K + 8 * k8) = pack8(v[8 * k8][i], v[8 * k8 + 1][i], v[8 * k8 + 2][i], v[8 * k8 + 3][i], v[8 * k8 + 4][i], v[8 * k8 + 5][i], v[8 * k8 + 6][i], v[8 * k8 + 7][i]);
}
template <int GRP> __device__ __forceinline__ void convert_weights(const Params& p, int gw, int NGW, int lane) {
    unsigned char* ws = p.ws;
    constexpr int I_AB = 16 * 30, I_ABO = 16 * 8, I_CI = 16 * 32, I_CO = 16 * 8, I_UP = 16 * 44, I_DN = 44 * 8;
    if (GRP == 0) {
#pragma unroll 1
        for (int r = gw; r < I_AB; r += NGW) conv64_item<0>(p.ab_w_in, 1024, 3664, p.mix_norm, (bf16*)(ws + WS_WAB), r / 30, r % 30, lane);
    } else if (GRP == 1) {
#pragma unroll 1
        for (int it = gw; it < I_ABO + I_UP + I_DN; it += NGW) { int r = it;
            if (r < I_ABO) { conv64_item<3>(p.ab_w_out, 1024, 1024, nullptr, (bf16*)(ws + WS_WABO), r / 8, r % 8, lane); continue; } r -= I_ABO;
            if (r < I_UP) { conv64_item<1>(p.ffn_w_up, 1024, NUP, p.ffn_norm, (bf16*)(ws + WS_WUP0), r / 44, r % 44, lane); continue; } r -= I_UP;
            conv64_item<3>(p.ffn_w_down, DFF, 1024, nullptr, (bf16*)(ws + WS_WDN0), r / 8, r % 8, lane); }
    } else {
#pragma unroll 1
        for (int it = gw; it < I_CI + I_CO + I_UP + I_DN; it += NGW) { int r = it;
            if (r < I_CI) { conv64_item<2>(p.c_w_in, 1024, 4096, p.mix_norm + 1024, (bf16*)(ws + WS_WCI), r / 32, r % 32, lane); continue; } r -= I_CI;
            if (r < I_CO) { conv64_item<3>(p.c_w_out, 1024, 1024, nullptr, (bf16*)(ws + WS_WCO), r / 8, r % 8, lane); continue; } r -= I_CO;
            if (r < I_UP) { conv64_item<1>(p.ffn_w_up + (size_t)1024 * NUP, 1024, NUP, p.ffn_norm + 1024, (bf16*)(ws + WS_WUP1), r / 44, r % 44, lane); continue; } r -= I_UP;
            conv64_item<3>(p.ffn_w_down + (size_t)DFF * 1024, DFF, 1024, nullptr, (bf16*)(ws + WS_WDN1), r / 8, r % 8, lane); }
    }
}
__device__ __forceinline__ void p0_prologue(const Params& p, LAS unsigned char* lds, int wave, int lane) {
    unsigned char* ws = p.ws;
    const int gw = blockIdx.x * NWAVES + wave, NGW = gridDim.x * NWAVES;
    convert_weights<0>(p, gw, NGW, lane);
    if (gridDim.x != 256) { convert_weights<1>(p, gw, NGW, lane); convert_weights<2>(p, gw, NGW, lane); }
    bf16* XB = (bf16*)(ws + WS_XB); float* SSQ0 = (float*)(ws + WS_SSQ0);
    for (int m0 = gw; m0 < M; m0 += 4 * NGW) {
        f32x4 v[4][4];
#pragma unroll
        for (int r = 0; r < 4; ++r) { const int mr = m0 + r * NGW; const f32x4* xr = (const f32x4*)(p.x + (size_t)(mr < M ? mr : m0) * DM) + 2 * lane;
#pragma unroll
            for (int j = 0; j < 4; ++j) v[r][j] = __builtin_nontemporal_load(xr + 128 * (j >> 1) + (j & 1)); }
#pragma unroll
        for (int r = 0; r < 4; ++r) { const int m = m0 + r * NGW;
            if (m < M) {
                float s = 0.f;
#pragma unroll
                for (int j = 0; j < 4; ++j) s += (v[r][j][0] * v[r][j][0] + v[r][j][1] * v[r][j][1]) + (v[r][j][2] * v[r][j][2] + v[r][j][3] * v[r][j][3]);
                s = wave_sum(s);
                bf16x8* o = (bf16x8*)(XB + (size_t)m * DM) + lane;
#pragma unroll
                for (int h = 0; h < 2; ++h) o[64 * h] = pack8(v[r][2 * h][0], v[r][2 * h][1], v[r][2 * h][2], v[r][2 * h][3], v[r][2 * h + 1][0], v[r][2 * h + 1][1], v[r][2 * h + 1][2], v[r][2 * h + 1][3]);
                if (lane == 0) SSQ0[m] = s;
            }
        }
    }
}

__device__ __forceinline__ void gmlp_unit(const Params& p, LAS unsigned char* lds, int unit, int wave, int lane_in) {
    unsigned char* ws = p.ws;
    const int lane = lane_now();
    (void)lane_in;
    const int b = unit >> 5, nblk = (unit >> 1) & 15, T0 = b * 2048 + 128 * nblk, tid = wave * 64 + lane, hh = lane >> 5, l31 = lane & 31, g = 4 * (unit & 1) + (wave & 3);
    LAS float* R = (LAS float*)lds;
    const float* SSQV = (const float*)(ws + WS_SSQV);
    const bf16* U = (const bf16*)(ws + WS_U);
    u32x2 uu[2][2][4]; f32x4 gnv[2][4]; float bsv[2];
#define GM_EPI_LOAD() do { const int ln_ = lane_now(), hq_ = ln_ >> 5, lq_ = ln_ & 31;     \
    _Pragma("unroll") for (int il = 0; il < 2; ++il) { const int i = 32 * (2 * (wave >> 2) + il) + lq_; bsv[il] = p.ab_b_s[g * 128 + i]; \
        _Pragma("unroll") for (int ct = 0; ct < 2; ++ct) _Pragma("unroll") for (int q4 = 0; q4 < 4; ++q4) uu[il][ct][q4] = *(const u32x2*)(U + (size_t)(T0 + i) * 512 + 64 * g + 32 * ct + 8 * q4 + 4 * hq_); } \
    _Pragma("unroll") for (int ct = 0; ct < 2; ++ct) _Pragma("unroll") for (int q4 = 0; q4 < 4; ++q4) gnv[ct][q4] = *(const f32x4*)(p.ab_gmlp_norm + 64 * g + 32 * ct + 8 * q4 + 4 * hq_); } while (0)
    const bf16* VGT = (const bf16*)(ws + WS_VGT);
    const int itp = wave >> 2, nks = itp == 0 ? 4 : 8;
    const float* Wg = p.ab_w_s + (size_t)g * 128 * 128;
    bf16x8 Ab[3][2]; f32x4 Wb[3][2][2];
#define GM_LOAD(SLOT_, KS_) do { \
        _Pragma("unroll") for (int ct = 0; ct < 2; ++ct) Ab[SLOT_][ct] = *(const bf16x8*)(VGT + (size_t)b * (512 * 2048) + frag_off(64 * g + 32 * ct + l31, 128 * nblk + 16 * (KS_) + 8 * hh, 2048)); \
        _Pragma("unroll") for (int il = 0; il < 2; ++il) { const float* wr_ = Wg + (size_t)(32 * (2 * itp + il) + l31) * 128 + 16 * (KS_) + 4 * hh; \
            Wb[SLOT_][il][0] = *(const f32x4*)wr_; Wb[SLOT_][il][1] = *(const f32x4*)(wr_ + 8); } } while (0)
    GM_LOAD(0, 0); GM_LOAD(1, 1); GM_LOAD(2, 2);
    if (tid < 128) { const f32x4 a = *(const f32x4*)(SSQV + (size_t)(T0 + tid) * 8), c = *(const f32x4*)(SSQV + (size_t)(T0 + tid) * 8 + 4);
        R[tid] = 1.0f / sqrtf(((a[0] + a[1]) + (a[2] + a[3]) + (c[0] + c[1]) + (c[2] + c[3])) * (1.0f / 512.0f) + EPS); }
    __syncthreads();
    bf16* Y = (bf16*)(ws + WS_Y);
    {
        f32x16 acc[2][2];
#pragma unroll
        for (int ct = 0; ct < 2; ++ct)
#pragma unroll
            for (int il = 0; il < 2; ++il)
#pragma unroll
                for (int q = 0; q < 16; ++q) acc[ct][il][q] = 0.f;
#define GM_STEP(KS_) do { const int ja = 16 * (KS_) + 4 * hh;                  \
            const f32x4 r0 = *(const LAS f32x4*)(R + ja), r1 = *(const LAS f32x4*)(R + ja + 8); \
            _Pragma("unroll") for (int il = 0; il < 2; ++il) { \
                const f32x4 w0 = Wb[(KS_) % 3][il][0] * r0, w1 = Wb[(KS_) % 3][il][1] * r1; \
                const bf16x8 B = pack8(w0[0], w0[1], w0[2], w0[3], w1[0], w1[1], w1[2], w1[3]); \
                _Pragma("unroll") for (int ct = 0; ct < 2; ++ct) { acc[ct][il] = MFMA32(Ab[(KS_) % 3][ct], B, acc[ct][il]); \
                    asm volatile("; operands stay live past the MFMA: a fresh destination must not be allocated over them" : "+v"(acc[ct][il]) : "v"(Ab[(KS_) % 3][ct]), "v"(B)); } } } while (0)
        if (nks == 8) {
            GM_STEP(0); GM_LOAD(0, 3); GM_STEP(1); GM_LOAD(1, 4); GM_STEP(2); GM_LOAD(2, 5); GM_STEP(3); GM_LOAD(0, 6); GM_STEP(4); GM_LOAD(1, 7);
            GM_STEP(5); GM_EPI_LOAD(); GM_STEP(6); GM_STEP(7);
        } else { GM_STEP(0); GM_LOAD(0, 3); GM_STEP(1); GM_STEP(2); GM_EPI_LOAD(); GM_STEP(3); }
#undef GM_STEP
#undef GM_LOAD
#undef GM_EPI_LOAD
#pragma unroll
        for (int il = 0; il < 2; ++il) { const int le_ = lane_now(), he_ = le_ >> 5; const int i = 32 * (2 * itp + il) + (le_ & 31), tok = T0 + i; const float bs = bsv[il];
#pragma unroll
            for (int ct = 0; ct < 2; ++ct) { u32x2 X[4];
#pragma unroll
                for (int q4 = 0; q4 < 4; ++q4) {
                    const f32x4 gn = gnv[ct][q4];
                    const u32x2 ux = uu[il][ct][q4];
                    const float u0 = __builtin_bit_cast(float, ux.x << 16), u1 = __builtin_bit_cast(float, ux.x & 0xffff0000u), u2 = __builtin_bit_cast(float, ux.y << 16), u3 = __builtin_bit_cast(float, ux.y & 0xffff0000u);
                    X[q4] = pack4(u0 * (acc[ct][il][4 * q4 + 0] * gn[0] + bs), u1 * (acc[ct][il][4 * q4 + 1] * gn[1] + bs), u2 * (acc[ct][il][4 * q4 + 2] * gn[2] + bs), u3 * (acc[ct][il][4 * q4 + 3] * gn[3] + bs)); }
#pragma unroll
                for (int qp = 0; qp < 2; ++qp) {
                    const u32x2 sx = __builtin_amdgcn_permlane32_swap(X[2 * qp].x, X[2 * qp + 1].x, false, false), sy = __builtin_amdgcn_permlane32_swap(X[2 * qp].y, X[2 * qp + 1].y, false, false);
                    const u32x4 v = {sx[0], sy[0], sx[1], sy[1]};
                    *(u32x4*)(Y + (size_t)tok * 1024 + 512 + 64 * g + 32 * ct + 8 * (2 * qp + he_)) = v; } } }
    }
    if (gridDim.x != 256) __syncthreads();
}

template <int CTRL, int RM> __device__ __forceinline__ int dpp_i(int v) { return __builtin_amdgcn_update_dpp(0, v, CTRL, RM, 0xF, false); }
__device__ __forceinline__ void half_sums(int v, int& s0, int& s1) {
    v += dpp_i<0x111, 0xF>(v); v += dpp_i<0x112, 0xF>(v); v += dpp_i<0x114, 0xF>(v); v += dpp_i<0x118, 0xF>(v);
    v += dpp_i<0x142, 0xA>(v);
    s0 = __builtin_amdgcn_readlane(v, 31); s1 = __builtin_amdgcn_readlane(v, 63);
}
__device__ __forceinline__ int count_ge_all(const LAS unsigned* SC, int n8, unsigned cand, int lane) {
    int cnt = 0;
#pragma unroll 1
    for (int i = 0; i < n8; i += 8) { unsigned u8[8];
#pragma unroll
        for (int k = 0; k < 8; ++k) u8[k] = SC[(i + k) * 64 + lane];
#pragma unroll
        for (int k = 0; k < 8; ++k) asm volatile("v_cmp_ge_u32 vcc, %1, %2\n\tv_addc_co_u32 %0, vcc, 0, %0, vcc" : "+v"(cnt) : "v"(u8[k]), "v"(cand) : "vcc"); }
    return cnt;
}
__device__ __forceinline__ void indexer_select(const Params& p, LAS unsigned* SC, LAS unsigned* LIST, int tq0, int c, int lane) {
    unsigned long long* SEL = (unsigned long long*)(p.ws + WS_SEL);
    const int hh = lane >> 5, n32 = 2 * (c + 1);
    const int n8 = (n32 + 7) & ~7;
    for (int kt = n32; kt < n8; ++kt) SC[kt * 64 + lane] = 0u;
    unsigned T0 = 0u, T1 = 0u; bool ex0 = false, ex1 = false;
    const int ng = n8 >> 3;
    unsigned H[8][4];
#pragma unroll
    for (int g = 0; g < 8; ++g)
        if (g < ng) {
#pragma unroll
            for (int k2 = 0; k2 < 4; ++k2) { const unsigned a = SC[(8 * g + 2 * k2) * 64 + lane], b2 = SC[(8 * g + 2 * k2 + 1) * 64 + lane]; H[g][k2] = (a >> 16) | (b2 & 0xFFFF0000u); }
        } else {
#pragma unroll
            for (int k2 = 0; k2 < 4; ++k2) H[g][k2] = 0u;
        }
#pragma unroll 1
    for (int bit = 31; bit >= 16; --bit) {
        const unsigned c0 = ex0 ? T0 : (T0 | (1u << bit)), c1 = ex1 ? T1 : (T1 | (1u << bit));
        const unsigned cm = ((hh ? c1 : c0) >> 16) - 1u, CM = cm | (cm << 16);
        unsigned acc = 0u;
#pragma unroll
        for (int g = 0; g < 8; ++g)
            if (g < ng) {
#pragma unroll
                for (int k2 = 0; k2 < 4; ++k2) { unsigned d_;
                    asm("v_pk_sub_u16 %0, %1, %2 clamp" : "=v"(d_) : "v"(H[g][k2]), "v"(CM));
                    asm("v_pk_min_u16 %0, %1, %2" : "=v"(d_) : "v"(d_), "v"(0x00010001u));
                    asm("v_pk_add_u16 %0, %1, %2" : "=v"(acc) : "v"(acc), "v"(d_)); }
            }
        int n0, n1; half_sums((int)((acc & 0xFFFFu) + (acc >> 16)), n0, n1);
        if (!ex0 && n0 >= 256) { T0 = c0; ex0 = (n0 == 256); }
        if (!ex1 && n1 >= 256) { T1 = c1; ex1 = (n1 == 256); }
        if (ex0 && ex1) break;
    }
    int need0 = 0, need1 = 0;
    if (!(ex0 && ex1)) {
        const unsigned Tl = hh ? T1 : T0;
#pragma unroll
        for (int s = 0; s < 5; ++s) LIST[s * 64 + lane] = 0u;
        int m = 0, cge = 0;
#pragma unroll 1
        for (int i = 0; i < n8; i += 8) { unsigned u8[8];
#pragma unroll
            for (int k = 0; k < 8; ++k) u8[k] = SC[(i + k) * 64 + lane];
#pragma unroll
            for (int k = 0; k < 8; ++k) { const unsigned d = u8[k] - Tl; cge += (u8[k] >= Tl) ? 1 : 0;
                if (u8[k] >= Tl && d < (1u << 16)) { if (m < 5) LIST[m * 64 + lane] = u8[k]; ++m; } } }
        int ge0, ge1, mb0, mb1; half_sums(cge, ge0, ge1); half_sums(m, mb0, mb1);
        const int G0 = ge0 - mb0, G1 = ge1 - mb1;
        const bool overflow = __ballot(m > 5) != 0ull;
        unsigned v[5];
#pragma unroll
        for (int s = 0; s < 5; ++s) v[s] = LIST[s * 64 + lane];
#pragma unroll 1
        for (int bit = 15; bit >= 0; --bit) {
            const unsigned c0 = ex0 ? T0 : (T0 | (1u << bit)), c1 = ex1 ? T1 : (T1 | (1u << bit));
            const unsigned cand = hh ? c1 : c0;
            int n0, n1;
            if (overflow) half_sums(count_ge_all(SC, n8, cand, lane), n0, n1);
            else { int cnt = 0;
#pragma unroll
                for (int s = 0; s < 5; ++s) cnt += (v[s] >= cand) ? 1 : 0;
                half_sums(cnt, n0, n1); n0 += G0; n1 += G1; }
            if (!ex0 && n0 >= 256) { T0 = c0; ex0 = (n0 == 256); }
            if (!ex1 && n1 >= 256) { T1 = c1; ex1 = (n1 == 256); }
            if (ex0 && ex1) break;
        }
        if (!(ex0 && ex1)) { const unsigned Tf = hh ? T1 : T0; int g0, g1;
            if (overflow) { int cnt = 0;
#pragma unroll 1
                for (int i = 0; i < n8; i += 8) { unsigned u8[8];
#pragma unroll
                    for (int k = 0; k < 8; ++k) u8[k] = SC[(i + k) * 64 + lane];
#pragma unroll
                    for (int k = 0; k < 8; ++k) cnt += (u8[k] > Tf) ? 1 : 0; }
                half_sums(cnt, g0, g1);
            } else { int cnt = 0;
#pragma unroll
                for (int s = 0; s < 5; ++s) cnt += (v[s] > Tf) ? 1 : 0;
                half_sums(cnt, g0, g1); g0 += G0; g1 += G1; }
            need0 = ex0 ? 0 : 256 - g0; need1 = ex1 ? 0 : 256 - g1; }
    }
    const unsigned T = hh ? T1 : T0;
    const bool exl = hh ? ex1 : ex0;
#pragma unroll 1
    for (int i0 = 0; i0 < n8; i0 += 8) {
        unsigned u8[8];
#pragma unroll
        for (int k = 0; k < 8; ++k) u8[k] = SC[(i0 + k) * 64 + lane];
        unsigned s0[8], s1[8];
#pragma unroll
        for (int k = 0; k < 8; ++k) { const unsigned long long mg = __ballot(exl ? (u8[k] >= T) : (u8[k] > T)); s0[k] = (unsigned)mg; s1[k] = (unsigned)(mg >> 32); }
        if (need0 > 0 || need1 > 0) {
#pragma unroll
            for (int k = 0; k < 8; ++k) { const unsigned long long me = __ballot(!exl && u8[k] == T);
                unsigned t0 = (unsigned)me, t1 = (unsigned)(me >> 32);
                while (t0 != 0u && need0 > 0) { const unsigned low = t0 & (0u - t0); s0[k] |= low; t0 ^= low; --need0; }
                while (t1 != 0u && need1 > 0) { const unsigned low = t1 & (0u - t1); s1[k] |= low; t1 ^= low; --need1; } }
        }
        int val = 0;
        asm("v_writelane_b32 %0, %1, 0" : "+v"(val) : "s"(s0[0])); asm("v_writelane_b32 %0, %1, 32" : "+v"(val) : "s"(s1[0]));
        asm("v_writelane_b32 %0, %1, 1" : "+v"(val) : "s"(s0[1])); asm("v_writelane_b32 %0, %1, 33" : "+v"(val) : "s"(s1[1]));
        asm("v_writelane_b32 %0, %1, 2" : "+v"(val) : "s"(s0[2])); asm("v_writelane_b32 %0, %1, 34" : "+v"(val) : "s"(s1[2]));
        asm("v_writelane_b32 %0, %1, 3" : "+v"(val) : "s"(s0[3])); asm("v_writelane_b32 %0, %1, 35" : "+v"(val) : "s"(s1[3]));
        asm("v_writelane_b32 %0, %1, 4" : "+v"(val) : "s"(s0[4])); asm("v_writelane_b32 %0, %1, 36" : "+v"(val) : "s"(s1[4]));
        asm("v_writelane_b32 %0, %1, 5" : "+v"(val) : "s"(s0[5])); asm("v_writelane_b32 %0, %1, 37" : "+v"(val) : "s"(s1[5]));
        asm("v_writelane_b32 %0, %1, 6" : "+v"(val) : "s"(s0[6])); asm("v_writelane_b32 %0, %1, 38" : "+v"(val) : "s"(s1[6]));
        asm("v_writelane_b32 %0, %1, 7" : "+v"(val) : "s"(s0[7])); asm("v_writelane_b32 %0, %1, 39" : "+v"(val) : "s"(s1[7]));
        if ((lane & 31) < 8) ((unsigned*)SEL)[(size_t)(tq0 + hh) * 64 + i0 + (lane & 31)] = (unsigned)val;
    }
}

__device__ __forceinline__ void indexer_unit(const Params& p, LAS unsigned char* lds, int b, int c, int qg, int wave, int lane) {
    unsigned char* ws = p.ws;
    const int tq0 = b * 2048 + 64 * c + 16 * qg, hh = lane >> 5, l31 = lane & 31, tid = wave * 64 + lane;
    if (c < 4) {
        if (tid < 64) { const int q = tid >> 2, kt = tid & 3; if (kt <= c) ((unsigned long long*)(ws + WS_SEL))[(size_t)(tq0 + q) * 32 + kt] = ~0ull; }
        return;
    }
    LAS unsigned* SCall = (LAS unsigned*)lds;
    LAS float* WQ = (LAS float*)(lds + LDSX_OFF);
    const bf16* IQ = (const bf16*)(ws + WS_IQ); const bf16* IK = (const bf16*)(ws + WS_IK); const float* IW = (const float*)(ws + WS_IW);
    const int n32 = 2 * (c + 1);
    const bf16* ikp = IK + frag_off(b * 2048 + l31, 8 * hh, 64);
    float wq_ = 0.f; if (tid < 256) wq_ = IW[(size_t)tq0 * 16 + tid];
    const bf16* iqp = IQ + frag_off((tq0 >> 1) * 32 + l31, 8 * hh, 64);
    bf16x8 Ac[4];
#pragma unroll
    for (int ks = 0; ks < 4; ++ks) Ac[ks] = *(const bf16x8*)(iqp + ks * 512);
    bf16x8 Bt[8][4];
#pragma unroll
    for (int j = 0; j < 8; ++j) { const int kt = wave + 8 * j < n32 ? wave + 8 * j : wave;
#pragma unroll
        for (int ks = 0; ks < 4; ++ks) Bt[j][ks] = *(const bf16x8*)(ikp + (size_t)((kt * 4 + ks) * 512)); }
    asm volatile("" : "+v"(wq_)); if (tid < 256) WQ[tid] = wq_;
    __syncthreads();
#pragma unroll 1
    for (int mt = 0; mt < 8; ++mt) {
        const int mtn = mt + 1 < 8 ? mt + 1 : mt;
        bf16x8 An[4];
#pragma unroll
        for (int ks = 0; ks < 4; ++ks) An[ks] = *(const bf16x8*)(iqp + (size_t)((mtn * 4 + ks) * 512));
        const LAS f32x4* wq = (const LAS f32x4*)(WQ + (2 * mt + hh) * 16);
        const f32x4 w0 = wq[0], w1 = wq[1], w2 = wq[2], w3 = wq[3];
#pragma unroll
        for (int j = 0; j < 8; ++j) {
            if (wave + 8 * j < n32) {
                f32x16 a;
#pragma unroll
                for (int q = 0; q < 16; ++q) a[q] = 0.f;
#pragma unroll
                for (int ks = 0; ks < 4; ++ks) a = MFMA32(Ac[ks], Bt[j][ks], a);
                asm volatile("s_nop 10" : "+v"(a));
                float s4[4];
#define IDX_RELU(T_, A_) asm("v_max_f32 %0, 0, %1" : "=v"(T_) : "v"(A_))
#pragma unroll
                for (int i = 0; i < 4; ++i) { float t_; IDX_RELU(t_, a[i]); asm("v_mul_f32 %0, %1, %2" : "=v"(s4[i]) : "v"(w0[i]), "v"(t_)); }
#pragma unroll
                for (int i = 0; i < 4; ++i) { float t_; IDX_RELU(t_, a[4 + i]); asm("v_fmac_f32 %0, %1, %2" : "+v"(s4[i]) : "v"(w1[i]), "v"(t_)); }
#pragma unroll
                for (int i = 0; i < 4; ++i) { float t_; IDX_RELU(t_, a[8 + i]); asm("v_fmac_f32 %0, %1, %2" : "+v"(s4[i]) : "v"(w2[i]), "v"(t_)); }
#pragma unroll
                for (int i = 0; i < 4; ++i) { float t_; IDX_RELU(t_, a[12 + i]); asm("v_fmac_f32 %0, %1, %2" : "+v"(s4[i]) : "v"(w3[i]), "v"(t_)); }
#undef IDX_RELU
                float sc;
                asm("v_add_f32 %0, %1, %2" : "=v"(sc) : "v"(s4[0]), "v"(s4[1])); asm("v_add_f32 %0, %0, %1" : "+v"(s4[2]) : "v"(s4[3])); asm("v_add_f32 %0, %0, %1" : "+v"(sc) : "v"(s4[2]));
                unsigned bits = __builtin_bit_cast(unsigned, sc); bits ^= (bits >> 31) ? 0xFFFFFFFFu : 0x80000000u;
                SCall[mt * 4096 + (wave + 8 * j) * 64 + lane] = bits;
            }
        }
#pragma unroll
        for (int ks = 0; ks < 4; ++ks) Ac[ks] = An[ks];
    }
    __syncthreads();
    indexer_select(p, SCall + wave * 4096, (LAS unsigned*)(lds + LDSX_OFF + 1024) + wave * 320, tq0 + 2 * wave, c, lane);
}

__device__ __forceinline__ void p2_gmlp(const Params& p, LAS unsigned char* lds, int wave, int lane) {
    for (int u = blockIdx.x; u < 256; u += gridDim.x) gmlp_unit(p, lds, u, wave, lane);
}
__device__ __forceinline__ void p2_indexer(const Params& p, LAS unsigned char* lds, int wave, int lane) {
#pragma unroll 1
    for (int it = blockIdx.x; it < 512; it += gridDim.x) {
        const int b = it & 7, cp = (it >> 3) & 15, qg = it >> 7;
#pragma unroll 1
        for (int sub = 0; sub < 2; ++sub) indexer_unit(p, lds, b, sub ? cp : 31 - cp, qg, wave, lane);
    }
}

__device__ __forceinline__ void p3_attention(const Params& p, LAS unsigned char* lds, int wave, int lane) {
    unsigned char* ws = p.ws;
    LAS unsigned* SELL = (LAS unsigned*)(lds + 8192 + 4 * 17 * 1024);
    LAS float* BT = (LAS float*)lds;
    const bf16* Q = (const bf16*)(ws + WS_Q); const bf16* K = (const bf16*)(ws + WS_K); const bf16* VT = (const bf16*)(ws + WS_VT); bf16* Y = (bf16*)(ws + WS_Y);
    const unsigned long long* SEL = (const unsigned long long*)(ws + WS_SEL);
    for (int item = blockIdx.x; item < 256; item += gridDim.x) {
        const int lane_ = lane_now(), hh = lane_ >> 5, l31 = lane_ & 31;
        const int b = item & 7, g = (item >> 3) & 1, cp = item >> 4;
        const int hd = wave & 3, head = 4 * g + hd, kh = wave >> 2, bh = b * 8 + head;
        const LAS float* bt = BT + head * 256;
        int c = 31 - cp;
#define tq0 (64 * c + l31)
#define nTw (c + 1)
#define SELW(S_, NQ_, T_) SELL[((S_) * 64 + 32 * (NQ_) + l31) * 65 + (T_)]
        const bf16* kbase = K + (size_t)bh * (2048 * 64) + (size_t)(hh * 32 + l31) * 8;
        const bf16* vbase = VT + (size_t)b * (512 * 2048) + frag_off(head * 64 + l31, 8 * hh, 2048);
        bf16x8 Qo[2][4], K0[4], K1[4], V0[2][2], V1[2][2]; unsigned w0[2], w1[2];
#define ATT_LOAD(KX, VX, WX, I, SUB_) do { const int T_ = kh + 2 * ((I) < nTw ? (I) : nTw - 1); \
                _Pragma("unroll") for (int ks = 0; ks < 4; ++ks) KX[ks] = *(const bf16x8*)(kbase + (size_t)((T_ * 4 + ks) * 512)); \
                _Pragma("unroll") for (int s2 = 0; s2 < 2; ++s2) _Pragma("unroll") for (int dt = 0; dt < 2; ++dt) VX[s2][dt] = *(const bf16x8*)(vbase + (size_t)dt * (128 * 512) + (size_t)((2 * T_ + s2) * 512)); \
                WX[0] = SELW(SUB_, 0, T_); WX[1] = SELW(SUB_, 1, T_); } while (0)
#define ATT_LOADQ() do { _Pragma("unroll") for (int nq = 0; nq < 2; ++nq) _Pragma("unroll") for (int ks = 0; ks < 4; ++ks) \
                Qo[nq][ks] = *(const bf16x8*)(Q + (size_t)bh * (2048 * 64) + frag_off(tq0 + 32 * nq, 16 * ks + 8 * hh, 64)); } while (0)
        ATT_LOADQ();
#pragma unroll
        for (int ks = 0; ks < 4; ++ks) K0[ks] = *(const bf16x8*)(kbase + (size_t)((kh * 4 + ks) * 512));
#pragma unroll
        for (int s2 = 0; s2 < 2; ++s2)
#pragma unroll
            for (int dt = 0; dt < 2; ++dt) V0[s2][dt] = *(const bf16x8*)(vbase + (size_t)dt * (128 * 512) + (size_t)((2 * kh + s2) * 512));
        if (item != (int)blockIdx.x) __syncthreads();
        {
            const int tid_ = wave * 64 + lane_;
            u32x4 sv_[4]; float bv_[4];
#pragma unroll
            for (int j = 0; j < 4; ++j) {
                const int k_ = tid_ + 512 * j, s_ = k_ >> 10, row_ = (k_ >> 4) & 63, part_ = k_ & 15;
                sv_[j] = *(const u32x4*)((const unsigned*)SEL + (size_t)(b * 2048 + 64 * (s_ ? cp : 31 - cp) + row_) * 64 + 4 * part_);
            }
            if (item == (int)blockIdx.x) {
#pragma unroll
                for (int j = 0; j < 4; ++j) { const int idx = tid_ + 512 * j;
                    const int h = idx >> 8, rel = (idx & 255) - 191, n = rel < 0 ? -rel : rel;
                    int bk = rel > 0 ? 16 : 0;
                    if (n < 8) bk += n; else { int lg = 33 - __builtin_clz((unsigned)(n * n)); bk += lg < 15 ? lg : 15; }
                    bv_[j] = p.rel_bias[bk * 8 + h]; }
            }
#pragma unroll
            for (int j = 0; j < 4; ++j) {
                const int k_ = tid_ + 512 * j, s_ = k_ >> 10, row_ = (k_ >> 4) & 63, part_ = k_ & 15;
                LAS unsigned* d_ = SELL + (s_ * 64 + row_) * 65 + 4 * part_;
                d_[0] = sv_[j][0]; d_[1] = sv_[j][1]; d_[2] = sv_[j][2]; d_[3] = sv_[j][3];
            }
            if (item == (int)blockIdx.x) {
#pragma unroll
                for (int j = 0; j < 4; ++j) BT[tid_ + 512 * j] = bv_[j] * LOG2E;
            }
        }
        __syncthreads();
        w0[0] = SELW(0, 0, kh); w0[1] = SELW(0, 1, kh);
        const float bfar = bt[0];
#pragma unroll 1
        for (int sub = 0; sub < 2; ++sub) {
            f32x16 O[2][2];
#pragma unroll
            for (int q = 0; q < 16; ++q) { O[0][0][q] = 0.f; O[0][1][q] = 0.f; O[1][0][q] = 0.f; O[1][1][q] = 0.f; }
            float mrun[2] = {-1e30f, -1e30f}, lsum[2] = {0.f, 0.f};
#define ATT_PAIR(J, KB0, KB1) { int m0_, m1_; asm("v_bfe_i32 %0, %1, " #KB0 ", 1" : "=v"(m0_) : "v"(w)); asm("v_bfe_i32 %0, %1, " #KB1 ", 1" : "=v"(m1_) : "v"(w)); \
                float a0_, a1_; asm("v_add_f32 %0, %1, %2" : "=v"(a0_) : "v"(S[nq][2 * J]), "v"(sh_)); asm("v_add_f32 %0, %1, %2" : "=v"(a1_) : "v"(S[nq][2 * J + 1]), "v"(sh_)); \
                const float e0_ = __builtin_bit_cast(float, __builtin_bit_cast(unsigned, fexp2(a0_)) & (unsigned)m0_), e1_ = __builtin_bit_cast(float, __builtin_bit_cast(unsigned, fexp2(a1_)) & (unsigned)m1_); \
                pk[J] = cvt_pk(e0_, e1_); \
                asm("v_add_f32 %0, %0, %1" : "+v"(ps0_) : "v"(e0_)); asm("v_add_f32 %0, %0, %1" : "+v"(ps1_) : "v"(e1_)); }
#define ATT_STEP(NEAR) do { \
                ATT_LOAD(K1, V1, w1, i + 1, sub); \
                const int T = kh + 2 * i; \
                f32x16 S[2]; \
                _Pragma("unroll") for (int nq = 0; nq < 2; ++nq) { \
                    _Pragma("unroll") for (int q = 0; q < 16; ++q) S[nq][q] = 0.f; \
                    _Pragma("unroll") for (int ks = 0; ks < 4; ++ks) S[nq] = MFMA32(K0[ks], Qo[nq][ks], S[nq]); \
                    asm volatile("; operands stay live past the MFMAs: a fresh destination must not be allocated over them" : "+v"(S[nq]) : "v"(K0[0]), "v"(K0[1]), "v"(K0[2]), "v"(K0[3])); \
                } \
                _Pragma("unroll") for (int nq = 0; nq < 2; ++nq) { \
                    if (NEAR) { const LAS float* btp = bt + (32 * T - tq0 - 32 * nq + 191) + 4 * hh; \
                        _Pragma("unroll") for (int q = 0; q < 16; ++q) S[nq][q] += btp[(q & 3) + 8 * (q >> 2)]; } \
                    float tmax = S[nq][0]; \
                    _Pragma("unroll") for (int q = 1; q < 16; ++q) tmax = fmaxf(tmax, S[nq][q]); \
                    if (!(NEAR)) tmax += bfar; \
                      \
                    { const u32x2 r_ = __builtin_amdgcn_permlane32_swap(__builtin_bit_cast(unsigned, tmax), __builtin_bit_cast(unsigned, tmax), false, false); \
                      tmax = fmaxf(__builtin_bit_cast(float, r_[0]), __builtin_bit_cast(float, r_[1])); } \
                    if (__builtin_amdgcn_ballot_w64(tmax > mrun[nq] + 8.0f)) {     \
                        const float mnew = fmaxf(mrun[nq], tmax), alpha = fexp2(mrun[nq] - mnew); \
                        mrun[nq] = mnew; lsum[nq] *= alpha; \
                        _Pragma("unroll") for (int q = 0; q < 16; ++q) { O[nq][0][q] *= alpha; O[nq][1][q] *= alpha; } \
                    } \
                    const unsigned w = w0[nq] >> (4 * hh);                  \
                    const float sh_ = (NEAR) ? -mrun[nq] : bfar - mrun[nq]; \
                    unsigned pk[8]; float ps0_ = 0.f, ps1_ = 0.f; \
                    ATT_PAIR(0, 0, 1) ATT_PAIR(1, 2, 3) ATT_PAIR(2, 8, 9) ATT_PAIR(3, 10, 11) ATT_PAIR(4, 16, 17) ATT_PAIR(5, 18, 19) ATT_PAIR(6, 24, 25) ATT_PAIR(7, 26, 27) \
                    lsum[nq] += ps0_ + ps1_; \
                    _Pragma("unroll") for (int s2 = 0; s2 < 2; ++s2) { \
                        const bf16x8 Po = __builtin_bit_cast(bf16x8, u32x4{pk[4 * s2], pk[4 * s2 + 1], pk[4 * s2 + 2], pk[4 * s2 + 3]}); \
                        _Pragma("unroll") for (int dt = 0; dt < 2; ++dt) O[nq][dt] = MFMA32(V0[s2][dt], Po, O[nq][dt]); \
                    } \
                } \
                _Pragma("unroll") for (int ks = 0; ks < 4; ++ks) K0[ks] = K1[ks]; \
                _Pragma("unroll") for (int s2 = 0; s2 < 2; ++s2) _Pragma("unroll") for (int dt = 0; dt < 2; ++dt) V0[s2][dt] = V1[s2][dt]; \
                w0[0] = w1[0]; w0[1] = w1[1]; } while (0)
            const int nfar = c > 2 ? c - 2 : 0;
            int i = 0;
#pragma unroll 1
            for (; i < nfar; ++i) ATT_STEP(false);
#pragma unroll 1
            for (; i < nTw; ++i) ATT_STEP(true);
#undef ATT_STEP
#undef ATT_PAIR
            const int cs_ = c;
            if (sub == 0) {
                c = cp;
                ATT_LOADQ();
#pragma unroll
                for (int ks = 0; ks < 4; ++ks) K0[ks] = *(const bf16x8*)(kbase + (size_t)((kh * 4 + ks) * 512));
            }
            LAS float* MG = (LAS float*)(lds + 8192 + hd * (17 * 1024));
            if (sub != 0) __syncthreads();
            if (kh == 1) {
#pragma unroll
                for (int nq = 0; nq < 2; ++nq) {
#pragma unroll
                    for (int dt = 0; dt < 2; ++dt)
#pragma unroll
                        for (int q4 = 0; q4 < 4; ++q4)
                            *(LAS f32x4*)(MG + ((nq * 2 + dt) * 4 + q4) * 256 + lane_ * 4) = f32x4{O[nq][dt][4 * q4], O[nq][dt][4 * q4 + 1], O[nq][dt][4 * q4 + 2], O[nq][dt][4 * q4 + 3]};
                    MG[4096 + nq * 64 + lane_] = mrun[nq]; MG[4096 + 128 + nq * 64 + lane_] = lsum[nq];
                }
            }
            __syncthreads();
            if (kh == 0) {
                LAS unsigned char* ST = (LAS unsigned char*)MG;
#pragma unroll
                for (int nq = 0; nq < 2; ++nq) {
                    const float mB = MG[4096 + nq * 64 + lane_], lB = MG[4096 + 128 + nq * 64 + lane_];
                    const float m = fmaxf(mrun[nq], mB);
                    float fa = fexp2(mrun[nq] - m), fb = fexp2(mB - m);
                    float l = lsum[nq] * fa + lB * fb;
                    l += __shfl_xor(l, 32);
                    const float inv = 1.0f / l;
                    fa *= inv; fb *= inv;
#pragma unroll
                    for (int dt = 0; dt < 2; ++dt)
#pragma unroll
                        for (int q4 = 0; q4 < 4; ++q4) {
                            const f32x4 ob = *(const LAS f32x4*)(MG + ((nq * 2 + dt) * 4 + q4) * 256 + lane_ * 4);
#pragma unroll
                            for (int i = 0; i < 4; ++i) O[nq][dt][4 * q4 + i] = O[nq][dt][4 * q4 + i] * fa + ob[i] * fb;
                        }
#pragma unroll
                    for (int dt = 0; dt < 2; ++dt)
#pragma unroll
                        for (int q4 = 0; q4 < 4; ++q4) {
                            const int r = 32 * nq + l31, u = 8 * dt + 2 * q4 + hh;
                            *(LAS u32x2*)(ST + r * 128 + ((u ^ ((r & 7) << 1)) * 8)) = pack4(O[nq][dt][4 * q4], O[nq][dt][4 * q4 + 1], O[nq][dt][4 * q4 + 2], O[nq][dt][4 * q4 + 3]);
                        }
                    __builtin_amdgcn_sched_barrier(0);
                }
                const int ln2_ = lane_now();
                bf16* yb = Y + (size_t)(b * 2048 + 64 * cs_) * 1024 + head * 64;
#pragma unroll
                for (int it = 0; it < 8; ++it) {
                    const int rr = 8 * it + (ln2_ >> 3), ch = ln2_ & 7;
                    *(u32x4*)(yb + (size_t)rr * 1024 + ch * 8) = *(const LAS u32x4*)(ST + rr * 128 + ((ch ^ (rr & 7)) * 16));
                }
            }
            if (sub == 0) {
#pragma unroll
                for (int s2 = 0; s2 < 2; ++s2)
#pragma unroll
                    for (int dt = 0; dt < 2; ++dt) V0[s2][dt] = *(const bf16x8*)(vbase + (size_t)dt * (128 * 512) + (size_t)((2 * kh + s2) * 512));
                w0[0] = SELW(1, 0, kh); w0[1] = SELW(1, 1, kh);
            }
        }
#undef ATT_LOAD
#undef ATT_LOADQ
#undef tq0
#undef nTw
#undef SELW
    }
}

__device__ __forceinline__ void p_convfix_rows(const Params& p, int layer, int row_lo, int nrows, int t0, int nthr) {
    unsigned char* ws = p.ws; const float* HB = (const float*)(ws + WS_HB); bf16* ACT = (bf16*)(ws + WS_ACT);
    const float* cw = p.ffn_conv_w + (size_t)layer * 3 * NUP; const float* cbv = p.ffn_conv_b + (size_t)layer * NUP;
    const int total = nrows * (DFF / 4);
#pragma unroll 3
    for (int idx = t0; idx < total; idx += nthr) {
        const int row = row_lo + idx / (DFF / 4), c4 = (idx % (DFF / 4)) * 4, grp = row >> 1, w = row & 1, tok = 128 * grp + w;
        const bool first = (tok & 2047) < 2;
        f32x4 y[2];
#pragma unroll
        for (int half = 0; half < 2; ++half) { const int col = half * DFF + c4;
            const f32x4 h0 = *(const f32x4*)(HB + ((size_t)grp * 4 + 2 + w) * NUP + col);
            f32x4 h1, h2; const f32x4 z = {0.f, 0.f, 0.f, 0.f};
            if (w == 0) { h1 = first ? z : *(const f32x4*)(HB + ((size_t)(grp - 1) * 4 + 1) * NUP + col); h2 = first ? z : *(const f32x4*)(HB + ((size_t)(grp - 1) * 4 + 0) * NUP + col); }
            else        { h1 = *(const f32x4*)(HB + ((size_t)grp * 4 + 2) * NUP + col); h2 = first ? z : *(const f32x4*)(HB + ((size_t)(grp - 1) * 4 + 1) * NUP + col); }
            y[half] = *(const f32x4*)(cbv + col) + *(const f32x4*)(cw + 2 * NUP + col) * h0 + *(const f32x4*)(cw + NUP + col) * h1 + *(const f32x4*)(cw + col) * h2; }
        *(u32x2*)(ACT + (size_t)tok * DFF + c4) = pack4(fsilu(y[0][0]) * y[1][0], fsilu(y[0][1]) * y[1][1], fsilu(y[0][2]) * y[1][2], fsilu(y[0][3]) * y[1][3]);
    }
}

__device__ __forceinline__ void p_convfix(const Params& p, int layer, int wave, int lane) { p_convfix_rows(p, layer, 0, 256, blockIdx.x * (NWAVES * 64) + wave * 64 + lane, gridDim.x * NWAVES * 64); }
struct HgX { bf16x8 bq[2][2], kq[2][2], akt[4], bi[4]; };
__device__ __forceinline__ void hg_lds_put(LAS float* buf, int tt, int slot, const f32x16& o, int lane) {
    LAS f32x4* d = (LAS f32x4*)(buf + (tt * 4 + slot) * 1024) + lane;
#pragma unroll
    for (int k = 0; k < 4; ++k) d[k * 64] = (f32x4){o[4 * k], o[4 * k + 1], o[4 * k + 2], o[4 * k + 3]};
}
__device__ __forceinline__ void hg_reader(LAS float* buf, bf16* OB, float* OSSQ, int tokc, int h, int es, int hw, int lane) {
    const int tt = hw >> 2, tl = 8 * (hw & 3) + (lane & 7), part = lane >> 3;
    const LAS f32x4* src = (const LAS f32x4*)(buf + tt * 4 * 1024) + (part >> 1) * 64 + 32 * (part & 1) + tl;
    f32x4 v = src[0];
#pragma unroll
    for (int s = 1; s < 4; ++s) v += src[s * 256];
    float ss = (v[0] * v[0] + v[1] * v[1]) + (v[2] * v[2] + v[3] * v[3]);
    ss += __shfl_xor(ss, 8); ss += __shfl_xor(ss, 16); ss += __shfl_xor(ss, 32);
    const int tok = tokc + 32 * tt + tl;
    *(u32x2*)(OB + (size_t)tok * 1024 + h * 128 + es * 32 + 4 * part) = pack4(v[0], v[1], v[2], v[3]);
    if (part == 0) OSSQ[(size_t)tok * 32 + h * 4 + es] = ss;
}
#define HG_SYNC() do { asm volatile("s_waitcnt lgkmcnt(0)" ::: "memory"); __builtin_amdgcn_s_barrier(); asm volatile("" ::: "memory"); } while (0)
__device__ __forceinline__ void p9_hgrn(const Params& p, LAS unsigned char* lds, int wave, int lane) {
    unsigned char* ws = p.ws;
    const bf16* QM = (const bf16*)(ws + WS_QM); const bf16* KM = (const bf16*)(ws + WS_KM); const bf16* KMT = (const bf16*)(ws + WS_KMT); const bf16* IT = (const bf16*)(ws + WS_IT);
    const float* EB = (const float*)(ws + WS_EB); const float* FAC = (const float*)(ws + WS_FAC);
    bf16* OB = (bf16*)p.out; float* OSSQ = (float*)(ws + WS_OSSQ);
    LAS float* OBUF = (LAS float*)lds;
    LAS float* EFA = (LAS float*)(lds + 65536);
    const int hh = lane >> 5, l31 = lane & 31;
    HG_SYNC();
    for (int ub = blockIdx.x; ub < 256; ub += gridDim.x) {
        const int unit = (gridDim.x == 256) ? (ub & 7) * 32 + (ub >> 3) : ub;
        const int b = unit >> 5, h = (unit >> 2) & 7, es = unit & 3, bh = b * 8 + h, tb0 = b * 2048;
        const float* ebp = EB + ((size_t)(b * 32 * 8 + h)) * 128; const float* fcp = FAC + ((size_t)(b * 32 * 8 + h)) * 128;
        if (wave < 4) {
            const int dt = wave;
            f32x16 S;
#pragma unroll
            for (int q = 0; q < 16; ++q) S[q] = 0.f;
            const bf16* qmp = QM + (size_t)bh * (2048 * 128) + frag_off(l31, 32 * dt + 8 * hh, 128);
            const bf16* kmp = KM + (size_t)bh * (2048 * 128) + frag_off(l31, 32 * dt + 8 * hh, 128);
            const bf16* ktp = KMT + (size_t)bh * (128 * 2048) + frag_off(32 * dt + l31, 8 * hh, 2048);
            const bf16* itp = IT + (size_t)bh * (128 * 2048) + frag_off(es * 32 + l31, 8 * hh, 2048);
#define HGX_LOAD(X, c) do { \
            _Pragma("unroll") for (int t2 = 0; t2 < 2; ++t2) _Pragma("unroll") for (int s2 = 0; s2 < 2; ++s2) { \
                X.bq[t2][s2] = *(const bf16x8*)(qmp + (size_t)(((2 * (c) + t2) * 8 + s2) * 512)); X.kq[t2][s2] = *(const bf16x8*)(kmp + (size_t)(((2 * (c) + t2) * 8 + s2) * 512)); } \
            _Pragma("unroll") for (int k4 = 0; k4 < 4; ++k4) { X.akt[k4] = *(const bf16x8*)(ktp + (4 * (c) + k4) * 512); X.bi[k4] = *(const bf16x8*)(itp + (4 * (c) + k4) * 512); } } while (0)
#define HGX_TILE(X, st, tt, O) do { f32x16 a; _Pragma("unroll") for (int q = 0; q < 16; ++q) a[q] = 0.f; \
                _Pragma("unroll") for (int s2 = 0; s2 < 2; ++s2) a = MFMA32(X.kq[st][s2], X.bq[tt][s2], a); \
                asm volatile("; operands stay live past the MFMAs" : "+v"(a) : "v"(X.kq[st][0]), "v"(X.kq[st][1]), "v"(X.bq[tt][0]), "v"(X.bq[tt][1])); \
                if ((st) == (tt)) { _Pragma("unroll") for (int q = 0; q < 16; ++q) { const int srow = (q & 3) + 8 * (q >> 2) + 4 * hh; a[q] = (l31 >= srow) ? a[q] : 0.f; } } \
                _Pragma("unroll") for (int s2 = 0; s2 < 2; ++s2) { const bf16x8 Pa = pack8(a[8 * s2], a[8 * s2 + 1], a[8 * s2 + 2], a[8 * s2 + 3], a[8 * s2 + 4], a[8 * s2 + 5], a[8 * s2 + 6], a[8 * s2 + 7]); \
                    O = MFMA32(X.bi[2 * (st) + s2], Pa, O); asm volatile("; B operand stays live past the MFMA: a fresh destination must not be allocated over it" : "+v"(O) : "v"(Pa)); } } while (0)
#define HGX_STEP(X, c) do { \
            const LAS float* ef = EFA + (c) * 256 + 32 * dt + 4 * hh; \
            _Pragma("unroll") for (int q4 = 0; q4 < 4; ++q4) { const f32x4 e4 = *(const LAS f32x4*)(ef + 8 * q4); _Pragma("unroll") for (int i = 0; i < 4; ++i) S[4 * q4 + i] *= e4[i]; } \
            bf16x8 So[2]; _Pragma("unroll") for (int s2 = 0; s2 < 2; ++s2) So[s2] = pack8(S[8 * s2], S[8 * s2 + 1], S[8 * s2 + 2], S[8 * s2 + 3], S[8 * s2 + 4], S[8 * s2 + 5], S[8 * s2 + 6], S[8 * s2 + 7]); \
            LAS float* buf = OBUF + ((c) & 1) * 8192; \
            { f32x16 O; _Pragma("unroll") for (int q = 0; q < 16; ++q) O[q] = 0.f; \
              HGX_TILE(X, 0, 0, O); _Pragma("unroll") for (int s2 = 0; s2 < 2; ++s2) O = MFMA32(So[s2], X.bq[0][s2], O); hg_lds_put(buf, 0, dt, O, lane); } \
            { f32x16 O; _Pragma("unroll") for (int q = 0; q < 16; ++q) O[q] = 0.f; \
              HGX_TILE(X, 0, 1, O); HGX_TILE(X, 1, 1, O); _Pragma("unroll") for (int s2 = 0; s2 < 2; ++s2) O = MFMA32(So[s2], X.bq[1][s2], O); hg_lds_put(buf, 1, dt, O, lane); } \
            _Pragma("unroll") for (int k4 = 0; k4 < 4; ++k4) S = MFMA32(X.akt[k4], X.bi[k4], S); \
            _Pragma("unroll") for (int q4 = 0; q4 < 4; ++q4) { const f32x4 f4 = *(const LAS f32x4*)(ef + 128 + 8 * q4); _Pragma("unroll") for (int i = 0; i < 4; ++i) S[4 * q4 + i] *= f4[i]; } \
            HG_SYNC(); } while (0)
            HgX XA, XB_;
            HGX_LOAD(XA, 0);
            HG_SYNC();
#pragma unroll 1
            for (int c = 0; c < 32; c += 2) { HGX_LOAD(XB_, c + 1); HGX_STEP(XA, c); { const int cn = c + 2 < 32 ? c + 2 : 31; HGX_LOAD(XA, cn); } HGX_STEP(XB_, c + 1); }
#undef HGX_LOAD
#undef HGX_STEP
#undef HGX_TILE
        } else {
            const int hq = wave - 4;
            {
                const int j = lane & 31, kh = lane >> 5;
#pragma unroll
                for (int k = 0; k < 4; ++k) { const int cc = 8 * hq + 2 * k + kh;
                    const f32x4 ve = *(const f32x4*)(ebp + cc * 1024 + 4 * j), vf = *(const f32x4*)(fcp + cc * 1024 + 4 * j);
                    *(LAS f32x4*)(EFA + cc * 256 + 4 * j) = ve; *(LAS f32x4*)(EFA + cc * 256 + 128 + 4 * j) = vf; }
            }
            HG_SYNC();
#pragma unroll 1
            for (int c = 0; c < 32; ++c) {
                LAS float* buf = OBUF + (c & 1) * 8192;
                HG_SYNC();
                hg_reader(buf, OB, OSSQ, tb0 + 64 * c, h, es, 2 * hq, lane); hg_reader(buf, OB, OSSQ, tb0 + 64 * c, h, es, 2 * hq + 1, lane);
            }
        }
        HG_SYNC();
    }
}

__device__ __forceinline__ void p10_outnorm(const Params& p, int wave, int lane) {
    unsigned char* ws = p.ws; const bf16* OB = (const bf16*)p.out; const bf16* GATE = (const bf16*)(ws + WS_GATE); const float* OSSQ = (const float*)(ws + WS_OSSQ); bf16* ON = (bf16*)(ws + WS_ON);
    const int gw = blockIdx.x * NWAVES + wave, NGW = gridDim.x * NWAVES;
    const int col = 16 * lane, h = lane >> 3;
    f32x4 n0[2], n1[2];
#pragma unroll
    for (int k = 0; k < 2; ++k) { const int cc = col + 8 * k; n0[k] = *(const f32x4*)(p.c_out_norm + (cc & 127)); n1[k] = *(const f32x4*)(p.c_out_norm + (cc & 127) + 4); }
    for (int m0 = gw; m0 < M; m0 += 4 * NGW) {
        u32x4 o[4][2], g[4][2]; f32x4 sq[4];
#pragma unroll
        for (int r = 0; r < 4; ++r) { const int mr = m0 + r * NGW, m = mr < M ? mr : m0; sq[r] = *(const f32x4*)(OSSQ + (size_t)m * 32 + 4 * h);
#pragma unroll
            for (int k = 0; k < 2; ++k) { o[r][k] = *(const u32x4*)(OB + (size_t)m * 1024 + col + 8 * k); g[r][k] = *(const u32x4*)(GATE + (size_t)m * 1024 + col + 8 * k); } }
#pragma unroll
        for (int r = 0; r < 4; ++r) { const int m = m0 + r * NGW;
            if (m < M) {
                const float rn = 1.0f / sqrtf(((sq[r][0] + sq[r][1]) + (sq[r][2] + sq[r][3])) * (1.0f / 128.0f) + EPS);
#pragma unroll
                for (int k = 0; k < 2; ++k) { const int cc = col + 8 * k;
                    float v[8];
#pragma unroll
                    for (int i = 0; i < 4; ++i) { const unsigned ow = o[r][k][i], gwd = g[r][k][i];
                        v[2 * i] = __builtin_bit_cast(float, ow << 16) * __builtin_bit_cast(float, gwd << 16); v[2 * i + 1] = __builtin_bit_cast(float, ow & 0xffff0000u) * __builtin_bit_cast(float, gwd & 0xffff0000u); }
                    *(bf16x8*)(ON + (size_t)m * 1024 + cc) = pack8(v[0] * rn * n0[k][0], v[1] * rn * n0[k][1], v[2] * rn * n0[k][2], v[3] * rn * n0[k][3], v[4] * rn * n1[k][0], v[5] * rn * n1[k][1], v[6] * rn * n1[k][2], v[7] * rn * n1[k][3]);
                }
            }
        }
    }
}

__device__ __forceinline__ void p15_final(const Params& p, int wave, int lane) {
    const float* SSQ = (const float*)(p.ws + WS_SSQA) + 3 * M; const bf16* XB = (const bf16*)(p.ws + WS_XB);
    const int gw = blockIdx.x * NWAVES + wave, NGW = gridDim.x * NWAVES;
    for (int m = gw; m < M; m += NGW) {
        const float rn = 1.0f / sqrtf(SSQ[m] * (1.0f / DM) + EPS);
        f32x4* xr = (f32x4*)(p.out + (size_t)m * DM) + lane; const f32x4* gr = (const f32x4*)p.final_norm + lane; const u32x2* xb = (const u32x2*)(XB + (size_t)m * DM) + lane;
#pragma unroll
        for (int j = 0; j < 4; ++j) { const u32x2 w = xb[64 * j]; f32x4 v; v[0] = __builtin_bit_cast(float, w.x << 16); v[1] = __builtin_bit_cast(float, w.x & 0xffff0000u); v[2] = __builtin_bit_cast(float, w.y << 16); v[3] = __builtin_bit_cast(float, w.y & 0xffff0000u);
            xr[64 * j] = v * rn * gr[64 * j]; }
    }
}

constexpr int NPHASE = 16;
__global__ void __launch_bounds__(NWAVES * 64, 2) mk_fwd(Params p) {
    extern __shared__ __attribute__((aligned(16))) unsigned char lds_raw[];
    LAS unsigned char* lds = (LAS unsigned char*)lds_raw;
    volatile LAS unsigned* MISC = (volatile LAS unsigned*)(lds + MISC_OFF);
    const int wave = __builtin_amdgcn_readfirstlane(threadIdx.x >> 6);
    unsigned char* ws = p.ws;
    for (int u = wave * 64 + lane_now(); u < (LDS_BYTES - MISC_OFF) / 4; u += NWAVES * 64) ((LAS unsigned*)(lds + MISC_OFF))[u] = 0u;
    __syncthreads();
    const bool one = (MK_N_LAUNCHES == 1);
    XcdBarrier bar; bar.bar = (unsigned*)(ws + WS_CTL) + CW_BAR; bar.x = 0; bar.st = nullptr;
    if (one) bar = xcd_barrier_post((unsigned*)(ws + WS_CTL) + CW_BAR, MISC + 8, wave == 0 && lane_now() == 0);
    const int lo = p.ph_lo, hi = p.ph_hi;
#define IN(k) (lo <= (k) && (k) < hi)
#define LN() lane_now()
#define SEAM(k) do { if (one && lo <= (k) && (k) + 1 < hi) xcd_barrier(bar, wave == 0 && lane_now() == 0); } while (0)
    float* SSQA = (float*)(ws + WS_SSQA); bf16* XB = (bf16*)(ws + WS_XB);
    const int G = gridDim.x, cidx = blockIdx.x;

    if (IN(0)) { p0_prologue(p, lds, wave, LN()); } SEAM(0);
    if (IN(1)) {
        pg8::Gemm g{XB, (const bf16*)(ws + WS_WAB), M, NAB, DM}; pg8::StaticOrder S; S.init(M, NAB, G, cidx);
        EpiAB E{ws, p.ab_idx_k_norm};
        pg8::gemm_phase<EpiAB, pg8::StaticOrder, true, true>(lds, g, S, E, wave);
        if (G == 256 && cidx >= 192) convert_weights<1>(p, (cidx - 192) * NWAVES + wave, 64 * NWAVES, LN());
    } SEAM(1);
    if (IN(2)) { p2_gmlp(p, lds, wave, LN()); p2_indexer(p, lds, wave, LN()); } SEAM(2);
    if (IN(3)) { p3_attention(p, lds, wave, LN()); } SEAM(3);
    if (IN(4)) {
        pg8::Gemm g{(const bf16*)(ws + WS_Y), (const bf16*)(ws + WS_WABO), M, DM, DM}; pg8::StaticOrder S; S.init(M, DM, G, cidx);
        EpiRes E{XB, SSQA};
        pg8::gemm_phase<EpiRes, pg8::StaticOrder, true, true>(lds, g, S, E, wave);
    } SEAM(4);
#define FFN_PHASES(l, pb) do { \
        if (IN(pb)) { \
            pg8::Gemm g{XB, (const bf16*)(ws + ((l) ? WS_WUP1 : WS_WUP0)), M, NUP, DM}; pg8::StaticOrder S; S.init(M, NUP, G, cidx); \
            EpiConv E{SSQA + ((l) ? 2 * M : 0), p.ffn_conv_w + (size_t)(l) * 3 * NUP, p.ffn_conv_b + (size_t)(l) * NUP, (bf16*)(ws + WS_ACT), (float*)(ws + WS_HB)}; \
            pg8::gemm_phase<EpiConv, pg8::StaticOrder, true, true>(lds, g, S, E, wave); \
            if ((l) == 0 && G == 256 && cidx >= 128) convert_weights<2>(p, (cidx - 128) * NWAVES + wave, 128 * NWAVES, LN());     \
        } SEAM(pb); \
        if (G != 256) { if (IN((pb) + 1)) { p_convfix(p, (l), wave, LN()); } SEAM((pb) + 1); }     \
        if (IN((pb) + 2)) { \
            pg8::Gemm g{(const bf16*)(ws + WS_ACT), (const bf16*)(ws + ((l) ? WS_WDN1 : WS_WDN0)), M, DM, DFF}; pg8::StaticOrder S; S.init(M, DM, G, cidx); \
            if (G == 256) { pg8::Unit u0; if (S.next(0, u0)) p_convfix_rows(p, (l), 4 * u0.pm, 4, wave * 64 + LN(), NWAVES * 64);     \
                asm volatile("s_waitcnt vmcnt(0)" ::: "memory"); __syncthreads(); } \
            if ((l) == 0 || G != 256) { EpiRes E{XB, SSQA + ((l) ? 3 * M : M)}; \
                pg8::gemm_phase<EpiRes, pg8::StaticOrder, true, true>(lds, g, S, E, wave); } \
            else { EpiFinal E{XB, p.out, SSQA + 3 * M, (unsigned*)(ws + WS_FCNT), p.final_norm};     \
                pg8::gemm_phase<EpiFinal, pg8::StaticOrder, true, true>(lds, g, S, E, wave); } \
        } if (!((l) == 1 && G == 256)) SEAM((pb) + 2); } while (0)
    FFN_PHASES(0, 5);
    if (IN(8)) {
        pg8::Gemm g{XB, (const bf16*)(ws + WS_WCI), M, NCI, DM}; pg8::StaticOrder S; S.init(M, NCI, G, cidx);
        EpiHg E{ws, p.hgrn_lb};
        pg8::gemm_phase<EpiHg, pg8::StaticOrder, true, true>(lds, g, S, E, wave);
    } SEAM(8);
    if (IN(9)) { p9_hgrn(p, lds, wave, LN()); } SEAM(9);
    if (IN(10)) { p10_outnorm(p, wave, LN()); } SEAM(10);
    if (IN(11)) {
        pg8::Gemm g{(const bf16*)(ws + WS_ON), (const bf16*)(ws + WS_WCO), M, DM, DM}; pg8::StaticOrder S; S.init(M, DM, G, cidx);
        EpiRes E{XB, SSQA + 2 * M};
        pg8::gemm_phase<EpiRes, pg8::StaticOrder, true, true>(lds, g, S, E, wave);
    } SEAM(11);
    FFN_PHASES(1, 12);
    if (IN(15) && G != 256) { p15_final(p, wave, LN()); }
#undef IN
#undef SEAM
}

extern "C" void kernel_launch(void* const* d_in, const int* in_sizes, int n_in, void* d_out, int out_size, void* d_ws, size_t ws_size, hipStream_t stream) {
    static int grid = 0;
    if (grid == 0) {
        if (n_in != 19 || out_size != M * DM || ws_size < WS_END) { fprintf(stderr, "kernel_launch: unexpected shapes (n_in %d out %d ws %zu)\n", n_in, out_size, ws_size); grid = -1; return; }
        int dev = 0, cus = 0, per_cu = 0;
        if (hipGetDevice(&dev) != hipSuccess || hipDeviceGetAttribute(&cus, hipDeviceAttributeMultiprocessorCount, dev) != hipSuccess) { grid = -1; return; }
        if (hipFuncSetAttribute((const void*)mk_fwd, hipFuncAttributeMaxDynamicSharedMemorySize, LDS_BYTES) != hipSuccess) { fprintf(stderr, "kernel_launch: hipFuncSetAttribute failed\n"); grid = -1; return; }
        if (hipOccupancyMaxActiveBlocksPerMultiprocessor(&per_cu, (const void*)mk_fwd, NWAVES * 64, LDS_BYTES) != hipSuccess || per_cu < 1) { fprintf(stderr, "kernel_launch: occupancy query says %d\n", per_cu); }
        (void)hipGetLastError();
        grid = cus;
    }
    if (grid < 0) return;
    if (hipMemsetAsync((char*)d_ws + WS_CTL, 0, CTL_ZERO_BYTES, stream) != hipSuccess) return;
    Params p{};
    const float** pp = (const float**)&p;
    for (int i = 0; i < 19; ++i) pp[i] = (const float*)d_in[i];
    p.out = (float*)d_out; p.ws = (unsigned char*)d_ws;
#if MK_N_LAUNCHES == 1
    p.ph_lo = 0; p.ph_hi = NPHASE;
    hipLaunchKernelGGL(mk_fwd, dim3(grid), dim3(NWAVES * 64), LDS_BYTES, stream, p);
#else
    for (int k = 0; k < NPHASE; ++k) { p.ph_lo = k; p.ph_hi = k + 1; hipLaunchKernelGGL(mk_fwd, dim3(grid), dim3(NWAVES * 64), LDS_BYTES, stream, p); }
#endif
}
```

```cpp
#include <hip/hip_runtime.h>
#include <cstdio>
#include <cstdint>

#ifndef MK_N_LAUNCHES
#define MK_N_LAUNCHES 1
#endif

__device__ __forceinline__ int lane_now() { int l; asm volatile("v_mbcnt_lo_u32_b32 %0, -1, 0\n\tv_mbcnt_hi_u32_b32 %0, -1, %0" : "=v"(l)); return l; }

namespace pg8 {
#define PG8_LAS __attribute__((address_space(3)))
typedef unsigned short bf16_t;
typedef short bf16x8 __attribute__((ext_vector_type(8)));
typedef float f32x4 __attribute__((ext_vector_type(4)));
typedef unsigned u32x4 __attribute__((ext_vector_type(4)));
constexpr int BM = 256, BK = 64, HALF = 128, HTB = HALF * BK * 2  , STAGE_BYTES = 8 * HTB, NXCD = 8, WGM = 8;

__host__ __device__ __forceinline__ int lds_byte(int r, int c) { const int st = (r >> 4) * 2 + (c >> 5), rr = r & 15, cc = c & 31, ob = rr * 64 + cc * 2; return st * 1024 + (ob ^ (((ob >> 9) & 1) << 5)); }
__host__ __device__ __forceinline__ void stage_rc(int b, int& R, int& C) { const int st = b / 1024, sb = b % 1024, swz = sb ^ (((sb >> 9) & 1) << 5); R = (st >> 1) * 16 + swz / 64; C = (st & 1) * 32 + (swz % 64) / 2; }
__host__ __device__ __forceinline__ int perm32(int rho) { const int n = rho >> 4, i = rho & 15; return 8 * (i >> 2) + 4 * n + (i & 3); }

struct Unit { int pm, pn; };
struct Gemm { const bf16_t* A; const bf16_t* Bt; int M, N, K; };

struct StaticOrder {
    int nM, nN, nwg, G, c;
    __host__ __device__ __forceinline__ void init(int M, int N, int G_, int c_) { nM = M / BM; nN = N / BM; nwg = nM * nN; G = G_; c = c_; }
    __host__ __device__ __forceinline__ bool next(int i, Unit& u) const {
        const long L = (long)i * G + c; if (L >= nwg) return false;
        int wgid = (int)L; { const int q = nwg / NXCD, r = nwg % NXCD, xcd = wgid % NXCD, off = wgid / NXCD; wgid = (xcd < r ? xcd * (q + 1) : r * (q + 1) + (xcd - r) * q) + off; }
        const int nig = WGM * nN, gid = wgid / nig, fm = gid * WGM, gsz = (nM - fm) < WGM ? (nM - fm) : WGM;
        u.pm = fm + ((wgid % nig) % gsz); u.pn = (wgid % nig) / gsz; return true;
    }
    __device__ __forceinline__ void a_ready(const Unit&) const {}
    __device__ __forceinline__ void done(const Unit&) const {}
};

template <class Epi, class Sched, bool ALIGN_EPI = false, bool SP2 = false>
__device__ __forceinline__ void gemm_phase(PG8_LAS unsigned char* lds, const Gemm g, const Sched& S, const Epi& E, const int wave_idx) {
    int tid_l = wave_idx * 64 + lane_now();
    const int tid = tid_l, wid = __builtin_amdgcn_readfirstlane(tid >> 6), lane = tid & 63, wr = wid >> 2, wc = wid & 3, fr = lane & 15, fq = lane >> 4;
    const int K = g.K, nt = K / BK;
    unsigned voffA[2], voffB[2];
#pragma unroll
    for (int i = 0; i < 2; ++i) { int R, C; stage_rc(tid * 16 + i * 8192, R, C); const int Rb = Epi::PERM ? ((R & ~31) + perm32(R & 31)) : R;
        const int Rp = (((R >> 6) * 16 + (R & 15)) * 8 + ((R >> 4) & 3)); voffA[i] = (unsigned)(Rp * K + C) * 2u; voffB[i] = (unsigned)(Rb * K + C) * 2u; }
    const size_t kstep = (size_t)(BK * 2);
    const size_t hstepB = (size_t)HALF * K * 2, hstepA = (size_t)4 * K * 2;
    const size_t tstep = 2 * hstepB;
    const unsigned ldsw = (unsigned)wid * 1024u;
    const int aoff = lds_byte(wr * 64 + fr, fq * 8), boff = lds_byte(wc * 32 + fr, fq * 8);
#define PG8_SA(b, h) (((b) * 2 + (h)) * HTB)
#define PG8_SB(b, h) ((4 + (b) * 2 + (h)) * HTB)
#define PG8_STAGE(bufoff, gbase, voff) do { _Pragma("unroll") for (int _i = 0; _i < 2; ++_i) \
        __builtin_amdgcn_global_load_lds((const unsigned*)((const char*)(gbase) + (voff)[_i]), (PG8_LAS unsigned*)(lds + (bufoff) + ldsw + _i * 8192), 16, 0, 0); } while (0)
#define PG8_LDA(dst, b, h) do { _Pragma("unroll") for (int m = 0; m < 4; ++m) _Pragma("unroll") for (int k = 0; k < 2; ++k) dst[m][k] = *(const PG8_LAS bf16x8*)(lds + PG8_SA(b, h) + aoff + m * 2048 + k * 1024); } while (0)
#define PG8_LDB(dst, b, h) do { _Pragma("unroll") for (int n = 0; n < 2; ++n) _Pragma("unroll") for (int k = 0; k < 2; ++k) dst[n][k] = *(const PG8_LAS bf16x8*)(lds + PG8_SB(b, h) + boff + n * 2048 + k * 1024); } while (0)
#define PG8_MMA(ai, bj, At, Bt) do { __builtin_amdgcn_s_setprio(1); _Pragma("unroll") for (int m = 0; m < 4; ++m) _Pragma("unroll") for (int n = 0; n < 2; ++n) _Pragma("unroll") for (int k = 0; k < 2; ++k) \
        acc[ai][bj][m][n] = __builtin_amdgcn_mfma_f32_16x16x32_bf16(Bt[n][k], At[m][k], acc[ai][bj][m][n], 0, 0, 0); __builtin_amdgcn_s_setprio(0); } while (0)
#define PG8_WAIT_V(n) asm volatile("s_waitcnt vmcnt(" #n ")" ::: "memory")
#define PG8_WAIT_L(n) asm volatile("s_waitcnt lgkmcnt(" #n ")" ::: "memory")
#define PG8_BAR __builtin_amdgcn_s_barrier()
#define PG8_SCHED __builtin_amdgcn_sched_barrier(0)
    Unit cur, nxt; int ui = 0;
    if (!S.next(0, cur)) return;
    f32x4 acc[2][2][4][2];
#pragma unroll
    for (int a = 0; a < 2; ++a)
#pragma unroll
        for (int b = 0; b < 2; ++b)
#pragma unroll
            for (int m = 0; m < 4; ++m)
#pragma unroll
                for (int n = 0; n < 2; ++n) acc[a][b][m][n] = (f32x4){0.f, 0.f, 0.f, 0.f};
    bf16x8 At[4][2], B0[2][2], B1[2][2];
    const char* cA = (const char*)g.A + (size_t)cur.pm * tstep; const char* cB = (const char*)g.Bt + (size_t)cur.pn * tstep;
    S.a_ready(cur);
    if constexpr (SP2) {
        PG8_STAGE(PG8_SB(0, 0), cB, voffB); PG8_STAGE(PG8_SB(0, 1), cB + hstepB, voffB); PG8_STAGE(PG8_SA(0, 0), cA, voffA); PG8_STAGE(PG8_SA(0, 1), cA + hstepA, voffA);
        if (wr == 1) PG8_BAR;
        PG8_WAIT_V(2); PG8_BAR;
        PG8_STAGE(PG8_SB(1, 0), cB + kstep, voffB); PG8_STAGE(PG8_SA(1, 0), cA + kstep, voffA); PG8_STAGE(PG8_SB(1, 1), cB + hstepB + kstep, voffB);
        PG8_WAIT_V(6); PG8_BAR;
    } else {
        PG8_STAGE(PG8_SB(0, 0), cB, voffB); PG8_STAGE(PG8_SA(0, 0), cA, voffA); PG8_STAGE(PG8_SB(0, 1), cB + hstepB, voffB); PG8_STAGE(PG8_SA(0, 1), cA + hstepA, voffA);
        if (wr == 1) PG8_BAR;
        PG8_WAIT_V(4); PG8_BAR;
        PG8_STAGE(PG8_SB(1, 0), cB + kstep, voffB); PG8_STAGE(PG8_SA(1, 0), cA + kstep, voffA); PG8_STAGE(PG8_SB(1, 1), cB + hstepB + kstep, voffB);
        PG8_WAIT_V(6); PG8_BAR;
    }
    for (;;) {
        const bool has_next = S.next(ui + 1, nxt);
        const char* nA = has_next ? (const char*)g.A + (size_t)nxt.pm * tstep : cA; const char* nB = has_next ? (const char*)g.Bt + (size_t)nxt.pn * tstep : cB;
        for (int t = 0; t < nt; t += 2) {
            const bool last = (t == nt - 2);
            const char* a1 = cA + (size_t)(t + 1) * kstep;
            const char* a2 = last ? nA : cA + (size_t)(t + 2) * kstep; const char* b2 = last ? nB : cB + (size_t)(t + 2) * kstep;
            const char* a3 = a2 + kstep; const char* b3 = b2 + kstep;
            if (last && has_next) S.a_ready(nxt);
            if constexpr (SP2) {
            PG8_LDB(B0, 0, 0); PG8_LDB(B1, 0, 1); PG8_SCHED; PG8_LDA(At, 0, 0); PG8_STAGE(PG8_SA(1, 1), a1 + hstepA, voffA);
            PG8_WAIT_V(8); PG8_WAIT_L(0); PG8_BAR; PG8_MMA(0, 0, At, B0); PG8_MMA(0, 1, At, B1); PG8_BAR; PG8_SCHED;
            PG8_LDA(At, 0, 1); PG8_STAGE(PG8_SB(0, 0), b2, voffB); PG8_STAGE(PG8_SB(0, 1), b2 + hstepB, voffB); PG8_STAGE(PG8_SA(0, 0), a2, voffA);
            PG8_WAIT_V(8); PG8_WAIT_L(0); PG8_BAR; PG8_MMA(1, 0, At, B0); PG8_MMA(1, 1, At, B1); PG8_BAR; PG8_SCHED;
            PG8_LDB(B0, 1, 0); PG8_LDB(B1, 1, 1); PG8_SCHED; PG8_LDA(At, 1, 0); PG8_STAGE(PG8_SA(0, 1), a2 + hstepA, voffA);
            PG8_WAIT_V(8); PG8_WAIT_L(0); PG8_BAR; PG8_MMA(0, 0, At, B0); PG8_MMA(0, 1, At, B1); PG8_BAR; PG8_SCHED;
            PG8_LDA(At, 1, 1); PG8_STAGE(PG8_SB(1, 0), b3, voffB); PG8_STAGE(PG8_SB(1, 1), b3 + hstepB, voffB); PG8_STAGE(PG8_SA(1, 0), a3, voffA);
            PG8_WAIT_V(8); PG8_WAIT_L(0); PG8_BAR; PG8_MMA(1, 0, At, B0); PG8_MMA(1, 1, At, B1); PG8_BAR; PG8_SCHED;
            } else {
            PG8_LDB(B0, 0, 0); PG8_SCHED; PG8_LDA(At, 0, 0); PG8_STAGE(PG8_SA(1, 1), a1 + hstepA, voffA);
            PG8_WAIT_L(8); PG8_BAR; PG8_WAIT_L(0); PG8_MMA(0, 0, At, B0); PG8_BAR; PG8_SCHED;
            PG8_LDB(B1, 0, 1); PG8_STAGE(PG8_SB(0, 0), b2, voffB);
            PG8_BAR; PG8_WAIT_L(0); PG8_MMA(0, 1, At, B1); PG8_BAR;
            PG8_LDA(At, 0, 1); PG8_STAGE(PG8_SA(0, 0), a2, voffA);
            PG8_BAR; PG8_WAIT_L(0); PG8_MMA(1, 0, At, B0); PG8_BAR; PG8_SCHED;
            PG8_STAGE(PG8_SB(0, 1), b2 + hstepB, voffB);
            PG8_WAIT_V(6); PG8_BAR; PG8_MMA(1, 1, At, B1); PG8_BAR;
            PG8_LDB(B0, 1, 0); PG8_SCHED; PG8_LDA(At, 1, 0); PG8_STAGE(PG8_SA(0, 1), a2 + hstepA, voffA);
            PG8_WAIT_L(8); PG8_BAR; PG8_WAIT_L(0); PG8_MMA(0, 0, At, B0); PG8_BAR; PG8_SCHED;
            PG8_LDB(B1, 1, 1); PG8_STAGE(PG8_SB(1, 0), b3, voffB);
            PG8_BAR; PG8_WAIT_L(0); PG8_MMA(0, 1, At, B1); PG8_BAR;
            PG8_LDA(At, 1, 1); PG8_STAGE(PG8_SA(1, 0), a3, voffA);
            PG8_BAR; PG8_WAIT_L(0); PG8_MMA(1, 0, At, B0); PG8_BAR; PG8_SCHED;
            PG8_STAGE(PG8_SB(1, 1), b3 + hstepB, voffB);
            PG8_WAIT_V(6); PG8_BAR; PG8_MMA(1, 1, At, B1); PG8_BAR;
            }
        }
        if constexpr (ALIGN_EPI) { if (wr == 0) PG8_BAR; }
        if constexpr (!Epi::AFTER_DRAIN) { E(acc, cur, wr, wc, fr, fq); S.done(cur); }
        if (!has_next) break;
#pragma unroll
        for (int a = 0; a < 2; ++a)
#pragma unroll
            for (int b = 0; b < 2; ++b)
#pragma unroll
                for (int m = 0; m < 4; ++m)
#pragma unroll
                    for (int n = 0; n < 2; ++n) acc[a][b][m][n] = (f32x4){0.f, 0.f, 0.f, 0.f};
        cur = nxt; cA = nA; cB = nB; ++ui;
        if constexpr (ALIGN_EPI) { if (wr == 1) PG8_BAR; }
    }
    PG8_WAIT_V(0);
    if constexpr (!ALIGN_EPI) { if (wr == 0) PG8_BAR; }
    PG8_BAR;
    if constexpr (Epi::AFTER_DRAIN) { E.fused(acc, cur, wr, wc, fr, fq, lds, wid, lane); S.done(cur); }
#undef PG8_SA
#undef PG8_SB
#undef PG8_STAGE
#undef PG8_LDA
#undef PG8_LDB
#undef PG8_MMA
#undef PG8_WAIT_V
#undef PG8_WAIT_L
#undef PG8_BAR
#undef PG8_SCHED
}
}

constexpr int NB = 8, SEQ = 2048, DM = 1024, M = NB * SEQ;
constexpr int DFF = 2816, NUP = 2 * DFF;
constexpr int NAB = 3840;
constexpr int NCI = 4096;
constexpr float EPS = 1e-6f, LOG2E = 1.4426950408889634f, LN2 = 0.6931471805599453f;

#define GAS __attribute__((address_space(1)))
#define LAS __attribute__((address_space(3)))
typedef unsigned short bf16;
typedef short bf16x8 __attribute__((ext_vector_type(8)));
typedef float f32x4 __attribute__((ext_vector_type(4)));
typedef float f32x2 __attribute__((ext_vector_type(2)));
typedef float f32x16 __attribute__((ext_vector_type(16)));
typedef unsigned u32x4 __attribute__((ext_vector_type(4)));
typedef unsigned u32x2 __attribute__((ext_vector_type(2)));
typedef __bf16 bf16x2v __attribute__((ext_vector_type(2)));
typedef GAS unsigned gu32;

constexpr size_t MiB = 1u << 20;
constexpr size_t WS_CTL = 0, CTL_ZERO_BYTES = 1 * MiB;
constexpr size_t WS_WCI = 1 * MiB, WS_WCO = 9 * MiB, WS_WUP1 = 11 * MiB, WS_WDN1 = 22 * MiB;
constexpr size_t WS_SSQA = 128 * 1024;
constexpr size_t WS_SSQ0 = 29 * MiB;
constexpr size_t WS_OSSQ = 29 * MiB + 512 * 1024;
constexpr size_t WS_HB = 32 * MiB;
constexpr size_t WS_EB = 43 * MiB, WS_FAC = 44 * MiB;
constexpr size_t WS_XB = 46 * MiB;
constexpr size_t WS_WAB = 78 * MiB, WS_WABO = 86 * MiB, WS_WUP0 = 88 * MiB, WS_WDN0 = 99 * MiB;
constexpr size_t WS_R = 105 * MiB;
constexpr size_t WS_Q = WS_R, WS_K = WS_R + 16 * MiB, WS_VT = WS_R + 32 * MiB, WS_IQ = WS_R + 48 * MiB, WS_U = WS_R + 80 * MiB, WS_VGT = WS_R + 96 * MiB,
                 WS_Y = WS_R + 112 * MiB, WS_SEL = WS_R + 144 * MiB, WS_IK = WS_R + 148 * MiB, WS_IW = WS_R + 150 * MiB;
constexpr size_t WS_SSQV = 28 * MiB;
constexpr size_t WS_ACT = WS_R;
constexpr size_t WS_GATE = 78 * MiB, WS_QM = 110 * MiB, WS_KM = 142 * MiB, WS_KMT = 174 * MiB, WS_IT = 206 * MiB;
constexpr size_t WS_ON = WS_QM;
constexpr size_t WS_END = 256 * MiB;
static_assert(WS_IW + (size_t)M * 16 * 4 <= WS_END && WS_SSQV + (size_t)M * 8 * 4 <= WS_SSQ0 && WS_IT + 32 * MiB <= WS_END && WS_WDN0 + (size_t)DM * DFF * 2 <= WS_R, "ws map");
constexpr int CW_BAR = 4096;
constexpr size_t WS_FCNT = 64 * 1024;

constexpr int RING_BYTES = 131072, LDSX_OFF = RING_BYTES, MISC_OFF = RING_BYTES + 12288, LDS_BYTES = 147456;
constexpr int NWAVES = 8;

#define RLX_AGENT __ATOMIC_RELAXED, __HIP_MEMORY_SCOPE_AGENT
__device__ __forceinline__ unsigned cvt_pk(float lo, float hi) { unsigned r; asm volatile("v_cvt_pk_bf16_f32 %0, %1, %2" : "=v"(r) : "v"(lo), "v"(hi)); return r; }
__device__ __forceinline__ float fexp2(float x) { return __builtin_amdgcn_exp2f(x); }
__device__ __forceinline__ float frcp(float x) { return __builtin_amdgcn_rcpf(x); }
__device__ __forceinline__ float fexp(float x) { return __builtin_amdgcn_exp2f(x * LOG2E); }
__device__ __forceinline__ float fsigmoid(float x) { return frcp(1.f + fexp2(-LOG2E * x)); }
__device__ __forceinline__ float fsilu(float x) { return x * fsigmoid(x); }
__device__ __forceinline__ float fgelu(float x) { const float u = 0.7978845608028654f * (x + 0.044715f * x * x * x); return x * frcp(1.f + fexp2(-2.f * LOG2E * u)); }
__device__ __forceinline__ f32x2 fsilu2(f32x2 x, f32x2 xe) {
    const f32x2 e = {fexp2(xe[0]), fexp2(xe[1])}, d = e + 1.f; const f32x2 rr = {frcp(d[0]), frcp(d[1])}; return x * rr; }
__device__ __forceinline__ f32x2 fgelu2(f32x2 x) {
    constexpr float C1 = -2.f * LOG2E * 0.7978845608028654f, C2 = C1 * 0.044715f;
    const f32x2 x2 = x * x, t = x2 * C2 + C1, a = x * t;
    const f32x2 e = {fexp2(a[0]), fexp2(a[1])}, d = e + 1.f; const f32x2 rr = {frcp(d[0]), frcp(d[1])}; return x * rr; }
__device__ __forceinline__ float bf2f(unsigned short v) { return __builtin_bit_cast(float, (unsigned)v << 16); }
template <int CTRL> __device__ __forceinline__ float dpp_f(float v) { return __builtin_bit_cast(float, __builtin_amdgcn_update_dpp(0, __builtin_bit_cast(int, v), CTRL, 0xF, 0xF, false)); }
__device__ __forceinline__ bf16x8 pack8(float a0, float a1, float a2, float a3, float a4, float a5, float a6, float a7) {
    u32x4 w; w.x = cvt_pk(a0, a1); w.y = cvt_pk(a2, a3); w.z = cvt_pk(a4, a5); w.w = cvt_pk(a6, a7); return __builtin_bit_cast(bf16x8, w); }
__device__ __forceinline__ u32x2 pack4(float a0, float a1, float a2, float a3) { u32x2 w; w.x = cvt_pk(a0, a1); w.y = cvt_pk(a2, a3); return w; }
__device__ __forceinline__ size_t frag_off(int r, int c, int C) { return ((size_t)((r >> 5) * (C >> 4) + (c >> 4)) * 64 + ((c >> 3) & 1) * 32 + (r & 31)) * 8 + (c & 7); }
__device__ __forceinline__ int swap23(int v) { return (v & ~12) | ((v & 4) << 1) | ((v & 8) >> 1); }
#define MFMA32(a, b, c) __builtin_amdgcn_mfma_f32_32x32x16_bf16((a), (b), (c), 0, 0, 0)
__device__ __forceinline__ float wave_sum(float v) {
#pragma unroll
    for (int o = 1; o < 64; o <<= 1) v += __shfl_xor(v, o);
    return v;
}

struct Params {
    const float *x, *rel_bias, *hgrn_lb, *mix_norm, *ffn_norm, *final_norm, *ab_w_in, *ab_idx_k_norm, *ab_gmlp_norm, *ab_w_s, *ab_b_s, *ab_w_out,
                *c_w_in, *c_out_norm, *c_w_out, *ffn_w_up, *ffn_conv_w, *ffn_conv_b, *ffn_w_down;
    float* out; unsigned char* ws; int ph_lo, ph_hi;
};

template <int NP> __device__ __forceinline__ void row_scales(const float* ssq, int tok0, float (&r)[8]) {
#pragma unroll
    for (int j = 0; j < 8; ++j) {
        float s = 0.f;
        if (NP == 1) s = ssq[tok0 + j];
        else {
#pragma unroll
            for (int q = 0; q < NP / 4; ++q) { const f32x4 v = *(const f32x4*)(ssq + (size_t)(tok0 + j) * NP + 4 * q); s += (v[0] + v[1]) + (v[2] + v[3]); }
        }
        r[j] = 1.0f / sqrtf(s * (1.0f / DM) + EPS);
    }
}

#define ACC(j, bj, n, i) acc[(j) >> 2][bj][(j) & 3][n][i]
typedef pg8::Unit Unit;

struct EpiAB {
    static constexpr bool PERM = true, AFTER_DRAIN = false;
    unsigned char* ws; const float* ikg;
    __device__ __forceinline__ void operator()(const f32x4 (&acc)[2][2][4][2], const Unit& u, int wr, int wc, int fr, int fq) const {
        asm volatile("; epilogue-local lane coordinates" : "+v"(fr), "+v"(fq));
        const int tok0 = u.pm * 256 + (wr * 16 + fr) * 8, b = tok0 >> 11, s0 = tok0 & 2047, pn = u.pn;
        bf16* const IK = (bf16*)(ws + WS_IK); float* const IW = (float*)(ws + WS_IW); float* const SSQV = (float*)(ws + WS_SSQV);
        float r[8]; row_scales<1>((const float*)(ws + WS_SSQ0), tok0, r);
        const int cb = 32 * wc + 8 * fq;
        if (pn == 14) {
            if (wc == 0) {
                f32x4 gk[2][2];
#pragma unroll
                for (int bj = 0; bj < 2; ++bj) { gk[bj][0] = *(const f32x4*)(ikg + 32 * bj + 8 * fq); gk[bj][1] = *(const f32x4*)(ikg + 32 * bj + 8 * fq + 4); }
#pragma unroll
                for (int j = 0; j < 8; ++j) { f32x4 x[2][2]; float s = 0.f;
#pragma unroll
                    for (int bj = 0; bj < 2; ++bj)
#pragma unroll
                        for (int n = 0; n < 2; ++n) { x[bj][n] = acc[j >> 2][bj][j & 3][n] * r[j]; s += (x[bj][n][0] * x[bj][n][0] + x[bj][n][1] * x[bj][n][1]) + (x[bj][n][2] * x[bj][n][2] + x[bj][n][3] * x[bj][n][3]); }
                    s += __shfl_xor(s, 16); s += __shfl_xor(s, 32);
                    const float rn = 1.0f / sqrtf(s * (1.0f / 64.0f) + EPS);
#pragma unroll
                    for (int bj = 0; bj < 2; ++bj) { const int d0 = 32 * bj + 8 * fq; const f32x4 g0 = gk[bj][0], g1 = gk[bj][1];
                        const f32x4 y0 = x[bj][0] * rn * g0, y1 = x[bj][1] * rn * g1;
                        *(bf16x8*)(IK + frag_off(tok0 + j, d0, 64)) = pack8(y0[0], y0[1], y0[2], y0[3], y1[0], y1[1], y1[2], y1[3]); }
                    __builtin_amdgcn_sched_barrier(0); }
            } else if (wc == 1 && fq < 2) {
#pragma unroll
                for (int j = 0; j < 8; ++j) { const float rs = r[j] * 0.03125f;
                    *(f32x4*)(IW + (size_t)(tok0 + j) * 16 + 8 * fq) = acc[j >> 2][0][j & 3][0] * rs; *(f32x4*)(IW + (size_t)(tok0 + j) * 16 + 8 * fq + 4) = acc[j >> 2][0][j & 3][1] * rs; }
            }
        } else if (pn == 4 || pn == 5 || pn == 12 || pn == 13) {
            const bool isvg = pn >= 12; bf16* tb = (bf16*)(ws + (isvg ? WS_VGT : WS_VT)); const int pt = isvg ? pn - 12 : pn - 4;
            f32x2 ss2[8];
#pragma unroll
            for (int j = 0; j < 8; ++j) ss2[j] = f32x2{0.f, 0.f};
#pragma unroll
            for (int bj = 0; bj < 2; ++bj) { const int col = pt * 256 + 128 * bj + cb;
#pragma unroll
                for (int n = 0; n < 2; ++n)
#pragma unroll
                    for (int ip = 0; ip < 2; ++ip) { f32x2 v[8];
#pragma unroll
                        for (int j = 0; j < 8; ++j) { const f32x4 a = acc[j >> 2][bj][j & 3][n];
                            v[j] = (ip ? __builtin_shufflevector(a, a, 2, 3) : __builtin_shufflevector(a, a, 0, 1)) * r[j]; if (isvg) { v[j] = fgelu2(v[j]); ss2[j] = ss2[j] + v[j] * v[j]; } }
#pragma unroll
                        for (int e = 0; e < 2; ++e) {
                            bf16* base = tb + (size_t)b * (512 * 2048) + frag_off(col + 4 * n + 2 * ip + e, (s0 & ~15) + 4 * ((s0 >> 3) & 1), 2048);
                            *(u32x2*)base = pack4(v[0][e], v[1][e], v[2][e], v[3][e]); *(u32x2*)(base + 256) = pack4(v[4][e], v[5][e], v[6][e], v[7][e]); }
                        __builtin_amdgcn_sched_barrier(0); } }
            float ss[8];
#pragma unroll
            for (int j = 0; j < 8; ++j) ss[j] = ss2[j][0] + ss2[j][1];
            if (isvg) {
#pragma unroll
                for (int j = 0; j < 8; ++j) { float s = ss[j]; s += __shfl_xor(s, 16); s += __shfl_xor(s, 32); if (fq == 0) SSQV[(size_t)(tok0 + j) * 8 + pt * 4 + wc] = s; }
            }
        } else {
            const bool isqk = pn < 4, isu = pn >= 10;
            bf16* dst = (bf16*)(ws + (isqk ? WS_Q + (size_t)(pn >> 1) * (WS_K - WS_Q) : (isu ? WS_U : WS_IQ)));
            const int pt = isqk ? (pn & 1) : (isu ? pn - 10 : pn - 6);
            const float sc = pn < 2 ? 0.125f * LOG2E : 1.0f;
            const int sA = isqk ? 8 : (isu ? 512 : 0), sB = (isqk || isu) ? 0 : 2048, sC = (isqk || isu) ? 0 : 32;
#pragma unroll
            for (int bj = 0; bj < 2; ++bj) { const int col = pt * 256 + 128 * bj + cb, hd = col >> 6, d0 = col & 63;
                const size_t o0 = isqk ? (size_t)(b * 8 + hd) * (2048 * 64) + frag_off(s0, d0, 64) : (isu ? (size_t)tok0 * 512 + col : frag_off((tok0 >> 1) * 32 + (hd & 3) + 8 * (hd >> 2), d0, 64));
                bf16* dp = dst + o0;
#pragma unroll
                for (int j = 0; j < 8; ++j) { const float rs = r[j] * sc; const f32x4 a0 = acc[j >> 2][bj][j & 3][0], a1 = acc[j >> 2][bj][j & 3][1];
                    f32x2 p0 = __builtin_shufflevector(a0, a0, 0, 1) * rs, p1 = __builtin_shufflevector(a0, a0, 2, 3) * rs, p2 = __builtin_shufflevector(a1, a1, 0, 1) * rs, p3 = __builtin_shufflevector(a1, a1, 2, 3) * rs;
                    if (isu) { p0 = fgelu2(p0); p1 = fgelu2(p1); p2 = fgelu2(p2); p3 = fgelu2(p3); }
                    *(bf16x8*)(dp + (size_t)(j * sA + (j >> 1) * sB + (j & 1) * sC)) = pack8(p0[0], p0[1], p1[0], p1[1], p2[0], p2[1], p3[0], p3[1]);
                    __builtin_amdgcn_sched_barrier(0); } }
        }
    }
};

struct EpiRes {
    static constexpr bool PERM = true, AFTER_DRAIN = false;
    bf16* XB; float* ssq;
    __device__ __forceinline__ void operator()(const f32x4 (&acc)[2][2][4][2], const Unit& u, int wr, int wc, int fr, int fq) const {
        asm volatile("; epilogue-local lane coordinates" : "+v"(fr), "+v"(fq));
        const int tok0 = u.pm * 256 + (wr * 16 + fr) * 8;
        float sj[4];
        u32x4 xn[2];
#pragma unroll
        for (int bj = 0; bj < 2; ++bj) xn[bj] = *(const u32x4*)(XB + (size_t)tok0 * DM + u.pn * 256 + 128 * bj + 32 * wc + 8 * fq);
#pragma unroll
        for (int j = 0; j < 8; ++j) { const size_t ro = (size_t)(tok0 + j) * DM; float s = 0.f;
            const u32x4 xc0 = xn[0], xc1 = xn[1];
            if (j < 7) {
#pragma unroll
                for (int bj = 0; bj < 2; ++bj) xn[bj] = *(const u32x4*)(XB + ro + DM + u.pn * 256 + 128 * bj + 32 * wc + 8 * fq); }
#pragma unroll
            for (int bj = 0; bj < 2; ++bj) { const int col = u.pn * 256 + 128 * bj + 32 * wc + 8 * fq;
                const u32x4 xb = bj ? xc1 : xc0;
                f32x4 v0, v1;
                v0[0] = __builtin_bit_cast(float, xb.x << 16); v0[1] = __builtin_bit_cast(float, xb.x & 0xffff0000u); v0[2] = __builtin_bit_cast(float, xb.y << 16); v0[3] = __builtin_bit_cast(float, xb.y & 0xffff0000u);
                v1[0] = __builtin_bit_cast(float, xb.z << 16); v1[1] = __builtin_bit_cast(float, xb.z & 0xffff0000u); v1[2] = __builtin_bit_cast(float, xb.w << 16); v1[3] = __builtin_bit_cast(float, xb.w & 0xffff0000u);
                v0 += acc[j >> 2][bj][j & 3][0]; v1 += acc[j >> 2][bj][j & 3][1];
                *(bf16x8*)(XB + ro + col) = pack8(v0[0], v0[1], v0[2], v0[3], v1[0], v1[1], v1[2], v1[3]);
                s += (v0[0] * v0[0] + v0[1] * v0[1]) + (v0[2] * v0[2] + v0[3] * v0[3]) + (v1[0] * v1[0] + v1[1] * v1[1]) + (v1[2] * v1[2] + v1[3] * v1[3]); }
            s += __shfl_xor(s, 16); s += __shfl_xor(s, 32);
            sj[j & 3] = s;
            if ((j & 3) == 3) { const float sv = fq == 0 ? sj[0] : (fq == 1 ? sj[1] : (fq == 2 ? sj[2] : sj[3]));
                __hip_atomic_fetch_add(ssq + tok0 + (j & ~3) + fq, sv, __ATOMIC_RELAXED, __HIP_MEMORY_SCOPE_AGENT); }
            __builtin_amdgcn_sched_barrier(0); }
    }
};

struct EpiFinal {
    static constexpr bool PERM = true, AFTER_DRAIN = false;
    const bf16* XB; float* out; float* ssq; unsigned* cnt; const float* gain;
    __device__ __forceinline__ void operator()(f32x4 (&acc)[2][2][4][2], const Unit& u, int wr, int wc, int fr, int fq) const {
        asm volatile("; epilogue-local lane coordinates" : "+v"(fr), "+v"(fq));
        const int tok0 = u.pm * 256 + (wr * 16 + fr) * 8, col0 = u.pn * 256 + 32 * wc + 8 * fq;
        float sj[4];
#pragma unroll
        for (int j = 0; j < 8; ++j) { const size_t ro = (size_t)(tok0 + j) * DM; float s = 0.f;
#pragma unroll
            for (int bj = 0; bj < 2; ++bj) { const int col = col0 + 128 * bj;
                const u32x4 xb = *(const u32x4*)(XB + ro + col);
                f32x4 v0, v1;
                v0[0] = __builtin_bit_cast(float, xb.x << 16); v0[1] = __builtin_bit_cast(float, xb.x & 0xffff0000u); v0[2] = __builtin_bit_cast(float, xb.y << 16); v0[3] = __builtin_bit_cast(float, xb.y & 0xffff0000u);
                v1[0] = __builtin_bit_cast(float, xb.z << 16); v1[1] = __builtin_bit_cast(float, xb.z & 0xffff0000u); v1[2] = __builtin_bit_cast(float, xb.w << 16); v1[3] = __builtin_bit_cast(float, xb.w & 0xffff0000u);
                v0 += acc[j >> 2][bj][j & 3][0]; v1 += acc[j >> 2][bj][j & 3][1];
                acc[j >> 2][bj][j & 3][0] = v0; acc[j >> 2][bj][j & 3][1] = v1;
                s += (v0[0] * v0[0] + v0[1] * v0[1]) + (v0[2] * v0[2] + v0[3] * v0[3]) + (v1[0] * v1[0] + v1[1] * v1[1]) + (v1[2] * v1[2] + v1[3] * v1[3]); }
            s += __shfl_xor(s, 16); s += __shfl_xor(s, 32);
            sj[j & 3] = s;
            if ((j & 3) == 3) { const float sv = fq == 0 ? sj[0] : (fq == 1 ? sj[1] : (fq == 2 ? sj[2] : sj[3]));
                __hip_atomic_fetch_add(ssq + tok0 + (j & ~3) + fq, sv, __ATOMIC_RELAXED, __HIP_MEMORY_SCOPE_AGENT); }
            __builtin_amdgcn_sched_barrier(0); }
        f32x4 gq[2][2];
#pragma unroll
        for (int bj = 0; bj < 2; ++bj) { gq[bj][0] = *(const f32x4*)(gain + col0 + 128 * bj); gq[bj][1] = *(const f32x4*)(gain + col0 + 128 * bj + 4); }
        asm volatile("s_waitcnt vmcnt(0)" ::: "memory");
        unsigned* c = cnt + 64 * u.pm;
        if (fq == 0 && fr == 0) {
            __hip_atomic_fetch_add(c, 1u, __ATOMIC_RELAXED, __HIP_MEMORY_SCOPE_AGENT);
            unsigned spins = 0;
            while (__hip_atomic_load(c, __ATOMIC_RELAXED, __HIP_MEMORY_SCOPE_AGENT) < 32u) { __builtin_amdgcn_s_sleep(2); if (++spins > (1u << 20)) break; }
        }
        asm volatile("" ::: "memory");
        float r[8];
#pragma unroll
        for (int j = 0; j < 8; ++j) { const float s = __hip_atomic_load(ssq + tok0 + j, __ATOMIC_RELAXED, __HIP_MEMORY_SCOPE_AGENT); r[j] = 1.0f / sqrtf(s * (1.0f / DM) + EPS); }
#pragma unroll
        for (int bj = 0; bj < 2; ++bj) { const int col = col0 + 128 * bj; const f32x4 g0 = gq[bj][0], g1 = gq[bj][1];
#pragma unroll
            for (int j = 0; j < 8; ++j) { const size_t ro = (size_t)(tok0 + j) * DM;
                *(f32x4*)(out + ro + col) = acc[j >> 2][bj][j & 3][0] * r[j] * g0; *(f32x4*)(out + ro + col + 4) = acc[j >> 2][bj][j & 3][1] * r[j] * g1; } }
    }
};

struct EpiConv {
    static constexpr bool PERM = true, AFTER_DRAIN = false;
    const float* ssq; const float* cw; const float* cbias; bf16* ACT; float* HB;
    __device__ __forceinline__ void operator()(const f32x4 (&acc)[2][2][4][2], const Unit& u, int wr, int wc, int fr, int fq) const {
        asm volatile("; epilogue-local lane coordinates" : "+v"(fr), "+v"(fq));
        const int tok0 = u.pm * 256 + (wr * 16 + fr) * 8, ca0 = u.pn * 128 + 32 * wc + 8 * fq;
        f32x4 wa[2][3], wb[2][3], ba[2], bb[2];
#pragma unroll
        for (int n = 0; n < 2; ++n) { const int ca = ca0 + 4 * n, cbn = DFF + ca;
#pragma unroll
            for (int tp = 0; tp < 3; ++tp) { wa[n][tp] = *(const f32x4*)(cw + tp * NUP + ca); wb[n][tp] = *(const f32x4*)(cw + tp * NUP + cbn); }
            ba[n] = *(const f32x4*)(cbias + ca); bb[n] = *(const f32x4*)(cbias + cbn); }
        float r[8]; row_scales<1>(ssq, tok0, r);
        const int grp = 2 * u.pm + wr;
        float* hp15 = HB + ((size_t)grp * 4) * NUP; float* hp0 = HB + ((size_t)grp * 4 + 2) * NUP;
        unsigned w[8][4];
#define EC_PAIR(V_) (ip ? __builtin_shufflevector(V_, V_, 2, 3) : __builtin_shufflevector(V_, V_, 0, 1))
#pragma unroll
        for (int n = 0; n < 2; ++n) { const int ca = ca0 + 4 * n, cbn = DFF + ca;
#pragma unroll
            for (int ip = 0; ip < 2; ++ip) {
                const f32x2 WA0 = EC_PAIR(wa[n][0]) * (-LOG2E), WA1 = EC_PAIR(wa[n][1]) * (-LOG2E), WA2 = EC_PAIR(wa[n][2]) * (-LOG2E), BA = EC_PAIR(ba[n]) * (-LOG2E);
                const f32x2 WB0 = EC_PAIR(wb[n][0]) * (-LN2), WB1 = EC_PAIR(wb[n][1]) * (-LN2), WB2 = EC_PAIR(wb[n][2]) * (-LN2), BB = EC_PAIR(bb[n]) * (-LN2);
                f32x2 HA[8], HBv[8];
#pragma unroll
                for (int j = 0; j < 8; ++j) { HA[j] = EC_PAIR(acc[j >> 2][0][j & 3][n]) * r[j]; HBv[j] = EC_PAIR(acc[j >> 2][1][j & 3][n]) * r[j]; }
                const f32x2 PA6 = {dpp_f<0x111>(HA[6][0]), dpp_f<0x111>(HA[6][1])}, PA7 = {dpp_f<0x111>(HA[7][0]), dpp_f<0x111>(HA[7][1])};
                const f32x2 PB6 = {dpp_f<0x111>(HBv[6][0]), dpp_f<0x111>(HBv[6][1])}, PB7 = {dpp_f<0x111>(HBv[7][0]), dpp_f<0x111>(HBv[7][1])};
                const int i0 = 2 * ip;
                if (fr == 15) { *(f32x2*)(hp15 + ca + i0) = HA[6]; *(f32x2*)(hp15 + cbn + i0) = HBv[6]; *(f32x2*)(hp15 + NUP + ca + i0) = HA[7]; *(f32x2*)(hp15 + NUP + cbn + i0) = HBv[7]; }
                if (fr == 0) { *(f32x2*)(hp0 + ca + i0) = HA[0]; *(f32x2*)(hp0 + cbn + i0) = HBv[0]; *(f32x2*)(hp0 + NUP + ca + i0) = HA[1]; *(f32x2*)(hp0 + NUP + cbn + i0) = HBv[1]; }
#pragma unroll
                for (int j = 0; j < 8; ++j) {
                    const f32x2 AM1 = j >= 1 ? HA[j >= 1 ? j - 1 : 0] : PA7, AM2 = j >= 2 ? HA[j >= 2 ? j - 2 : 0] : (j == 1 ? PA7 : PA6);
                    const f32x2 BM1 = j >= 1 ? HBv[j >= 1 ? j - 1 : 0] : PB7, BM2 = j >= 2 ? HBv[j >= 2 ? j - 2 : 0] : (j == 1 ? PB7 : PB6);
                    const f32x2 YA = BA + WA2 * HA[j] + WA1 * AM1 + WA0 * AM2, YB = BB + WB2 * HBv[j] + WB1 * BM1 + WB0 * BM2;
                    const f32x2 E = {fexp2(YA[0]), fexp2(YA[1])};
                    const f32x2 D = E + 1.f;
                    const f32x2 R = {frcp(D[0]), frcp(D[1])};
                    const f32x2 O = (YA * YB) * R;
                    w[j][2 * n + ip] = cvt_pk(O[0], O[1]);
                }
                __builtin_amdgcn_sched_barrier(0);
            }
        }
#undef EC_PAIR
#pragma unroll
        for (int j = 0; j < 8; ++j) if (!(fr == 0 && j < 2)) { u32x4 v; v.x = w[j][0]; v.y = w[j][1]; v.z = w[j][2]; v.w = w[j][3]; *(u32x4*)(ACT + (size_t)(tok0 + j) * DFF + ca0) = v; }
    }
};

struct EpiHg {
    static constexpr bool PERM = true, AFTER_DRAIN = false;
    unsigned char* ws; const float* hlb;
    __device__ __forceinline__ void operator()(const f32x4 (&acc)[2][2][4][2], const Unit& u, int wr, int wc, int fr, int fq) const {
        asm volatile("; epilogue-local lane coordinates" : "+v"(fr), "+v"(fq));
        const int tok0 = u.pm * 256 + (wr * 16 + fr) * 8, b = tok0 >> 11, s0 = tok0 & 2047, pn = u.pn;
        float r[8]; row_scales<1>((const float*)(ws + WS_SSQA) + M, tok0, r);
        const int cb = 32 * wc + 8 * fq;
        if (pn < 8) {
            bf16* const QM = (bf16*)(ws + WS_QM); bf16* const KM = (bf16*)(ws + WS_KM); bf16* const KMT = (bf16*)(ws + WS_KMT); float* const EB = (float*)(ws + WS_EB); float* const FAC = (float*)(ws + WS_FAC);
            const int h = pn, chunk = s0 >> 6, lane = fq * 16 + fr, f7 = fr & 7;
            float lb8[8];
            { const f32x4 l1a = *(const f32x4*)(hlb + 1024 + h * 128 + cb), l1b = *(const f32x4*)(hlb + 1024 + h * 128 + cb + 4), l0a = *(const f32x4*)(hlb + h * 128 + cb), l0b = *(const f32x4*)(hlb + h * 128 + cb + 4);
#pragma unroll
              for (int i = 0; i < 4; ++i) { lb8[i] = fsigmoid(l1a[i] - l0a[i]); lb8[4 + i] = fsigmoid(l1b[i] - l0b[i]); } }
            unsigned wq[8][4], wk[8][4];
            float rf[8];
#pragma unroll
            for (int j = 0; j < 8; ++j) rf[j] = r[j] * (-LOG2E);
#define HG_PAIR(V_) (ip ? __builtin_shufflevector(V_, V_, 2, 3) : __builtin_shufflevector(V_, V_, 0, 1))
#pragma unroll
            for (int n = 0; n < 2; ++n) {
#pragma unroll
                for (int ip = 0; ip < 2; ++ip) { const int d0 = cb + 4 * n + 2 * ip;
                    const f32x2 LB = {lb8[4 * n + 2 * ip], lb8[4 * n + 2 * ip + 1]}, OML = 1.f - LB;
                    f32x2 BC[8], KK[8], QS[8], RUN = {0.f, 0.f};
#pragma unroll
                    for (int j = 0; j < 8; ++j) { const f32x2 QV = HG_PAIR(acc[j >> 2][0][j & 3][n]) * r[j], FE = HG_PAIR(acc[j >> 2][1][j & 3][n]) * rf[j];
                        const f32x2 E1 = {fexp2(FE[0]), fexp2(FE[1])}, D1 = E1 + 1.f;
                        const f32x2 SG = {frcp(D1[0]), frcp(D1[1])};
                        const f32x2 G = LB + OML * SG;
                        const f32x2 LG = {__builtin_amdgcn_logf(G[0]), __builtin_amdgcn_logf(G[1])};
                        RUN = RUN + LG; BC[j] = RUN; KK[j] = OML - OML * SG;
                        const f32x2 QE = QV * (-LOG2E);
                        const f32x2 E2 = {fexp2(QE[0]), fexp2(QE[1])}, D2 = E2 + 1.f;
                        const f32x2 RQ = {frcp(D2[0]), frcp(D2[1])};
                        QS[j] = QV * RQ; }
                    f32x2 EXCL, BREF;
#pragma unroll
                    for (int e = 0; e < 2; ++e) { const float run = RUN[e]; float xs = run, t;
                        t = dpp_f<0x111>(xs); if (f7 >= 1) xs += t;
                        t = dpp_f<0x112>(xs); if (f7 >= 2) xs += t;
                        t = dpp_f<0x114>(xs); if (f7 >= 4) xs += t;
                        const float excl = xs - run, bl = __shfl(xs, (lane & ~7) + 7), bref = __shfl(xs, (lane & ~7) + 3);
                        EXCL[e] = excl; BREF[e] = bref;
                        const int lam = swap23(d0 + e);
                        if (f7 == 0) { const size_t o = ((size_t)((b * 32 + chunk) * 8 + h)) * 128 + lam; EB[o] = fexp2(bref); FAC[o] = fexp2(bl - bref); } }
#pragma unroll
                    for (int j = 0; j < 8; ++j) { const f32x2 BB = EXCL + BC[j], DQ = BB - BREF, DK = BREF - BB;
                        const f32x2 XQ = {fexp2(fminf(DQ[0], 80.f * LOG2E)), fexp2(fminf(DQ[1], 80.f * LOG2E))}, XK = {fexp2(fminf(DK[0], 80.f * LOG2E)), fexp2(fminf(DK[1], 80.f * LOG2E))};
                        QS[j] = QS[j] * XQ; KK[j] = KK[j] * XK;
                        wq[j][2 * n + ip] = cvt_pk(QS[j][0], QS[j][1]); wk[j][2 * n + ip] = cvt_pk(KK[j][0], KK[j][1]); }
#pragma unroll
                    for (int e = 0; e < 2; ++e) { const int lam = swap23(d0 + e);
                        bf16* base = KMT + (size_t)(b * 8 + h) * (128 * 2048) + frag_off(lam, (s0 & ~15) + 4 * ((s0 >> 3) & 1), 2048);
                        *(u32x2*)base = pack4(KK[0][e], KK[1][e], KK[2][e], KK[3][e]); *(u32x2*)(base + 256) = pack4(KK[4][e], KK[5][e], KK[6][e], KK[7][e]); }
                    __builtin_amdgcn_sched_barrier(0);
                }
            }
#undef HG_PAIR
            { const size_t o0 = (size_t)(b * 8 + h) * (2048 * 128) + frag_off(s0, cb, 128);
#pragma unroll
              for (int j = 0; j < 8; ++j) { u32x4 a; a.x = wq[j][0]; a.y = wq[j][1]; a.z = wq[j][2]; a.w = wq[j][3]; u32x4 c; c.x = wk[j][0]; c.y = wk[j][1]; c.z = wk[j][2]; c.w = wk[j][3];
                  *(u32x4*)(QM + o0 + 8 * j) = a; *(u32x4*)(KM + o0 + 8 * j) = c; } }
        } else if (pn < 12) {
            bf16* const IT = (bf16*)(ws + WS_IT);
#pragma unroll
            for (int bj = 0; bj < 2; ++bj) { const int col = (pn - 8) * 256 + 128 * bj + cb;
#pragma unroll
                for (int n = 0; n < 2; ++n)
#pragma unroll
                    for (int i = 0; i < 4; ++i) {
                        const int ci = col + 4 * n + i;
                        bf16* base = IT + (size_t)(b * 8 + (ci >> 7)) * (128 * 2048) + frag_off(ci & 127, (s0 & ~15) + 4 * ((s0 >> 3) & 1), 2048);
                        *(u32x2*)base = pack4(ACC(0, bj, n, i) * r[0], ACC(1, bj, n, i) * r[1], ACC(2, bj, n, i) * r[2], ACC(3, bj, n, i) * r[3]);
                        *(u32x2*)(base + 256) = pack4(ACC(4, bj, n, i) * r[4], ACC(5, bj, n, i) * r[5], ACC(6, bj, n, i) * r[6], ACC(7, bj, n, i) * r[7]);
                        __builtin_amdgcn_sched_barrier(0); } }
        } else {
            bf16* const GATE = (bf16*)(ws + WS_GATE);
#pragma unroll
            for (int bj = 0; bj < 2; ++bj) { const int col = (pn - 12) * 256 + 128 * bj + cb;
#pragma unroll
                for (int j = 0; j < 8; ++j) { const f32x4 a0 = acc[j >> 2][bj][j & 3][0], a1 = acc[j >> 2][bj][j & 3][1]; const float rj = r[j], rfj = rj * (-LOG2E);
                    const f32x2 p0 = __builtin_shufflevector(a0, a0, 0, 1), p1 = __builtin_shufflevector(a0, a0, 2, 3), p2 = __builtin_shufflevector(a1, a1, 0, 1), p3 = __builtin_shufflevector(a1, a1, 2, 3);
                    const f32x2 o0 = fsilu2(p0 * rj, p0 * rfj), o1 = fsilu2(p1 * rj, p1 * rfj), o2 = fsilu2(p2 * rj, p2 * rfj), o3 = fsilu2(p3 * rj, p3 * rfj);
                    *(bf16x8*)(GATE + (size_t)(tok0 + j) * 1024 + col) = pack8(o0[0], o0[1], o1[0], o1[1], o2[0], o2[1], o3[0], o3[1]);
                    __builtin_amdgcn_sched_barrier(0); } }
        }
    }
};

#define XB_TMO      128
#define XB_XCNT(j)  (256  + 64 * (j))
#define XB_XSUB(j)  (1280 + 64 * (j))
#define XB_XGEN(j)  (2304 + 64 * (j))
#define XB_TOP      3328
#define XB_TOPGEN   3392
#define XCD_BAR_WORDS 3456
#define XB_SPIN_CAP (1u << 18)
__device__ __forceinline__ unsigned xb_ld(unsigned* p)              { return __hip_atomic_load(p, __ATOMIC_RELAXED, __HIP_MEMORY_SCOPE_AGENT); }
__device__ __forceinline__ unsigned xb_add(unsigned* p, unsigned v) { return __hip_atomic_fetch_add(p, v, __ATOMIC_RELAXED, __HIP_MEMORY_SCOPE_AGENT); }
__device__ __forceinline__ unsigned xb_xcc_id() { return (unsigned)__builtin_amdgcn_s_getreg((3 << 11) | 20) & 0xFu; }
#define XB_SPIN(cond, bar) do { unsigned _sp = 0; while (cond) { __builtin_amdgcn_s_sleep(1); \
    if ((++_sp & 255u) == 0u) { if (xb_ld(&(bar)[XB_TMO])) break; if (_sp > XB_SPIN_CAP) { atomicAdd(&(bar)[XB_TMO], 1u); break; } } } } while (0)
struct XcdBarrier { unsigned* bar; unsigned x; volatile LAS unsigned* st; };
__device__ __forceinline__ XcdBarrier xcd_barrier_post(unsigned* bar, volatile LAS unsigned* st, bool t0) {
    XcdBarrier b; b.bar = bar; b.x = xb_xcc_id(); b.st = st;
    if (t0) (void)xb_add(&bar[XB_XCNT(b.x)], 1u);
    return b;
}
__device__ __forceinline__ void xcd_barrier_complete(unsigned* bar, unsigned x, unsigned& nloc, unsigned& nx) {
    const unsigned G = gridDim.x * gridDim.y * gridDim.z;
    unsigned sum, cnt, mine, sp = 0u;
    for (;;) {
        sum = 0u; cnt = 0u; mine = 0u;
#pragma unroll
        for (unsigned j = 0; j < 16; ++j) { const unsigned c = xb_ld(&bar[XB_XCNT(j)]); sum += c; cnt += (c > 0u) ? 1u : 0u; mine = (j == x) ? c : mine; }
        if (sum == G) break;
        __builtin_amdgcn_s_sleep(1);
        if ((++sp & 255u) == 0u) { if (xb_ld(&bar[XB_TMO])) break; if (sp > XB_SPIN_CAP) { atomicAdd(&bar[XB_TMO], 1u); break; } }
    }
    nloc = mine > 0u ? mine : 1u; nx = cnt > 0u ? cnt : 1u;
}
__device__ __forceinline__ void xcd_barrier(const XcdBarrier& b, bool t0) {
    asm volatile("s_waitcnt vmcnt(0)" ::: "memory");
    __syncthreads();
    if (t0) {
        unsigned* bar = b.bar;
        __builtin_amdgcn_s_waitcnt(0);
        unsigned nloc = b.st[0], nx = b.st[1];
        if (nloc == 0u) { xcd_barrier_complete(bar, b.x, nloc, nx); b.st[0] = nloc; b.st[1] = nx; }
        const unsigned old = xb_add(&bar[XB_XSUB(b.x)], 1u);
        const unsigned gen = old / nloc;
        if (old + 1u == (gen + 1u) * nloc) {
            __builtin_amdgcn_fence(__ATOMIC_RELEASE, "agent");
            asm volatile("s_waitcnt vmcnt(0)" ::: "memory");
            const unsigned og = xb_add(&bar[XB_TOP], 1u);
            const unsigned tg = og / nx;
            if (og + 1u == (tg + 1u) * nx) xb_add(&bar[XB_TOPGEN], 1u);
            else XB_SPIN(xb_ld(&bar[XB_TOPGEN]) == tg, bar);
            __builtin_amdgcn_fence(__ATOMIC_ACQUIRE, "agent");
            xb_add(&bar[XB_XGEN(b.x)], 1u);
            asm volatile("s_waitcnt vmcnt(0)" ::: "memory");
        } else {
            XB_SPIN(xb_ld(&bar[XB_XGEN(b.x)]) == gen, bar);
            __builtin_amdgcn_fence(__ATOMIC_ACQUIRE, "agent");
            asm volatile("s_waitcnt vmcnt(0)" ::: "memory");
        }
    }
    __syncthreads();
}

__device__ __forceinline__ void conv_item(const float* W, int K, int N, int src0, int nvalid, const float* gain, bf16* WT, int dst_row0, int kb, LAS float* scr, int lane) {
    const int k0 = 64 * kb, cl = lane & 31;
#pragma unroll 8
    for (int i = 0; i < 32; ++i) { const int kk = 2 * i + (lane >> 5); float v = 0.f; if (cl < nvalid) { v = W[(size_t)(k0 + kk) * N + src0 + cl]; if (gain) v *= gain[k0 + kk]; } scr[kk * 33 + cl] = v; }
    asm volatile("s_waitcnt lgkmcnt(0)" ::: "memory");
    const int c = lane & 7;
#pragma unroll
    for (int j = 0; j < 4; ++j) { const int n = (lane >> 3) + 8 * j; const LAS float* s = scr + (8 * c) * 33 + n;
        u32x4 o; o.x = cvt_pk(s[0 * 33], s[1 * 33]); o.y = cvt_pk(s[2 * 33], s[3 * 33]); o.z = cvt_pk(s[4 * 33], s[5 * 33]); o.w = cvt_pk(s[6 * 33], s[7 * 33]);
        *(u32x4*)(WT + (size_t)(dst_row0 + n) * K + k0 + 8 * c) = o; }
    asm volatile("s_waitcnt lgkmcnt(0)" ::: "memory");
}
__device__ __forceinline__ void map_ab(int nb, int& src, int& nv) {
    nv = 32;
    if (nb < 80) src = 32 * nb;
    else if (nb < 96) src = 2640 + 32 * (nb - 80);
    else if (nb < 112) src = 3152 + 32 * (nb - 96);
    else { const int t = nb - 112; if (t == 0) src = 2560; else if (t == 1) { src = 2624; nv = 16; } else if (t == 4) src = 2592; else { src = 0; nv = 0; } }
}
__device__ __forceinline__ int map_up(int nb) { const int pn = nb >> 3, t = nb & 7; return (t < 4 ? 0 : DFF) + 128 * pn + 32 * (t & 3); }
__device__ __forceinline__ int map_ci(int nb) { if (nb < 64) { const int h = nb >> 3, t = nb & 7; return (t < 4 ? 0 : 1024) + 128 * h + 32 * (t & 3); } return 32 * nb; }

template <int MAT> __device__ __forceinline__ void conv64_item(const float* W, int K, int N, const float* gain, bf16* WT, int kb, int nt, int lane) {
    const int n = 128 * nt + 2 * lane, nb = n >> 5, wi = n & 31;
    int src = 32 * nb, nv = 32;
    if (MAT == 0) map_ab(nb, src, nv); else if (MAT == 1) src = map_up(nb); else if (MAT == 2) src = map_ci(nb);
    const bool valid = wi < nv;
    const float* wp = W + (size_t)(64 * kb) * N + src + wi;
    f32x2 v[64];
#pragma unroll
    for (int kk = 0; kk < 64; ++kk) v[kk] = valid ? __builtin_nontemporal_load((const f32x2*)(wp + (size_t)kk * N)) : (f32x2){0.f, 0.f};
    if (gain) {
#pragma unroll
        for (int k4 = 0; k4 < 16; ++k4) { const f32x4 g = *(const f32x4*)(gain + 64 * kb + 4 * k4);
#pragma unroll
            for (int i = 0; i < 4; ++i) v[4 * k4 + i] = v[4 * k4 + i] * g[i]; }
    }
    bf16* op = WT + (size_t)n * K + 64 * kb;
#pragma unroll
    for (int i = 0; i < 2; ++i)
#pragma unroll
        for (int k8 = 0; k8 < 8; ++k8)
            *(bf16x8*)(op + (size_t)i * K + 8 * k8) = pack8(v[8 * k8][i], v[8 * k8 + 1][i], v[8 * k8 + 2][i], v[8 * k8 + 3][i], v[8 * k8 + 4][i], v[8 * k8 + 5][i], v[8 * k8 + 6][i], v[8 * k8 + 7][i]);
}
template <int GRP> __device__ __forceinline__ void convert_weights(const Params& p, int gw, int NGW, int lane) {
    unsigned char* ws = p.ws;
    constexpr int I_AB = 16 * 30, I_ABO = 16 * 8, I_CI = 16 * 32, I_CO = 16 * 8, I_UP = 16 * 44, I_DN = 44 * 8;
    if (GRP == 0) {
#pragma unroll 1
        for (int r = gw; r < I_AB; r += NGW) conv64_item<0>(p.ab_w_in, 1024, 3664, p.mix_norm, (bf16*)(ws + WS_WAB), r / 30, r % 30, lane);
    } else if (GRP == 1) {
#pragma unroll 1
        for (int it = gw; it < I_ABO + I_UP + I_DN; it += NGW) { int r = it;
            if (r < I_ABO) { conv64_item<3>(p.ab_w_out, 1024, 1024, nullptr, (bf16*)(ws + WS_WABO), r / 8, r % 8, lane); continue; } r -= I_ABO;
            if (r < I_UP) { conv64_item<1>(p.ffn_w_up, 1024, NUP, p.ffn_norm, (bf16*)(ws + WS_WUP0), r / 44, r % 44, lane); continue; } r -= I_UP;
            conv64_item<3>(p.ffn_w_down, DFF, 1024, nullptr, (bf16*)(ws + WS_WDN0), r / 8, r % 8, lane); }
    } else {
#pragma unroll 1
        for (int it = gw; it < I_CI + I_CO + I_UP + I_DN; it += NGW) { int r = it;
            if (r < I_CI) { conv64_item<2>(p.c_w_in, 1024, 4096, p.mix_norm + 1024, (bf16*)(ws + WS_WCI), r / 32, r % 32, lane); continue; } r -= I_CI;
            if (r < I_CO) { conv64_item<3>(p.c_w_out, 1024, 1024, nullptr, (bf16*)(ws + WS_WCO), r / 8, r % 8, lane); continue; } r -= I_CO;
            if (r < I_UP) { conv64_item<1>(p.ffn_w_up + (size_t)1024 * NUP, 1024, NUP, p.ffn_norm + 1024, (bf16*)(ws + WS_WUP1), r / 44, r % 44, lane); continue; } r -= I_UP;
            conv64_item<3>(p.ffn_w_down + (size_t)DFF * 1024, DFF, 1024, nullptr, (bf16*)(ws + WS_WDN1), r / 8, r % 8, lane); }
    }
}
__device__ __forceinline__ void p0_prologue(const Params& p, LAS unsigned char* lds, int wave, int lane) {
    unsigned char* ws = p.ws;
    const int gw = blockIdx.x * NWAVES + wave, NGW = gridDim.x * NWAVES;
    convert_weights<0>(p, gw, NGW, lane);
    if (gridDim.x != 256) { convert_weights<1>(p, gw, NGW, lane); convert_weights<2>(p, gw, NGW, lane); }
    bf16* XB = (bf16*)(ws + WS_XB); float* SSQ0 = (float*)(ws + WS_SSQ0);
    for (int m0 = gw; m0 < M; m0 += 4 * NGW) {
        f32x4 v[4][4];
#pragma unroll
        for (int r = 0; r < 4; ++r) { const int mr = m0 + r * NGW; const f32x4* xr = (const f32x4*)(p.x + (size_t)(mr < M ? mr : m0) * DM) + 2 * lane;
#pragma unroll
            for (int j = 0; j < 4; ++j) v[r][j] = __builtin_nontemporal_load(xr + 128 * (j >> 1) + (j & 1)); }
#pragma unroll
        for (int r = 0; r < 4; ++r) { const int m = m0 + r * NGW;
            if (m < M) {
                float s = 0.f;
#pragma unroll
                for (int j = 0; j < 4; ++j) s += (v[r][j][0] * v[r][j][0] + v[r][j][1] * v[r][j][1]) + (v[r][j][2] * v[r][j][2] + v[r][j][3] * v[r][j][3]);
                s = wave_sum(s);
                bf16x8* o = (bf16x8*)(XB + (size_t)m * DM) + lane;
#pragma unroll
                for (int h = 0; h < 2; ++h) o[64 * h] = pack8(v[r][2 * h][0], v[r][2 * h][1], v[r][2 * h][2], v[r][2 * h][3], v[r][2 * h + 1][0], v[r][2 * h + 1][1], v[r][2 * h + 1][2], v[r][2 * h + 1][3]);
                if (lane == 0) SSQ0[m] = s;
            }
        }
    }
}

__device__ __forceinline__ void gmlp_unit(const Params& p, LAS unsigned char* lds, int unit, int wave, int lane_in) {
    unsigned char* ws = p.ws;
    const int lane = lane_now();
    (void)lane_in;
    const int b = unit >> 5, nblk = (unit >> 1) & 15, T0 = b * 2048 + 128 * nblk, tid = wave * 64 + lane, hh = lane >> 5, l31 = lane & 31, g = 4 * (unit & 1) + (wave & 3);
    LAS float* R = (LAS float*)lds;
    const float* SSQV = (const float*)(ws + WS_SSQV);
    const bf16* U = (const bf16*)(ws + WS_U);
    u32x2 uu[2][2][4]; f32x4 gnv[2][4]; float bsv[2];
#define GM_EPI_LOAD() do { const int ln_ = lane_now(), hq_ = ln_ >> 5, lq_ = ln_ & 31;     \
    _Pragma("unroll") for (int il = 0; il < 2; ++il) { const int i = 32 * (2 * (wave >> 2) + il) + lq_; bsv[il] = p.ab_b_s[g * 128 + i]; \
        _Pragma("unroll") for (int ct = 0; ct < 2; ++ct) _Pragma("unroll") for (int q4 = 0; q4 < 4; ++q4) uu[il][ct][q4] = *(const u32x2*)(U + (size_t)(T0 + i) * 512 + 64 * g + 32 * ct + 8 * q4 + 4 * hq_); } \
    _Pragma("unroll") for (int ct = 0; ct < 2; ++ct) _Pragma("unroll") for (int q4 = 0; q4 < 4; ++q4) gnv[ct][q4] = *(const f32x4*)(p.ab_gmlp_norm + 64 * g + 32 * ct + 8 * q4 + 4 * hq_); } while (0)
    const bf16* VGT = (const bf16*)(ws + WS_VGT);
    const int itp = wave >> 2, nks = itp == 0 ? 4 : 8;
    const float* Wg = p.ab_w_s + (size_t)g * 128 * 128;
    bf16x8 Ab[3][2]; f32x4 Wb[3][2][2];
#define GM_LOAD(SLOT_, KS_) do { \
        _Pragma("unroll") for (int ct = 0; ct < 2; ++ct) Ab[SLOT_][ct] = *(const bf16x8*)(VGT + (size_t)b * (512 * 2048) + frag_off(64 * g + 32 * ct + l31, 128 * nblk + 16 * (KS_) + 8 * hh, 2048)); \
        _Pragma("unroll") for (int il = 0; il < 2; ++il) { const float* wr_ = Wg + (size_t)(32 * (2 * itp + il) + l31) * 128 + 16 * (KS_) + 4 * hh; \
            Wb[SLOT_][il][0] = *(const f32x4*)wr_; Wb[SLOT_][il][1] = *(const f32x4*)(wr_ + 8); } } while (0)
    GM_LOAD(0, 0); GM_LOAD(1, 1); GM_LOAD(2, 2);
    if (tid < 128) { const f32x4 a = *(const f32x4*)(SSQV + (size_t)(T0 + tid) * 8), c = *(const f32x4*)(SSQV + (size_t)(T0 + tid) * 8 + 4);
        R[tid] = 1.0f / sqrtf(((a[0] + a[1]) + (a[2] + a[3]) + (c[0] + c[1]) + (c[2] + c[3])) * (1.0f / 512.0f) + EPS); }
    __syncthreads();
    bf16* Y = (bf16*)(ws + WS_Y);
    {
        f32x16 acc[2][2];
#pragma unroll
        for (int ct = 0; ct < 2; ++ct)
#pragma unroll
            for (int il = 0; il < 2; ++il)
#pragma unroll
                for (int q = 0; q < 16; ++q) acc[ct][il][q] = 0.f;
#define GM_STEP(KS_) do { const int ja = 16 * (KS_) + 4 * hh;                  \
            const f32x4 r0 = *(const LAS f32x4*)(R + ja), r1 = *(const LAS f32x4*)(R + ja + 8); \
            _Pragma("unroll") for (int il = 0; il < 2; ++il) { \
                const f32x4 w0 = Wb[(KS_) % 3][il][0] * r0, w1 = Wb[(KS_) % 3][il][1] * r1; \
                const bf16x8 B = pack8(w0[0], w0[1], w0[2], w0[3], w1[0], w1[1], w1[2], w1[3]); \
                _Pragma("unroll") for (int ct = 0; ct < 2; ++ct) { acc[ct][il] = MFMA32(Ab[(KS_) % 3][ct], B, acc[ct][il]); \
                    asm volatile("; operands stay live past the MFMA: a fresh destination must not be allocated over them" : "+v"(acc[ct][il]) : "v"(Ab[(KS_) % 3][ct]), "v"(B)); } } } while (0)
        if (nks == 8) {
            GM_STEP(0); GM_LOAD(0, 3); GM_STEP(1); GM_LOAD(1, 4); GM_STEP(2); GM_LOAD(2, 5); GM_STEP(3); GM_LOAD(0, 6); GM_STEP(4); GM_LOAD(1, 7);
            GM_STEP(5); GM_EPI_LOAD(); GM_STEP(6); GM_STEP(7);
        } else { GM_STEP(0); GM_LOAD(0, 3); GM_STEP(1); GM_STEP(2); GM_EPI_LOAD(); GM_STEP(3); }
#undef GM_STEP
#undef GM_LOAD
#undef GM_EPI_LOAD
#pragma unroll
        for (int il = 0; il < 2; ++il) { const int le_ = lane_now(), he_ = le_ >> 5; const int i = 32 * (2 * itp + il) + (le_ & 31), tok = T0 + i; const float bs = bsv[il];
#pragma unroll
            for (int ct = 0; ct < 2; ++ct) { u32x2 X[4];
#pragma unroll
                for (int q4 = 0; q4 < 4; ++q4) {
                    const f32x4 gn = gnv[ct][q4];
                    const u32x2 ux = uu[il][ct][q4];
                    const float u0 = __builtin_bit_cast(float, ux.x << 16), u1 = __builtin_bit_cast(float, ux.x & 0xffff0000u), u2 = __builtin_bit_cast(float, ux.y << 16), u3 = __builtin_bit_cast(float, ux.y & 0xffff0000u);
                    X[q4] = pack4(u0 * (acc[ct][il][4 * q4 + 0] * gn[0] + bs), u1 * (acc[ct][il][4 * q4 + 1] * gn[1] + bs), u2 * (acc[ct][il][4 * q4 + 2] * gn[2] + bs), u3 * (acc[ct][il][4 * q4 + 3] * gn[3] + bs)); }
#pragma unroll
                for (int qp = 0; qp < 2; ++qp) {
                    const u32x2 sx = __builtin_amdgcn_permlane32_swap(X[2 * qp].x, X[2 * qp + 1].x, false, false), sy = __builtin_amdgcn_permlane32_swap(X[2 * qp].y, X[2 * qp + 1].y, false, false);
                    const u32x4 v = {sx[0], sy[0], sx[1], sy[1]};
                    *(u32x4*)(Y + (size_t)tok * 1024 + 512 + 64 * g + 32 * ct + 8 * (2 * qp + he_)) = v; } } }
    }
    __syncthreads();
}

template <int CTRL, int RM> __device__ __forceinline__ int dpp_i(int v) { return __builtin_amdgcn_update_dpp(0, v, CTRL, RM, 0xF, false); }
__device__ __forceinline__ void half_sums(int v, int& s0, int& s1) {
    v += dpp_i<0x111, 0xF>(v); v += dpp_i<0x112, 0xF>(v); v += dpp_i<0x114, 0xF>(v); v += dpp_i<0x118, 0xF>(v);
    v += dpp_i<0x142, 0xA>(v);
    s0 = __builtin_amdgcn_readlane(v, 31); s1 = __builtin_amdgcn_readlane(v, 63);
}
__device__ __forceinline__ int count_ge_all(const LAS unsigned* SC, int n8, unsigned cand, int lane) {
    int cnt = 0;
#pragma unroll 1
    for (int i = 0; i < n8; i += 8) { unsigned u8[8];
#pragma unroll
        for (int k = 0; k < 8; ++k) u8[k] = SC[(i + k) * 64 + lane];
#pragma unroll
        for (int k = 0; k < 8; ++k) asm volatile("v_cmp_ge_u32 vcc, %1, %2\n\tv_addc_co_u32 %0, vcc, 0, %0, vcc" : "+v"(cnt) : "v"(u8[k]), "v"(cand) : "vcc"); }
    return cnt;
}
__device__ __forceinline__ void indexer_select(const Params& p, LAS unsigned* SC, LAS unsigned* LIST, int tq0, int c, int lane) {
    unsigned long long* SEL = (unsigned long long*)(p.ws + WS_SEL);
    const int hh = lane >> 5, n32 = 2 * (c + 1);
    const int n8 = (n32 + 7) & ~7;
    for (int kt = n32; kt < n8; ++kt) SC[kt * 64 + lane] = 0u;
    unsigned T0 = 0u, T1 = 0u; bool ex0 = false, ex1 = false;
    const int ng = n8 >> 3;
    unsigned H[8][4];
#pragma unroll
    for (int g = 0; g < 8; ++g)
        if (g < ng) {
#pragma unroll
            for (int k2 = 0; k2 < 4; ++k2) { const unsigned a = SC[(8 * g + 2 * k2) * 64 + lane], b2 = SC[(8 * g + 2 * k2 + 1) * 64 + lane]; H[g][k2] = (a >> 16) | (b2 & 0xFFFF0000u); }
        } else {
#pragma unroll
            for (int k2 = 0; k2 < 4; ++k2) H[g][k2] = 0u;
        }
#pragma unroll 1
    for (int bit = 31; bit >= 16; --bit) {
        const unsigned c0 = ex0 ? T0 : (T0 | (1u << bit)), c1 = ex1 ? T1 : (T1 | (1u << bit));
        const unsigned cm = ((hh ? c1 : c0) >> 16) - 1u, CM = cm | (cm << 16);
        unsigned acc = 0u;
#pragma unroll
        for (int g = 0; g < 8; ++g)
            if (g < ng) {
#pragma unroll
                for (int k2 = 0; k2 < 4; ++k2) { unsigned d_;
                    asm("v_pk_sub_u16 %0, %1, %2 clamp" : "=v"(d_) : "v"(H[g][k2]), "v"(CM));
                    asm("v_pk_min_u16 %0, %1, %2" : "=v"(d_) : "v"(d_), "v"(0x00010001u));
                    asm("v_pk_add_u16 %0, %1, %2" : "=v"(acc) : "v"(acc), "v"(d_)); }
            }
        int n0, n1; half_sums((int)((acc & 0xFFFFu) + (acc >> 16)), n0, n1);
        if (!ex0 && n0 >= 256) { T0 = c0; ex0 = (n0 == 256); }
        if (!ex1 && n1 >= 256) { T1 = c1; ex1 = (n1 == 256); }
        if (ex0 && ex1) break;
    }
    int need0 = 0, need1 = 0;
    if (!(ex0 && ex1)) {
        const unsigned Tl = hh ? T1 : T0;
#pragma unroll
        for (int s = 0; s < 5; ++s) LIST[s * 64 + lane] = 0u;
        int m = 0, cge = 0;
#pragma unroll 1
        for (int i = 0; i < n8; i += 8) { unsigned u8[8];
#pragma unroll
            for (int k = 0; k < 8; ++k) u8[k] = SC[(i + k) * 64 + lane];
#pragma unroll
            for (int k = 0; k < 8; ++k) { const unsigned d = u8[k] - Tl; cge += (u8[k] >= Tl) ? 1 : 0;
                if (u8[k] >= Tl && d < (1u << 16)) { if (m < 5) LIST[m * 64 + lane] = u8[k]; ++m; } } }
        int ge0, ge1, mb0, mb1; half_sums(cge, ge0, ge1); half_sums(m, mb0, mb1);
        const int G0 = ge0 - mb0, G1 = ge1 - mb1;
        const bool overflow = __ballot(m > 5) != 0ull;
        unsigned v[5];
#pragma unroll
        for (int s = 0; s < 5; ++s) v[s] = LIST[s * 64 + lane];
#pragma unroll 1
        for (int bit = 15; bit >= 0; --bit) {
            const unsigned c0 = ex0 ? T0 : (T0 | (1u << bit)), c1 = ex1 ? T1 : (T1 | (1u << bit));
            const unsigned cand = hh ? c1 : c0;
            int n0, n1;
            if (overflow) half_sums(count_ge_all(SC, n8, cand, lane), n0, n1);
            else { int cnt = 0;
#pragma unroll
                for (int s = 0; s < 5; ++s) cnt += (v[s] >= cand) ? 1 : 0;
                half_sums(cnt, n0, n1); n0 += G0; n1 += G1; }
            if (!ex0 && n0 >= 256) { T0 = c0; ex0 = (n0 == 256); }
            if (!ex1 && n1 >= 256) { T1 = c1; ex1 = (n1 == 256); }
            if (ex0 && ex1) break;
        }
        if (!(ex0 && ex1)) { const unsigned Tf = hh ? T1 : T0; int g0, g1;
            if (overflow) { int cnt = 0;
#pragma unroll 1
                for (int i = 0; i < n8; i += 8) { unsigned u8[8];
#pragma unroll
                    for (int k = 0; k < 8; ++k) u8[k] = SC[(i + k) * 64 + lane];
#pragma unroll
                    for (int k = 0; k < 8; ++k) cnt += (u8[k] > Tf) ? 1 : 0; }
                half_sums(cnt, g0, g1);
            } else { int cnt = 0;
#pragma unroll
                for (int s = 0; s < 5; ++s) cnt += (v[s] > Tf) ? 1 : 0;
                half_sums(cnt, g0, g1); g0 += G0; g1 += G1; }
            need0 = ex0 ? 0 : 256 - g0; need1 = ex1 ? 0 : 256 - g1; }
    }
    const unsigned T = hh ? T1 : T0;
    const bool exl = hh ? ex1 : ex0;
#pragma unroll 1
    for (int i0 = 0; i0 < n8; i0 += 8) {
        unsigned u8[8];
#pragma unroll
        for (int k = 0; k < 8; ++k) u8[k] = SC[(i0 + k) * 64 + lane];
        unsigned s0[8], s1[8];
#pragma unroll
        for (int k = 0; k < 8; ++k) { const unsigned long long mg = __ballot(exl ? (u8[k] >= T) : (u8[k] > T)); s0[k] = (unsigned)mg; s1[k] = (unsigned)(mg >> 32); }
        if (need0 > 0 || need1 > 0) {
#pragma unroll
            for (int k = 0; k < 8; ++k) { const unsigned long long me = __ballot(!exl && u8[k] == T);
                unsigned t0 = (unsigned)me, t1 = (unsigned)(me >> 32);
                while (t0 != 0u && need0 > 0) { const unsigned low = t0 & (0u - t0); s0[k] |= low; t0 ^= low; --need0; }
                while (t1 != 0u && need1 > 0) { const unsigned low = t1 & (0u - t1); s1[k] |= low; t1 ^= low; --need1; } }
        }
        int val = 0;
        asm("v_writelane_b32 %0, %1, 0" : "+v"(val) : "s"(s0[0])); asm("v_writelane_b32 %0, %1, 32" : "+v"(val) : "s"(s1[0]));
        asm("v_writelane_b32 %0, %1, 1" : "+v"(val) : "s"(s0[1])); asm("v_writelane_b32 %0, %1, 33" : "+v"(val) : "s"(s1[1]));
        asm("v_writelane_b32 %0, %1, 2" : "+v"(val) : "s"(s0[2])); asm("v_writelane_b32 %0, %1, 34" : "+v"(val) : "s"(s1[2]));
        asm("v_writelane_b32 %0, %1, 3" : "+v"(val) : "s"(s0[3])); asm("v_writelane_b32 %0, %1, 35" : "+v"(val) : "s"(s1[3]));
        asm("v_writelane_b32 %0, %1, 4" : "+v"(val) : "s"(s0[4])); asm("v_writelane_b32 %0, %1, 36" : "+v"(val) : "s"(s1[4]));
        asm("v_writelane_b32 %0, %1, 5" : "+v"(val) : "s"(s0[5])); asm("v_writelane_b32 %0, %1, 37" : "+v"(val) : "s"(s1[5]));
        asm("v_writelane_b32 %0, %1, 6" : "+v"(val) : "s"(s0[6])); asm("v_writelane_b32 %0, %1, 38" : "+v"(val) : "s"(s1[6]));
        asm("v_writelane_b32 %0, %1, 7" : "+v"(val) : "s"(s0[7])); asm("v_writelane_b32 %0, %1, 39" : "+v"(val) : "s"(s1[7]));
        if ((lane & 31) < 8) ((unsigned*)SEL)[(size_t)(tq0 + hh) * 64 + i0 + (lane & 31)] = (unsigned)val;
    }
}

__device__ __forceinline__ void indexer_unit(const Params& p, LAS unsigned char* lds, int b, int c, int qg, int wave, int lane) {
    unsigned char* ws = p.ws;
    const int tq0 = b * 2048 + 64 * c + 16 * qg, hh = lane >> 5, l31 = lane & 31, tid = wave * 64 + lane;
    if (c < 4) {
        if (tid < 64) { const int q = tid >> 2, kt = tid & 3; if (kt <= c) ((unsigned long long*)(ws + WS_SEL))[(size_t)(tq0 + q) * 32 + kt] = ~0ull; }
        return;
    }
    LAS unsigned* SCall = (LAS unsigned*)lds;
    LAS float* WQ = (LAS float*)(lds + LDSX_OFF);
    const bf16* IQ = (const bf16*)(ws + WS_IQ); const bf16* IK = (const bf16*)(ws + WS_IK); const float* IW = (const float*)(ws + WS_IW);
    const int n32 = 2 * (c + 1);
    const bf16* ikp = IK + frag_off(b * 2048 + l31, 8 * hh, 64);
    bf16x8 Bt[8][4];
#pragma unroll
    for (int j = 0; j < 8; ++j) { const int kt = wave + 8 * j < n32 ? wave + 8 * j : wave;
#pragma unroll
        for (int ks = 0; ks < 4; ++ks) Bt[j][ks] = *(const bf16x8*)(ikp + (size_t)((kt * 4 + ks) * 512)); }
    const bf16* iqp = IQ + frag_off((tq0 >> 1) * 32 + l31, 8 * hh, 64);
    bf16x8 Ac[4];
#pragma unroll
    for (int ks = 0; ks < 4; ++ks) Ac[ks] = *(const bf16x8*)(iqp + ks * 512);
    { float wq_ = 0.f; if (tid < 256) wq_ = IW[(size_t)tq0 * 16 + tid]; asm volatile("" : "+v"(wq_)); if (tid < 256) WQ[tid] = wq_; }
    __syncthreads();
#pragma unroll 1
    for (int mt = 0; mt < 8; ++mt) {
        const int mtn = mt + 1 < 8 ? mt + 1 : mt;
        bf16x8 An[4];
#pragma unroll
        for (int ks = 0; ks < 4; ++ks) An[ks] = *(const bf16x8*)(iqp + (size_t)((mtn * 4 + ks) * 512));
        const LAS f32x4* wq = (const LAS f32x4*)(WQ + (2 * mt + hh) * 16);
        const f32x4 w0 = wq[0], w1 = wq[1], w2 = wq[2], w3 = wq[3];
#pragma unroll
        for (int j = 0; j < 8; ++j) {
            if (wave + 8 * j < n32) {
                f32x16 a;
#pragma unroll
                for (int q = 0; q < 16; ++q) a[q] = 0.f;
#pragma unroll
                for (int ks = 0; ks < 4; ++ks) a = MFMA32(Ac[ks], Bt[j][ks], a);
                asm volatile("s_nop 10" : "+v"(a));
                float s4[4];
#define IDX_RELU(T_, A_) asm("v_max_f32 %0, 0, %1" : "=v"(T_) : "v"(A_))
#pragma unroll
                for (int i = 0; i < 4; ++i) { float t_; IDX_RELU(t_, a[i]); asm("v_mul_f32 %0, %1, %2" : "=v"(s4[i]) : "v"(w0[i]), "v"(t_)); }
#pragma unroll
                for (int i = 0; i < 4; ++i) { float t_; IDX_RELU(t_, a[4 + i]); asm("v_fmac_f32 %0, %1, %2" : "+v"(s4[i]) : "v"(w1[i]), "v"(t_)); }
#pragma unroll
                for (int i = 0; i < 4; ++i) { float t_; IDX_RELU(t_, a[8 + i]); asm("v_fmac_f32 %0, %1, %2" : "+v"(s4[i]) : "v"(w2[i]), "v"(t_)); }
#pragma unroll
                for (int i = 0; i < 4; ++i) { float t_; IDX_RELU(t_, a[12 + i]); asm("v_fmac_f32 %0, %1, %2" : "+v"(s4[i]) : "v"(w3[i]), "v"(t_)); }
#undef IDX_RELU
                float sc;
                asm("v_add_f32 %0, %1, %2" : "=v"(sc) : "v"(s4[0]), "v"(s4[1])); asm("v_add_f32 %0, %0, %1" : "+v"(s4[2]) : "v"(s4[3])); asm("v_add_f32 %0, %0, %1" : "+v"(sc) : "v"(s4[2]));
                unsigned bits = __builtin_bit_cast(unsigned, sc); bits ^= (bits >> 31) ? 0xFFFFFFFFu : 0x80000000u;
                SCall[mt * 4096 + (wave + 8 * j) * 64 + lane] = bits;
            }
        }
#pragma unroll
        for (int ks = 0; ks < 4; ++ks) Ac[ks] = An[ks];
    }
    __syncthreads();
    indexer_select(p, SCall + wave * 4096, (LAS unsigned*)(lds + LDSX_OFF + 1024) + wave * 320, tq0 + 2 * wave, c, lane);
}

__device__ __forceinline__ void p2_gmlp(const Params& p, LAS unsigned char* lds, int wave, int lane) {
    for (int u = blockIdx.x; u < 256; u += gridDim.x) gmlp_unit(p, lds, u, wave, lane);
}
__device__ __forceinline__ void p2_indexer(const Params& p, LAS unsigned char* lds, int wave, int lane) {
#pragma unroll 1
    for (int it = blockIdx.x; it < 512; it += gridDim.x) {
        const int b = it & 7, cp = (it >> 3) & 15, qg = it >> 7;
#pragma unroll 1
        for (int sub = 0; sub < 2; ++sub) indexer_unit(p, lds, b, sub ? cp : 31 - cp, qg, wave, lane);
    }
}

__device__ __forceinline__ void p3_attention(const Params& p, LAS unsigned char* lds, int wave, int lane) {
    unsigned char* ws = p.ws;
    LAS unsigned* SELL = (LAS unsigned*)(lds + 8192 + 4 * 17 * 1024);
    LAS float* BT = (LAS float*)lds;
    const bf16* Q = (const bf16*)(ws + WS_Q); const bf16* K = (const bf16*)(ws + WS_K); const bf16* VT = (const bf16*)(ws + WS_VT); bf16* Y = (bf16*)(ws + WS_Y);
    const unsigned long long* SEL = (const unsigned long long*)(ws + WS_SEL);
    for (int item = blockIdx.x; item < 256; item += gridDim.x) {
        const int lane_ = lane_now(), hh = lane_ >> 5, l31 = lane_ & 31;
        const int b = item & 7, g = (item >> 3) & 1, cp = item >> 4;
        const int hd = wave & 3, head = 4 * g + hd, kh = wave >> 2, bh = b * 8 + head;
        const LAS float* bt = BT + head * 256;
        int c = 31 - cp;
#define tq0 (64 * c + l31)
#define nTw (c + 1)
#define SELW(S_, NQ_, T_) SELL[((S_) * 64 + 32 * (NQ_) + l31) * 65 + (T_)]
        const bf16* kbase = K + (size_t)bh * (2048 * 64) + (size_t)(hh * 32 + l31) * 8;
        const bf16* vbase = VT + (size_t)b * (512 * 2048) + frag_off(head * 64 + l31, 8 * hh, 2048);
        bf16x8 Qo[2][4], K0[4], K1[4], V0[2][2], V1[2][2]; unsigned w0[2], w1[2];
#define ATT_LOAD(KX, VX, WX, I, SUB_) do { const int T_ = kh + 2 * ((I) < nTw ? (I) : nTw - 1); \
                _Pragma("unroll") for (int ks = 0; ks < 4; ++ks) KX[ks] = *(const bf16x8*)(kbase + (size_t)((T_ * 4 + ks) * 512)); \
                _Pragma("unroll") for (int s2 = 0; s2 < 2; ++s2) _Pragma("unroll") for (int dt = 0; dt < 2; ++dt) VX[s2][dt] = *(const bf16x8*)(vbase + (size_t)dt * (128 * 512) + (size_t)((2 * T_ + s2) * 512)); \
                WX[0] = SELW(SUB_, 0, T_); WX[1] = SELW(SUB_, 1, T_); } while (0)
#define ATT_LOADQ() do { _Pragma("unroll") for (int nq = 0; nq < 2; ++nq) _Pragma("unroll") for (int ks = 0; ks < 4; ++ks) \
                Qo[nq][ks] = *(const bf16x8*)(Q + (size_t)bh * (2048 * 64) + frag_off(tq0 + 32 * nq, 16 * ks + 8 * hh, 64)); } while (0)
        ATT_LOADQ();
#pragma unroll
        for (int ks = 0; ks < 4; ++ks) K0[ks] = *(const bf16x8*)(kbase + (size_t)((kh * 4 + ks) * 512));
#pragma unroll
        for (int s2 = 0; s2 < 2; ++s2)
#pragma unroll
            for (int dt = 0; dt < 2; ++dt) V0[s2][dt] = *(const bf16x8*)(vbase + (size_t)dt * (128 * 512) + (size_t)((2 * kh + s2) * 512));
        if (item != (int)blockIdx.x) __syncthreads();
        {
            const int tid_ = wave * 64 + lane_;
            u32x4 sv_[4]; float bv_[4];
#pragma unroll
            for (int j = 0; j < 4; ++j) {
                const int k_ = tid_ + 512 * j, s_ = k_ >> 10, row_ = (k_ >> 4) & 63, part_ = k_ & 15;
                sv_[j] = *(const u32x4*)((const unsigned*)SEL + (size_t)(b * 2048 + 64 * (s_ ? cp : 31 - cp) + row_) * 64 + 4 * part_);
            }
            if (item == (int)blockIdx.x) {
#pragma unroll
                for (int j = 0; j < 4; ++j) { const int idx = tid_ + 512 * j;
                    const int h = idx >> 8, rel = (idx & 255) - 191, n = rel < 0 ? -rel : rel;
                    int bk = rel > 0 ? 16 : 0;
                    if (n < 8) bk += n; else { int lg = 33 - __builtin_clz((unsigned)(n * n)); bk += lg < 15 ? lg : 15; }
                    bv_[j] = p.rel_bias[bk * 8 + h]; }
            }
#pragma unroll
            for (int j = 0; j < 4; ++j) {
                const int k_ = tid_ + 512 * j, s_ = k_ >> 10, row_ = (k_ >> 4) & 63, part_ = k_ & 15;
                LAS unsigned* d_ = SELL + (s_ * 64 + row_) * 65 + 4 * part_;
                d_[0] = sv_[j][0]; d_[1] = sv_[j][1]; d_[2] = sv_[j][2]; d_[3] = sv_[j][3];
            }
            if (item == (int)blockIdx.x) {
#pragma unroll
                for (int j = 0; j < 4; ++j) BT[tid_ + 512 * j] = bv_[j] * LOG2E;
            }
        }
        __syncthreads();
        w0[0] = SELW(0, 0, kh); w0[1] = SELW(0, 1, kh);
        const float bfar = bt[0];
#pragma unroll 1
        for (int sub = 0; sub < 2; ++sub) {
            f32x16 O[2][2];
#pragma unroll
            for (int q = 0; q < 16; ++q) { O[0][0][q] = 0.f; O[0][1][q] = 0.f; O[1][0][q] = 0.f; O[1][1][q] = 0.f; }
            float mrun[2] = {-1e30f, -1e30f}, lsum[2] = {0.f, 0.f};
#define ATT_PAIR(J, KB0, KB1) { int m0_, m1_; asm("v_bfe_i32 %0, %1, " #KB0 ", 1" : "=v"(m0_) : "v"(w)); asm("v_bfe_i32 %0, %1, " #KB1 ", 1" : "=v"(m1_) : "v"(w)); \
                float a0_, a1_; asm("v_add_f32 %0, %1, %2" : "=v"(a0_) : "v"(S[nq][2 * J]), "v"(sh_)); asm("v_add_f32 %0, %1, %2" : "=v"(a1_) : "v"(S[nq][2 * J + 1]), "v"(sh_)); \
                const float e0_ = __builtin_bit_cast(float, __builtin_bit_cast(unsigned, fexp2(a0_)) & (unsigned)m0_), e1_ = __builtin_bit_cast(float, __builtin_bit_cast(unsigned, fexp2(a1_)) & (unsigned)m1_); \
                pk[J] = cvt_pk(e0_, e1_); \
                asm("v_add_f32 %0, %0, %1" : "+v"(ps0_) : "v"(e0_)); asm("v_add_f32 %0, %0, %1" : "+v"(ps1_) : "v"(e1_)); }
#define ATT_STEP(NEAR) do { \
                ATT_LOAD(K1, V1, w1, i + 1, sub); \
                const int T = kh + 2 * i; \
                f32x16 S[2]; \
                _Pragma("unroll") for (int nq = 0; nq < 2; ++nq) { \
                    _Pragma("unroll") for (int q = 0; q < 16; ++q) S[nq][q] = 0.f; \
                    _Pragma("unroll") for (int ks = 0; ks < 4; ++ks) S[nq] = MFMA32(K0[ks], Qo[nq][ks], S[nq]); \
                    asm volatile("; operands stay live past the MFMAs: a fresh destination must not be allocated over them" : "+v"(S[nq]) : "v"(K0[0]), "v"(K0[1]), "v"(K0[2]), "v"(K0[3])); \
                } \
                _Pragma("unroll") for (int nq = 0; nq < 2; ++nq) { \
                    if (NEAR) { const LAS float* btp = bt + (32 * T - tq0 - 32 * nq + 191) + 4 * hh; \
                        _Pragma("unroll") for (int q = 0; q < 16; ++q) S[nq][q] += btp[(q & 3) + 8 * (q >> 2)]; } \
                    float tmax = S[nq][0]; \
                    _Pragma("unroll") for (int q = 1; q < 16; ++q) tmax = fmaxf(tmax, S[nq][q]); \
                    if (!(NEAR)) tmax += bfar; \
                      \
                    { const u32x2 r_ = __builtin_amdgcn_permlane32_swap(__builtin_bit_cast(unsigned, tmax), __builtin_bit_cast(unsigned, tmax), false, false); \
                      tmax = fmaxf(__builtin_bit_cast(float, r_[0]), __builtin_bit_cast(float, r_[1])); } \
                    if (__builtin_amdgcn_ballot_w64(tmax > mrun[nq] + 8.0f)) {     \
                        const float mnew = fmaxf(mrun[nq], tmax), alpha = fexp2(mrun[nq] - mnew); \
                        mrun[nq] = mnew; lsum[nq] *= alpha; \
                        _Pragma("unroll") for (int q = 0; q < 16; ++q) { O[nq][0][q] *= alpha; O[nq][1][q] *= alpha; } \
                    } \
                    const unsigned w = w0[nq] >> (4 * hh);                  \
                    const float sh_ = (NEAR) ? -mrun[nq] : bfar - mrun[nq]; \
                    unsigned pk[8]; float ps0_ = 0.f, ps1_ = 0.f; \
                    ATT_PAIR(0, 0, 1) ATT_PAIR(1, 2, 3) ATT_PAIR(2, 8, 9) ATT_PAIR(3, 10, 11) ATT_PAIR(4, 16, 17) ATT_PAIR(5, 18, 19) ATT_PAIR(6, 24, 25) ATT_PAIR(7, 26, 27) \
                    lsum[nq] += ps0_ + ps1_; \
                    _Pragma("unroll") for (int s2 = 0; s2 < 2; ++s2) { \
                        const bf16x8 Po = __builtin_bit_cast(bf16x8, u32x4{pk[4 * s2], pk[4 * s2 + 1], pk[4 * s2 + 2], pk[4 * s2 + 3]}); \
                        _Pragma("unroll") for (int dt = 0; dt < 2; ++dt) O[nq][dt] = MFMA32(V0[s2][dt], Po, O[nq][dt]); \
                    } \
                } \
                _Pragma("unroll") for (int ks = 0; ks < 4; ++ks) K0[ks] = K1[ks]; \
                _Pragma("unroll") for (int s2 = 0; s2 < 2; ++s2) _Pragma("unroll") for (int dt = 0; dt < 2; ++dt) V0[s2][dt] = V1[s2][dt]; \
                w0[0] = w1[0]; w0[1] = w1[1]; } while (0)
            const int nfar = c > 2 ? c - 2 : 0;
            int i = 0;
#pragma unroll 1
            for (; i < nfar; ++i) ATT_STEP(false);
#pragma unroll 1
            for (; i < nTw; ++i) ATT_STEP(true);
#undef ATT_STEP
#undef ATT_PAIR
            const int cs_ = c;
            if (sub == 0) {
                c = cp;
                ATT_LOADQ();
#pragma unroll
                for (int ks = 0; ks < 4; ++ks) K0[ks] = *(const bf16x8*)(kbase + (size_t)((kh * 4 + ks) * 512));
            }
            LAS float* MG = (LAS float*)(lds + 8192 + hd * (17 * 1024));
            __syncthreads();
            if (kh == 1) {
#pragma unroll
                for (int nq = 0; nq < 2; ++nq) {
#pragma unroll
                    for (int dt = 0; dt < 2; ++dt)
#pragma unroll
                        for (int q4 = 0; q4 < 4; ++q4)
                            *(LAS f32x4*)(MG + ((nq * 2 + dt) * 4 + q4) * 256 + lane_ * 4) = f32x4{O[nq][dt][4 * q4], O[nq][dt][4 * q4 + 1], O[nq][dt][4 * q4 + 2], O[nq][dt][4 * q4 + 3]};
                    MG[4096 + nq * 64 + lane_] = mrun[nq]; MG[4096 + 128 + nq * 64 + lane_] = lsum[nq];
                }
            }
            __syncthreads();
            if (kh == 0) {
                LAS unsigned char* ST = (LAS unsigned char*)MG;
#pragma unroll
                for (int nq = 0; nq < 2; ++nq) {
                    const float mB = MG[4096 + nq * 64 + lane_], lB = MG[4096 + 128 + nq * 64 + lane_];
                    const float m = fmaxf(mrun[nq], mB);
                    float fa = fexp2(mrun[nq] - m), fb = fexp2(mB - m);
                    float l = lsum[nq] * fa + lB * fb;
                    l += __shfl_xor(l, 32);
                    const float inv = 1.0f / l;
                    fa *= inv; fb *= inv;
#pragma unroll
                    for (int dt = 0; dt < 2; ++dt)
#pragma unroll
                        for (int q4 = 0; q4 < 4; ++q4) {
                            const f32x4 ob = *(const LAS f32x4*)(MG + ((nq * 2 + dt) * 4 + q4) * 256 + lane_ * 4);
#pragma unroll
                            for (int i = 0; i < 4; ++i) O[nq][dt][4 * q4 + i] = O[nq][dt][4 * q4 + i] * fa + ob[i] * fb;
                        }
#pragma unroll
                    for (int dt = 0; dt < 2; ++dt)
#pragma unroll
                        for (int q4 = 0; q4 < 4; ++q4) {
                            const int r = 32 * nq + l31, u = 8 * dt + 2 * q4 + hh;
                            *(LAS u32x2*)(ST + r * 128 + ((u ^ ((r & 7) << 1)) * 8)) = pack4(O[nq][dt][4 * q4], O[nq][dt][4 * q4 + 1], O[nq][dt][4 * q4 + 2], O[nq][dt][4 * q4 + 3]);
                        }
                    __builtin_amdgcn_sched_barrier(0);
                }
                const int ln2_ = lane_now();
                bf16* yb = Y + (size_t)(b * 2048 + 64 * cs_) * 1024 + head * 64;
#pragma unroll
                for (int it = 0; it < 8; ++it) {
                    const int rr = 8 * it + (ln2_ >> 3), ch = ln2_ & 7;
                    *(u32x4*)(yb + (size_t)rr * 1024 + ch * 8) = *(const LAS u32x4*)(ST + rr * 128 + ((ch ^ (rr & 7)) * 16));
                }
            }
            if (sub == 0) {
#pragma unroll
                for (int s2 = 0; s2 < 2; ++s2)
#pragma unroll
                    for (int dt = 0; dt < 2; ++dt) V0[s2][dt] = *(const bf16x8*)(vbase + (size_t)dt * (128 * 512) + (size_t)((2 * kh + s2) * 512));
                w0[0] = SELW(1, 0, kh); w0[1] = SELW(1, 1, kh);
            }
        }
#undef ATT_LOAD
#undef ATT_LOADQ
#undef tq0
#undef nTw
#undef SELW
    }
}

__device__ __forceinline__ void p_convfix_rows(const Params& p, int layer, int row_lo, int nrows, int t0, int nthr) {
    unsigned char* ws = p.ws; const float* HB = (const float*)(ws + WS_HB); bf16* ACT = (bf16*)(ws + WS_ACT);
    const float* cw = p.ffn_conv_w + (size_t)layer * 3 * NUP; const float* cbv = p.ffn_conv_b + (size_t)layer * NUP;
    const int total = nrows * (DFF / 4);
#pragma unroll 3
    for (int idx = t0; idx < total; idx += nthr) {
        const int row = row_lo + idx / (DFF / 4), c4 = (idx % (DFF / 4)) * 4, grp = row >> 1, w = row & 1, tok = 128 * grp + w;
        const bool first = (tok & 2047) < 2;
        f32x4 y[2];
#pragma unroll
        for (int half = 0; half < 2; ++half) { const int col = half * DFF + c4;
            const f32x4 h0 = *(const f32x4*)(HB + ((size_t)grp * 4 + 2 + w) * NUP + col);
            f32x4 h1, h2; const f32x4 z = {0.f, 0.f, 0.f, 0.f};
            if (w == 0) { h1 = first ? z : *(const f32x4*)(HB + ((size_t)(grp - 1) * 4 + 1) * NUP + col); h2 = first ? z : *(const f32x4*)(HB + ((size_t)(grp - 1) * 4 + 0) * NUP + col); }
            else        { h1 = *(const f32x4*)(HB + ((size_t)grp * 4 + 2) * NUP + col); h2 = first ? z : *(const f32x4*)(HB + ((size_t)(grp - 1) * 4 + 1) * NUP + col); }
            y[half] = *(const f32x4*)(cbv + col) + *(const f32x4*)(cw + 2 * NUP + col) * h0 + *(const f32x4*)(cw + NUP + col) * h1 + *(const f32x4*)(cw + col) * h2; }
        *(u32x2*)(ACT + (size_t)tok * DFF + c4) = pack4(fsilu(y[0][0]) * y[1][0], fsilu(y[0][1]) * y[1][1], fsilu(y[0][2]) * y[1][2], fsilu(y[0][3]) * y[1][3]);
    }
}

__device__ __forceinline__ void p_convfix(const Params& p, int layer, int wave, int lane) { p_convfix_rows(p, layer, 0, 256, blockIdx.x * (NWAVES * 64) + wave * 64 + lane, gridDim.x * NWAVES * 64); }
struct HgX { bf16x8 bq[2][2], kq[2][2], akt[4], bi[4]; };
__device__ __forceinline__ void hg_lds_put(LAS float* buf, int tt, int slot, const f32x16& o, int lane) {
    LAS f32x4* d = (LAS f32x4*)(buf + (tt * 4 + slot) * 1024) + lane;
#pragma unroll
    for (int k = 0; k < 4; ++k) d[k * 64] = (f32x4){o[4 * k], o[4 * k + 1], o[4 * k + 2], o[4 * k + 3]};
}
__device__ __forceinline__ void hg_reader(LAS float* buf, bf16* OB, float* OSSQ, int tokc, int h, int es, int hw, int lane) {
    const int tt = hw >> 2, tl = 8 * (hw & 3) + (lane & 7), part = lane >> 3;
    const LAS f32x4* src = (const LAS f32x4*)(buf + tt * 4 * 1024) + (part >> 1) * 64 + 32 * (part & 1) + tl;
    f32x4 v = src[0];
#pragma unroll
    for (int s = 1; s < 4; ++s) v += src[s * 256];
    float ss = (v[0] * v[0] + v[1] * v[1]) + (v[2] * v[2] + v[3] * v[3]);
    ss += __shfl_xor(ss, 8); ss += __shfl_xor(ss, 16); ss += __shfl_xor(ss, 32);
    const int tok = tokc + 32 * tt + tl;
    *(u32x2*)(OB + (size_t)tok * 1024 + h * 128 + es * 32 + 4 * part) = pack4(v[0], v[1], v[2], v[3]);
    if (part == 0) OSSQ[(size_t)tok * 32 + h * 4 + es] = ss;
}
#define HG_SYNC() do { asm volatile("s_waitcnt lgkmcnt(0)" ::: "memory"); __builtin_amdgcn_s_barrier(); asm volatile("" ::: "memory"); } while (0)
__device__ __forceinline__ void p9_hgrn(const Params& p, LAS unsigned char* lds, int wave, int lane) {
    unsigned char* ws = p.ws;
    const bf16* QM = (const bf16*)(ws + WS_QM); const bf16* KM = (const bf16*)(ws + WS_KM); const bf16* KMT = (const bf16*)(ws + WS_KMT); const bf16* IT = (const bf16*)(ws + WS_IT);
    const float* EB = (const float*)(ws + WS_EB); const float* FAC = (const float*)(ws + WS_FAC);
    bf16* OB = (bf16*)p.out; float* OSSQ = (float*)(ws + WS_OSSQ);
    LAS float* OBUF = (LAS float*)lds;
    LAS float* EFA = (LAS float*)(lds + 65536);
    const int hh = lane >> 5, l31 = lane & 31;
    HG_SYNC();
    for (int ub = blockIdx.x; ub < 256; ub += gridDim.x) {
        const int unit = (gridDim.x == 256) ? (ub & 7) * 32 + (ub >> 3) : ub;
        const int b = unit >> 5, h = (unit >> 2) & 7, es = unit & 3, bh = b * 8 + h, tb0 = b * 2048;
        const float* ebp = EB + ((size_t)(b * 32 * 8 + h)) * 128; const float* fcp = FAC + ((size_t)(b * 32 * 8 + h)) * 128;
        if (wave < 4) {
            const int dt = wave;
            f32x16 S;
#pragma unroll
            for (int q = 0; q < 16; ++q) S[q] = 0.f;
            const bf16* qmp = QM + (size_t)bh * (2048 * 128) + frag_off(l31, 32 * dt + 8 * hh, 128);
            const bf16* kmp = KM + (size_t)bh * (2048 * 128) + frag_off(l31, 32 * dt + 8 * hh, 128);
            const bf16* ktp = KMT + (size_t)bh * (128 * 2048) + frag_off(32 * dt + l31, 8 * hh, 2048);
            const bf16* itp = IT + (size_t)bh * (128 * 2048) + frag_off(es * 32 + l31, 8 * hh, 2048);
#define HGX_LOAD(X, c) do { \
            _Pragma("unroll") for (int t2 = 0; t2 < 2; ++t2) _Pragma("unroll") for (int s2 = 0; s2 < 2; ++s2) { \
                X.bq[t2][s2] = *(const bf16x8*)(qmp + (size_t)(((2 * (c) + t2) * 8 + s2) * 512)); X.kq[t2][s2] = *(const bf16x8*)(kmp + (size_t)(((2 * (c) + t2) * 8 + s2) * 512)); } \
            _Pragma("unroll") for (int k4 = 0; k4 < 4; ++k4) { X.akt[k4] = *(const bf16x8*)(ktp + (4 * (c) + k4) * 512); X.bi[k4] = *(const bf16x8*)(itp + (4 * (c) + k4) * 512); } } while (0)
#define HGX_TILE(X, st, tt, O) do { f32x16 a; _Pragma("unroll") for (int q = 0; q < 16; ++q) a[q] = 0.f; \
                _Pragma("unroll") for (int s2 = 0; s2 < 2; ++s2) a = MFMA32(X.kq[st][s2], X.bq[tt][s2], a); \
                asm volatile("; operands stay live past the MFMAs" : "+v"(a) : "v"(X.kq[st][0]), "v"(X.kq[st][1]), "v"(X.bq[tt][0]), "v"(X.bq[tt][1])); \
                if ((st) == (tt)) { _Pragma("unroll") for (int q = 0; q < 16; ++q) { const int srow = (q & 3) + 8 * (q >> 2) + 4 * hh; a[q] = (l31 >= srow) ? a[q] : 0.f; } } \
                _Pragma("unroll") for (int s2 = 0; s2 < 2; ++s2) { const bf16x8 Pa = pack8(a[8 * s2], a[8 * s2 + 1], a[8 * s2 + 2], a[8 * s2 + 3], a[8 * s2 + 4], a[8 * s2 + 5], a[8 * s2 + 6], a[8 * s2 + 7]); \
                    O = MFMA32(X.bi[2 * (st) + s2], Pa, O); asm volatile("; B operand stays live past the MFMA: a fresh destination must not be allocated over it" : "+v"(O) : "v"(Pa)); } } while (0)
#define HGX_STEP(X, c) do { \
            const LAS float* ef = EFA + (c) * 256 + 32 * dt + 4 * hh; \
            _Pragma("unroll") for (int q4 = 0; q4 < 4; ++q4) { const f32x4 e4 = *(const LAS f32x4*)(ef + 8 * q4); _Pragma("unroll") for (int i = 0; i < 4; ++i) S[4 * q4 + i] *= e4[i]; } \
            bf16x8 So[2]; _Pragma("unroll") for (int s2 = 0; s2 < 2; ++s2) So[s2] = pack8(S[8 * s2], S[8 * s2 + 1], S[8 * s2 + 2], S[8 * s2 + 3], S[8 * s2 + 4], S[8 * s2 + 5], S[8 * s2 + 6], S[8 * s2 + 7]); \
            LAS float* buf = OBUF + ((c) & 1) * 8192; \
            { f32x16 O; _Pragma("unroll") for (int q = 0; q < 16; ++q) O[q] = 0.f; \
              HGX_TILE(X, 0, 0, O); _Pragma("unroll") for (int s2 = 0; s2 < 2; ++s2) O = MFMA32(So[s2], X.bq[0][s2], O); hg_lds_put(buf, 0, dt, O, lane); } \
            { f32x16 O; _Pragma("unroll") for (int q = 0; q < 16; ++q) O[q] = 0.f; \
              HGX_TILE(X, 0, 1, O); HGX_TILE(X, 1, 1, O); _Pragma("unroll") for (int s2 = 0; s2 < 2; ++s2) O = MFMA32(So[s2], X.bq[1][s2], O); hg_lds_put(buf, 1, dt, O, lane); } \
            _Pragma("unroll") for (int k4 = 0; k4 < 4; ++k4) S = MFMA32(X.akt[k4], X.bi[k4], S); \
            _Pragma("unroll") for (int q4 = 0; q4 < 4; ++q4) { const f32x4 f4 = *(const LAS f32x4*)(ef + 128 + 8 * q4); _Pragma("unroll") for (int i = 0; i < 4; ++i) S[4 * q4 + i] *= f4[i]; } \
            HG_SYNC(); } while (0)
            HgX XA, XB_;
            HGX_LOAD(XA, 0);
            HG_SYNC();
#pragma unroll 1
            for (int c = 0; c < 32; c += 2) { HGX_LOAD(XB_, c + 1); HGX_STEP(XA, c); { const int cn = c + 2 < 32 ? c + 2 : 31; HGX_LOAD(XA, cn); } HGX_STEP(XB_, c + 1); }
#undef HGX_LOAD
#undef HGX_STEP
#undef HGX_TILE
        } else {
            const int hq = wave - 4;
            {
                const int j = lane & 31, kh = lane >> 5;
#pragma unroll
                for (int k = 0; k < 4; ++k) { const int cc = 8 * hq + 2 * k + kh;
                    const f32x4 ve = *(const f32x4*)(ebp + cc * 1024 + 4 * j), vf = *(const f32x4*)(fcp + cc * 1024 + 4 * j);
                    *(LAS f32x4*)(EFA + cc * 256 + 4 * j) = ve; *(LAS f32x4*)(EFA + cc * 256 + 128 + 4 * j) = vf; }
            }
            HG_SYNC();
#pragma unroll 1
            for (int c = 0; c < 32; ++c) {
                LAS float* buf = OBUF + (c & 1) * 8192;
                HG_SYNC();
                hg_reader(buf, OB, OSSQ, tb0 + 64 * c, h, es, 2 * hq, lane); hg_reader(buf, OB, OSSQ, tb0 + 64 * c, h, es, 2 * hq + 1, lane);
            }
        }
        HG_SYNC();
    }
}

__device__ __forceinline__ void p10_outnorm(const Params& p, int wave, int lane) {
    unsigned char* ws = p.ws; const bf16* OB = (const bf16*)p.out; const bf16* GATE = (const bf16*)(ws + WS_GATE); const float* OSSQ = (const float*)(ws + WS_OSSQ); bf16* ON = (bf16*)(ws + WS_ON);
    const int gw = blockIdx.x * NWAVES + wave, NGW = gridDim.x * NWAVES;
    const int col = 16 * lane, h = lane >> 3;
    f32x4 n0[2], n1[2];
#pragma unroll
    for (int k = 0; k < 2; ++k) { const int cc = col + 8 * k; n0[k] = *(const f32x4*)(p.c_out_norm + (cc & 127)); n1[k] = *(const f32x4*)(p.c_out_norm + (cc & 127) + 4); }
    for (int m0 = gw; m0 < M; m0 += 4 * NGW) {
        u32x4 o[4][2], g[4][2]; f32x4 sq[4];
#pragma unroll
        for (int r = 0; r < 4; ++r) { const int mr = m0 + r * NGW, m = mr < M ? mr : m0; sq[r] = *(const f32x4*)(OSSQ + (size_t)m * 32 + 4 * h);
#pragma unroll
            for (int k = 0; k < 2; ++k) { o[r][k] = *(const u32x4*)(OB + (size_t)m * 1024 + col + 8 * k); g[r][k] = *(const u32x4*)(GATE + (size_t)m * 1024 + col + 8 * k); } }
#pragma unroll
        for (int r = 0; r < 4; ++r) { const int m = m0 + r * NGW;
            if (m < M) {
                const float rn = 1.0f / sqrtf(((sq[r][0] + sq[r][1]) + (sq[r][2] + sq[r][3])) * (1.0f / 128.0f) + EPS);
#pragma unroll
                for (int k = 0; k < 2; ++k) { const int cc = col + 8 * k;
                    float v[8];
#pragma unroll
                    for (int i = 0; i < 4; ++i) { const unsigned ow = o[r][k][i], gwd = g[r][k][i];
                        v[2 * i] = __builtin_bit_cast(float, ow << 16) * __builtin_bit_cast(float, gwd << 16); v[2 * i + 1] = __builtin_bit_cast(float, ow & 0xffff0000u) * __builtin_bit_cast(float, gwd & 0xffff0000u); }
                    *(bf16x8*)(ON + (size_t)m * 1024 + cc) = pack8(v[0] * rn * n0[k][0], v[1] * rn * n0[k][1], v[2] * rn * n0[k][2], v[3] * rn * n0[k][3], v[4] * rn * n1[k][0], v[5] * rn * n1[k][1], v[6] * rn * n1[k][2], v[7] * rn * n1[k][3]);
                }
            }
        }
    }
}

__device__ __forceinline__ void p15_final(const Params& p, int wave, int lane) {
    const float* SSQ = (const float*)(p.ws + WS_SSQA) + 3 * M; const bf16* XB = (const bf16*)(p.ws + WS_XB);
    const int gw = blockIdx.x * NWAVES + wave, NGW = gridDim.x * NWAVES;
    for (int m = gw; m < M; m += NGW) {
        const float rn = 1.0f / sqrtf(SSQ[m] * (1.0f / DM) + EPS);
        f32x4* xr = (f32x4*)(p.out + (size_t)m * DM) + lane; const f32x4* gr = (const f32x4*)p.final_norm + lane; const u32x2* xb = (const u32x2*)(XB + (size_t)m * DM) + lane;
#pragma unroll
        for (int j = 0; j < 4; ++j) { const u32x2 w = xb[64 * j]; f32x4 v; v[0] = __builtin_bit_cast(float, w.x << 16); v[1] = __builtin_bit_cast(float, w.x & 0xffff0000u); v[2] = __builtin_bit_cast(float, w.y << 16); v[3] = __builtin_bit_cast(float, w.y & 0xffff0000u);
            xr[64 * j] = v * rn * gr[64 * j]; }
    }
}

constexpr int NPHASE = 16;
__global__ void __launch_bounds__(NWAVES * 64, 2) mk_fwd(Params p) {
    extern __shared__ __attribute__((aligned(16))) unsigned char lds_raw[];
    LAS unsigned char* lds = (LAS unsigned char*)lds_raw;
    volatile LAS unsigned* MISC = (volatile LAS unsigned*)(lds + MISC_OFF);
    const int wave = __builtin_amdgcn_readfirstlane(threadIdx.x >> 6);
    unsigned char* ws = p.ws;
    for (int u = wave * 64 + lane_now(); u < (LDS_BYTES - MISC_OFF) / 4; u += NWAVES * 64) ((LAS unsigned*)(lds + MISC_OFF))[u] = 0u;
    __syncthreads();
    const bool one = (MK_N_LAUNCHES == 1);
    XcdBarrier bar; bar.bar = (unsigned*)(ws + WS_CTL) + CW_BAR; bar.x = 0; bar.st = nullptr;
    if (one) bar = xcd_barrier_post((unsigned*)(ws + WS_CTL) + CW_BAR, MISC + 8, wave == 0 && lane_now() == 0);
    const int lo = p.ph_lo, hi = p.ph_hi;
#define IN(k) (lo <= (k) && (k) < hi)
#define LN() lane_now()
#define SEAM(k) do { if (one && lo <= (k) && (k) + 1 < hi) xcd_barrier(bar, wave == 0 && lane_now() == 0); } while (0)
    float* SSQA = (float*)(ws + WS_SSQA); bf16* XB = (bf16*)(ws + WS_XB);
    const int G = gridDim.x, cidx = blockIdx.x;

    if (IN(0)) { p0_prologue(p, lds, wave, LN()); } SEAM(0);
    if (IN(1)) {
        pg8::Gemm g{XB, (const bf16*)(ws + WS_WAB), M, NAB, DM}; pg8::StaticOrder S; S.init(M, NAB, G, cidx);
        EpiAB E{ws, p.ab_idx_k_norm};
        pg8::gemm_phase<EpiAB, pg8::StaticOrder, true, true>(lds, g, S, E, wave);
        if (G == 256 && cidx >= 192) convert_weights<1>(p, (cidx - 192) * NWAVES + wave, 64 * NWAVES, LN());
    } SEAM(1);
    if (IN(2)) { p2_gmlp(p, lds, wave, LN()); p2_indexer(p, lds, wave, LN()); } SEAM(2);
    if (IN(3)) { p3_attention(p, lds, wave, LN()); } SEAM(3);
    if (IN(4)) {
        pg8::Gemm g{(const bf16*)(ws + WS_Y), (const bf16*)(ws + WS_WABO), M, DM, DM}; pg8::StaticOrder S; S.init(M, DM, G, cidx);
        EpiRes E{XB, SSQA};
        pg8::gemm_phase<EpiRes, pg8::StaticOrder, true, true>(lds, g, S, E, wave);
    } SEAM(4);
#define FFN_PHASES(l, pb) do { \
        if (IN(pb)) { \
            pg8::Gemm g{XB, (const bf16*)(ws + ((l) ? WS_WUP1 : WS_WUP0)), M, NUP, DM}; pg8::StaticOrder S; S.init(M, NUP, G, cidx); \
            EpiConv E{SSQA + ((l) ? 2 * M : 0), p.ffn_conv_w + (size_t)(l) * 3 * NUP, p.ffn_conv_b + (size_t)(l) * NUP, (bf16*)(ws + WS_ACT), (float*)(ws + WS_HB)}; \
            pg8::gemm_phase<EpiConv, pg8::StaticOrder, true, true>(lds, g, S, E, wave); \
            if ((l) == 0 && G == 256 && cidx >= 128) convert_weights<2>(p, (cidx - 128) * NWAVES + wave, 128 * NWAVES, LN());     \
        } SEAM(pb); \
        if (G != 256) { if (IN((pb) + 1)) { p_convfix(p, (l), wave, LN()); } SEAM((pb) + 1); }     \
        if (IN((pb) + 2)) { \
            pg8::Gemm g{(const bf16*)(ws + WS_ACT), (const bf16*)(ws + ((l) ? WS_WDN1 : WS_WDN0)), M, DM, DFF}; pg8::StaticOrder S; S.init(M, DM, G, cidx); \
            if (G == 256) { pg8::Unit u0; if (S.next(0, u0)) p_convfix_rows(p, (l), 4 * u0.pm, 4, wave * 64 + LN(), NWAVES * 64);     \
                asm volatile("s_waitcnt vmcnt(0)" ::: "memory"); __syncthreads(); } \
            if ((l) == 0 || G != 256) { EpiRes E{XB, SSQA + ((l) ? 3 * M : M)}; \
                pg8::gemm_phase<EpiRes, pg8::StaticOrder, true, true>(lds, g, S, E, wave); } \
            else { EpiFinal E{XB, p.out, SSQA + 3 * M, (unsigned*)(ws + WS_FCNT), p.final_norm};     \
                pg8::gemm_phase<EpiFinal, pg8::StaticOrder, true, true>(lds, g, S, E, wave); } \
        } if (!((l) == 1 && G == 256)) SEAM((pb) + 2); } while (0)
    FFN_PHASES(0, 5);
    if (IN(8)) {
        pg8::Gemm g{XB, (const bf16*)(ws + WS_WCI), M, NCI, DM}; pg8::StaticOrder S; S.init(M, NCI, G, cidx);
        EpiHg E{ws, p.hgrn_lb};
        pg8::gemm_phase<EpiHg, pg8::StaticOrder, true, true>(lds, g, S, E, wave);
    } SEAM(8);
    if (IN(9)) { p9_hgrn(p, lds, wave, LN()); } SEAM(9);
    if (IN(10)) { p10_outnorm(p, wave, LN()); } SEAM(10);
    if (IN(11)) {
        pg8::Gemm g{(const bf16*)(ws + WS_ON), (const bf16*)(ws + WS_WCO), M, DM, DM}; pg8::StaticOrder S; S.init(M, DM, G, cidx);
        EpiRes E{XB, SSQA + 2 * M};
        pg8::gemm_phase<EpiRes, pg8::StaticOrder, true, true>(lds, g, S, E, wave);
    } SEAM(11);
    FFN_PHASES(1, 12);
    if (IN(15) && G != 256) { p15_final(p, wave, LN()); }
#undef IN
#undef SEAM
}

extern "C" void kernel_launch(void* const* d_in, const int* in_sizes, int n_in, void* d_out, int out_size, void* d_ws, size_t ws_size, hipStream_t stream) {
    static int grid = 0;
    if (grid == 0) {
        if (n_in != 19 || out_size != M * DM || ws_size < WS_END) { fprintf(stderr, "kernel_launch: unexpected shapes (n_in %d out %d ws %zu)\n", n_in, out_size, ws_size); grid = -1; return; }
        int dev = 0, cus = 0, per_cu = 0;
        if (hipGetDevice(&dev) != hipSuccess || hipDeviceGetAttribute(&cus, hipDeviceAttributeMultiprocessorCount, dev) != hipSuccess) { grid = -1; return; }
        if (hipFuncSetAttribute((const void*)mk_fwd, hipFuncAttributeMaxDynamicSharedMemorySize, LDS_BYTES) != hipSuccess) { fprintf(stderr, "kernel_launch: hipFuncSetAttribute failed\n"); grid = -1; return; }
        if (hipOccupancyMaxActiveBlocksPerMultiprocessor(&per_cu, (const void*)mk_fwd, NWAVES * 64, LDS_BYTES) != hipSuccess || per_cu < 1) { fprintf(stderr, "kernel_launch: occupancy query says %d\n", per_cu); }
        (void)hipGetLastError();
        grid = cus;
    }
    if (grid < 0) return;
    if (hipMemsetAsync((char*)d_ws + WS_CTL, 0, CTL_ZERO_BYTES, stream) != hipSuccess) return;
    Params p{};
    const float** pp = (const float**)&p;
    for (int i = 0; i < 19; ++i) pp[i] = (const float*)d_in[i];
    p.out = (float*)d_out; p.ws = (unsigned char*)d_ws;
#if MK_N_LAUNCHES == 1
    p.ph_lo = 0; p.ph_hi = NPHASE;
    hipLaunchKernelGGL(mk_fwd, dim3(grid), dim3(NWAVES * 64), LDS_BYTES, stream, p);
#else
    for (int k = 0; k < NPHASE; ++k) { p.ph_lo = k; p.ph_hi = k + 1; hipLaunchKernelGGL(mk_fwd, dim3(grid), dim3(NWAVES * 64), LDS_BYTES, stream, p); }
#endif
}
```
